# Optimizing an MI355X kernel written in HIP

```python
import math
import jax, jax.numpy as jnp
from jax import lax
import numpy as np

D_MODEL = 2048
BATCH = 2
SEQ = 4096
DEPTH = 2

D_MIX = D_MODEL
D_POOL = D_MIX // 4
D_HYENA = 3 * D_MIX // 8
D_GMLP = D_MIX - D_POOL - D_HYENA
POOL_WINDOWS = (2, 4, 8, 16)
N_POOL_GROUPS = len(POOL_WINDOWS)
POOL_GROUP_DIM = D_POOL // N_POOL_GROUPS
HYENA_GROUP_DIM = 128
N_HYENA_GROUPS = D_HYENA // HYENA_GROUP_DIM
FILTER_BANDS = 16
FILTER_EMB = 1 + 2 * FILTER_BANDS
FILTER_HIDDEN = 64
DECAY_TARGET = 1e-2
FAST_DECAY_PCT = 0.3
SLOW_DECAY_PCT = 1.5
CHUNK = 128
GMLP_HEAD_DIM = 128
N_GMLP_HEADS = D_GMLP // GMLP_HEAD_DIM
D_IN_PROJ = D_POOL + 3 * D_HYENA + 2 * D_GMLP
D_FF = 5632
CONV_WIDTH = 3
RMS_EPS = 1e-6
LN_EPS = 1e-5

kernel_name = "hybrid_pool_hyena_gmlp_encoder"


def rmsnorm(x, g):
    xf = x.astype(jnp.float32)
    y = xf * lax.rsqrt(jnp.mean(xf * xf, axis=-1, keepdims=True) + RMS_EPS)
    return (y * g.astype(jnp.float32)).astype(x.dtype)


def layernorm(x, g, b):
    xf = x.astype(jnp.float32)
    mu = jnp.mean(xf, axis=-1, keepdims=True)
    var = jnp.mean(jnp.square(xf - mu), axis=-1, keepdims=True)
    y = (xf - mu) * lax.rsqrt(var + LN_EPS)
    return (y * g.astype(jnp.float32) + b.astype(jnp.float32)).astype(x.dtype)


def dwconv3(x, w, b):
    L = x.shape[1]
    xp = jnp.pad(x, ((0, 0), (1, 1), (0, 0)))
    return xp[:, :L] * w[0] + xp[:, 1:L + 1] * w[1] + xp[:, 2:] * w[2] + b


def multiscale_pool_mixer(xa, w_pool, b_pool, scale):
    B, L, _ = xa.shape
    xf = xa.reshape(B, L, N_POOL_GROUPS, POOL_GROUP_DIM).astype(jnp.float32)
    csum = jnp.concatenate([jnp.zeros_like(xf[:, :1]), jnp.cumsum(xf, axis=1)], axis=1)
    t = np.arange(L)
    pooled = []
    for g, w in enumerate(POOL_WINDOWS):
        lo = np.maximum(t - w // 2, 0)
        hi = np.minimum(t + w // 2 - 1, L - 1)
        cnt = (hi - lo + 1).astype(np.float32)
        s = csum[:, hi + 1, g] - csum[:, lo, g]
        pooled.append(s / cnt[None, :, None])
    pooled = jnp.stack(pooled, axis=2)
    diff = (pooled - xf).astype(xa.dtype)
    y = jnp.einsum('blgc,gcd->blgd', diff, w_pool) + b_pool
    return y.reshape(B, L, D_POOL) * scale


def filter_features(L):
    t = jnp.linspace(0.0, 1.0, L, dtype=jnp.float32)[:, None]
    w = 2.0 * math.pi * jnp.arange(L, dtype=jnp.float32)[:, None] / L
    f = jnp.linspace(1e-4, FILTER_BANDS - 1, FILTER_BANDS, dtype=jnp.float32)[None, :]
    return jnp.concatenate([t, jnp.cos(f * w), -jnp.sin(f * w)], axis=-1), t


def implicit_filters(feat, t, w1, b1, fr1, w2, b2, fr2, w3):
    f32 = lambda a: a.astype(jnp.float32)
    h = jnp.sin(f32(fr1) * (feat @ f32(w1) + f32(b1)))
    h = jnp.sin(f32(fr2) * (h @ f32(w2) + f32(b2)))
    h = h @ f32(w3)
    deltas = jnp.linspace(math.log(DECAY_TARGET) / SLOW_DECAY_PCT,
                          math.log(DECAY_TARGET) / FAST_DECAY_PCT, D_HYENA, dtype=jnp.float32)
    decay = jnp.exp(-t * jnp.abs(deltas)[None, :])
    return h[:, :D_HYENA] * decay, h[:, D_HYENA:] * decay


def bidirectional_fftconv(z, h_fwd, h_bwd):
    B, L, C = z.shape
    k = jnp.concatenate([h_fwd, jnp.zeros((1, C), h_fwd.dtype), h_bwd[:0:-1]], axis=0)
    k_f = jnp.fft.rfft(k, n=2 * L, axis=0)
    z_f = jnp.fft.rfft(z.astype(jnp.float32), n=2 * L, axis=1)
    return jnp.fft.irfft(z_f * k_f[None], n=2 * L, axis=1)[:, :L]


def hyena_mixer(xb, short_w, short_b, h_fwd, h_bwd, d_skip):
    xs = dwconv3(xb, short_w, short_b)
    x0, x1, v = jnp.split(xs, 3, axis=-1)
    z = x1 * v
    y = bidirectional_fftconv(z, h_fwd, h_bwd).astype(z.dtype) + d_skip * z
    return x0 * y


def chunked_spatial_gating(xc, ln_g, ln_b, w_s, b_s):
    B, L, _ = xc.shape
    z = jax.nn.gelu(xc)
    u, v = jnp.split(z, 2, axis=-1)
    v = layernorm(v, ln_g, ln_b).reshape(B, L // CHUNK, CHUNK, N_GMLP_HEADS, GMLP_HEAD_DIM)
    g = jnp.einsum('bnpec,eqp->bnqec', v, w_s) + b_s.T[:, :, None]
    return u * g.reshape(B, L, D_GMLP)


def setup_inputs(seed: int = 0) -> dict:
    key = jax.random.key(seed)
    ks = jax.random.split(key, 27)
    nrm = lambda k, shape, s: s * jax.random.normal(k, shape, jnp.float32)
    c = POOL_GROUP_DIM
    return {
        "x": nrm(ks[0], (BATCH, SEQ, D_MODEL), 1.0),
        "norm_mix": 1.0 + nrm(ks[1], (DEPTH, D_MODEL), 0.05),
        "w_in": nrm(ks[2], (DEPTH, D_MODEL, D_IN_PROJ), D_MODEL ** -0.5),
        "pool_w": nrm(ks[3], (DEPTH, N_POOL_GROUPS, c, c), c ** -0.5),
        "pool_b": nrm(ks[4], (DEPTH, N_POOL_GROUPS, c), 0.02),
        "pool_scale": 1.0 + nrm(ks[5], (DEPTH, D_POOL), 0.1),
        "hy_short_w": nrm(ks[6], (DEPTH, CONV_WIDTH, 3 * D_HYENA), 0.5),
        "hy_short_b": nrm(ks[7], (DEPTH, 3 * D_HYENA), 0.02),
        "hy_filt_w1": nrm(ks[8], (DEPTH, FILTER_EMB, FILTER_HIDDEN), FILTER_EMB ** -0.5),
        "hy_filt_b1": nrm(ks[9], (DEPTH, FILTER_HIDDEN), 0.5),
        "hy_filt_freq1": 1.0 + nrm(ks[10], (DEPTH, FILTER_HIDDEN), 0.1),
        "hy_filt_w2": nrm(ks[11], (DEPTH, FILTER_HIDDEN, FILTER_HIDDEN), FILTER_HIDDEN ** -0.5),
        "hy_filt_b2": nrm(ks[12], (DEPTH, FILTER_HIDDEN), 0.5),
        "hy_filt_freq2": 1.0 + nrm(ks[13], (DEPTH, FILTER_HIDDEN), 0.1),
        "hy_filt_w3": nrm(ks[14], (DEPTH, FILTER_HIDDEN, 2 * D_HYENA), 0.005),
        "hy_skip": nrm(ks[15], (DEPTH, D_HYENA), 0.5),
        "gm_ln_g": 1.0 + nrm(ks[16], (DEPTH, D_GMLP), 0.05),
        "gm_ln_b": nrm(ks[17], (DEPTH, D_GMLP), 0.02),
        "gm_w_s": nrm(ks[18], (DEPTH, N_GMLP_HEADS, CHUNK, CHUNK), CHUNK ** -0.5),
        "gm_b_s": 1.0 + nrm(ks[19], (DEPTH, N_GMLP_HEADS, CHUNK), 0.1),
        "w_out": nrm(ks[20], (DEPTH, D_MIX, D_MODEL), D_MIX ** -0.5),
        "norm_ffn": 1.0 + nrm(ks[21], (DEPTH, D_MODEL), 0.05),
        "ffn_w_up": nrm(ks[22], (DEPTH, D_MODEL, 2 * D_FF), D_MODEL ** -0.5),
        "ffn_conv_w": nrm(ks[23], (DEPTH, CONV_WIDTH, 2 * D_FF), 0.5),
        "ffn_conv_b": nrm(ks[24], (DEPTH, 2 * D_FF), 0.02),
        "ffn_w_down": nrm(ks[25], (DEPTH, D_FF, D_MODEL), D_FF ** -0.5),
        "norm_final": 1.0 + nrm(ks[26], (D_MODEL,), 0.05),
    }


def reference(x, norm_mix, w_in, pool_w, pool_b, pool_scale, hy_short_w, hy_short_b,
              hy_filt_w1, hy_filt_b1, hy_filt_freq1, hy_filt_w2, hy_filt_b2, hy_filt_freq2,
              hy_filt_w3, hy_skip, gm_ln_g, gm_ln_b, gm_w_s, gm_b_s, w_out, norm_ffn,
              ffn_w_up, ffn_conv_w, ffn_conv_b, ffn_w_down, norm_final):
    L = x.shape[1]
    feat, t = filter_features(L)
    a_end = D_POOL
    b_end = D_POOL + 3 * D_HYENA
    for i in range(DEPTH):
        h = rmsnorm(x, norm_mix[i])
        p = h @ w_in[i]
        y_a = multiscale_pool_mixer(p[..., :a_end], pool_w[i], pool_b[i], pool_scale[i])
        h_fwd, h_bwd = implicit_filters(feat, t, hy_filt_w1[i], hy_filt_b1[i], hy_filt_freq1[i],
                                        hy_filt_w2[i], hy_filt_b2[i], hy_filt_freq2[i], hy_filt_w3[i])
        y_b = hyena_mixer(p[..., a_end:b_end], hy_short_w[i], hy_short_b[i], h_fwd, h_bwd, hy_skip[i])
        y_c = chunked_spatial_gating(p[..., b_end:], gm_ln_g[i], gm_ln_b[i], gm_w_s[i], gm_b_s[i])
        x = x + jnp.concatenate([y_a, y_b, y_c], axis=-1) @ w_out[i]
        h = rmsnorm(x, norm_ffn[i])
        up = dwconv3(h @ ffn_w_up[i], ffn_conv_w[i], ffn_conv_b[i])
        gate, val = jnp.split(up, 2, axis=-1)
        x = x + (jax.nn.silu(gate) * val) @ ffn_w_down[i]
    return rmsnorm(x, norm_final)
```

```cpp
#include <hip/hip_runtime.h>
#include <hip/hip_cooperative_groups.h>
#include <cstdio>
namespace cg = cooperative_groups;

#define LAS __attribute__((address_space(3)))
typedef unsigned short bf16_t;
typedef short bf16x8 __attribute__((ext_vector_type(8)));
typedef float f32x4 __attribute__((ext_vector_type(4)));
typedef unsigned u32x4 __attribute__((ext_vector_type(4)));
typedef unsigned u32x2 __attribute__((ext_vector_type(2)));

constexpr int D_MODEL = 2048, SEQ = 4096, NTOK = 8192, D_INP = 4352, D_FF = 5632, D_UP = 11264;
constexpr int D_HY = 768, D_GM = 768;
constexpr int COL_HY = 512, COL_GM = 2816;
constexpr int MIX_HY = 512, MIX_GM = 1280;

constexpr size_t SZ_WT_IN = (size_t)D_INP * D_MODEL * 2, SZ_WT_OUT = (size_t)D_MODEL * D_MODEL * 2, SZ_WT_UP = (size_t)D_UP * D_MODEL * 2, SZ_WT_DN = (size_t)D_MODEL * D_FF * 2;
constexpr size_t SZ_POOLWT = 4 * 128 * 128 * 2, SZ_KF = (size_t)768 * 8192 * 8, SZ_H2 = (size_t)4096 * 64 * 4, SZ_STATS = (size_t)NTOK * 2 * 4;
constexpr size_t OFF_WT_IN = 0;
constexpr size_t OFF_WT_OUT = OFF_WT_IN + 2 * SZ_WT_IN;
constexpr size_t OFF_WT_UP = OFF_WT_OUT + 2 * SZ_WT_OUT;
constexpr size_t OFF_WT_DN = OFF_WT_UP + 2 * SZ_WT_UP;
constexpr size_t OFF_POOLWT = OFF_WT_DN + 2 * SZ_WT_DN;
constexpr size_t OFF_KF = OFF_POOLWT + 2 * SZ_POOLWT;
constexpr size_t OFF_H2 = OFF_KF + 2 * SZ_KF;
constexpr size_t OFF_STATS = OFF_H2 + 2 * SZ_H2;
constexpr size_t OFF_XA = OFF_STATS + 2 * SZ_STATS;
constexpr size_t OFF_H = OFF_XA + (size_t)NTOK * D_MODEL * 4;
constexpr size_t OFF_R1 = OFF_H + (size_t)(NTOK + 512) * D_MODEL * 2;
constexpr size_t OFF_P = OFF_R1;
constexpr size_t OFF_MIX = OFF_P + (size_t)NTOK * D_INP * 2;
constexpr size_t OFF_ZT = OFF_MIX + (size_t)NTOK * D_MODEL * 2;
constexpr size_t OFF_X0T = OFF_ZT + (size_t)768 * 8192 * 4;
constexpr size_t OFF_UP = OFF_R1;
constexpr size_t OFF_ACT = OFF_R1 + (size_t)NTOK * D_UP * 2;
constexpr size_t OFF_BAR = OFF_ACT + (size_t)NTOK * D_FF * 2;
constexpr size_t WS_END = OFF_BAR + 16384;
static_assert(OFF_X0T + (size_t)768 * 8192 * 4 <= OFF_ACT, "alias region");

constexpr int LDS_BYTES = 139264;
#ifndef PROBE
#define PROBE 0
#endif
#define REP(k) for (int rep_ = 0; rep_ < ((PROBE == (k)) ? 2 : 1); ++rep_)

struct Params {
    const float* in[27];
    float* out;
    unsigned char* ws;
    int ph_lo, ph_hi;
};


__device__ __forceinline__ const float* inp(int i) {
    const __attribute__((address_space(4))) char* ka = (const __attribute__((address_space(4))) char*)__builtin_amdgcn_kernarg_segment_ptr();
    int off = i * 8; asm volatile("" : "+s"(off));
    return *(const float* const __attribute__((address_space(4)))*)(ka + off);
}

__device__ __forceinline__ int tid_l() { int t = threadIdx.x; asm volatile("" : "+v"(t)); return t; }
__device__ __forceinline__ float bf2f(bf16_t b) { return __uint_as_float(((unsigned)b) << 16); }
__device__ __forceinline__ unsigned cvt_pk_bf16(float lo, float hi) { unsigned r; asm volatile("v_cvt_pk_bf16_f32 %0, %1, %2" : "=v"(r) : "v"(lo), "v"(hi)); return r; }
__device__ __forceinline__ float lo_bf(unsigned u) { return __uint_as_float(u << 16); }
__device__ __forceinline__ float hi_bf(unsigned u) { return __uint_as_float(u & 0xffff0000u); }
__device__ __forceinline__ float gelu_tanh(float x) {
    const float y2 = 1.5957691216f * (x + 0.044715f * x * x * x);
    return x * __builtin_amdgcn_rcpf(1.0f + __expf(-y2));
}
__device__ __forceinline__ float silu(float x) { return x * __builtin_amdgcn_rcpf(1.0f + __expf(-x)); }
__device__ __forceinline__ float wave_sum(float v) {
#pragma unroll
    for (int o = 32; o > 0; o >>= 1) v += __shfl_xor(v, o, 64);
    return v;
}

#define XB_TMO      128
#define XB_XCNT(j)  (256  + 64 * (j))
#define XB_XSUB(j)  (1280 + 64 * (j))
#define XB_XGEN(j)  (2304 + 64 * (j))
#define XB_TOP      3328
#define XB_TOPGEN   3392
#define XCD_BAR_WORDS 3456
#define XB_SPIN_CAP (1u << 18)

__device__ __forceinline__ unsigned xb_ld(unsigned* p)              { return __hip_atomic_load(p, __ATOMIC_RELAXED, __HIP_MEMORY_SCOPE_AGENT); }
__device__ __forceinline__ unsigned xb_add(unsigned* p, unsigned v) { return __hip_atomic_fetch_add(p, v, __ATOMIC_RELAXED, __HIP_MEMORY_SCOPE_AGENT); }
__device__ __forceinline__ unsigned xb_xcc_id() { return (unsigned)__builtin_amdgcn_s_getreg((3 << 11) | 20) & 0xFu; }
#define XB_SPIN(cond, bar) do { unsigned _sp = 0; while (cond) { __builtin_amdgcn_s_sleep(1); \
    if ((++_sp & 255u) == 0u) { if (xb_ld(&(bar)[XB_TMO])) break; if (_sp > XB_SPIN_CAP) { atomicAdd(&(bar)[XB_TMO], 1u); break; } } } } while (0)

struct XcdBarrier {
    unsigned* bar; unsigned x;
    volatile LAS unsigned* st;
};

__device__ __forceinline__ XcdBarrier xcd_barrier_post(unsigned* bar, volatile LAS unsigned* st) {
    XcdBarrier b; b.bar = bar; b.x = xb_xcc_id(); b.st = st;
    if (threadIdx.x == 0) (void)xb_add(&bar[XB_XCNT(b.x)], 1u);
    return b;
}
__device__ __forceinline__ void xcd_barrier_complete(unsigned* bar, unsigned x, unsigned& nloc, unsigned& nx) {
    const unsigned G = gridDim.x * gridDim.y * gridDim.z;
    unsigned sum, cnt, mine, sp = 0u;
    for (;;) {
        sum = 0u; cnt = 0u; mine = 0u;
#pragma unroll
        for (unsigned j = 0; j < 16; ++j) { const unsigned c = xb_ld(&bar[XB_XCNT(j)]); sum += c; cnt += (c > 0u) ? 1u : 0u; mine = (j == x) ? c : mine; }
        if (sum == G) break;
        __builtin_amdgcn_s_sleep(1);
        if ((++sp & 255u) == 0u) { if (xb_ld(&bar[XB_TMO])) break; if (sp > XB_SPIN_CAP) { atomicAdd(&bar[XB_TMO], 1u); break; } }
    }
    nloc = mine > 0u ? mine : 1u; nx = cnt > 0u ? cnt : 1u;
}

__device__ __forceinline__ void xcd_barrier(const XcdBarrier& b) {
    asm volatile("s_waitcnt vmcnt(0)" ::: "memory");
    __syncthreads();
    if (threadIdx.x == 0) {
        unsigned* bar = b.bar;
        __builtin_amdgcn_s_waitcnt(0);
        unsigned nloc = b.st[0], nx = b.st[1];
        if (nloc == 0u) { xcd_barrier_complete(bar, b.x, nloc, nx); b.st[0] = nloc; b.st[1] = nx; }
        const unsigned old = xb_add(&bar[XB_XSUB(b.x)], 1u);
        const unsigned gen = old / nloc;
        if (old + 1u == (gen + 1u) * nloc) {
            __builtin_amdgcn_fence(__ATOMIC_RELEASE, "agent");
            asm volatile("s_waitcnt vmcnt(0)" ::: "memory");
            const unsigned og = xb_add(&bar[XB_TOP], 1u);
            const unsigned tg = og / nx;
            if (og + 1u == (tg + 1u) * nx) xb_add(&bar[XB_TOPGEN], 1u);
            else XB_SPIN(xb_ld(&bar[XB_TOPGEN]) == tg, bar);
            __builtin_amdgcn_fence(__ATOMIC_ACQUIRE, "agent");
            xb_add(&bar[XB_XGEN(b.x)], 1u);
            asm volatile("s_waitcnt vmcnt(0)" ::: "memory");
        } else {
            XB_SPIN(xb_ld(&bar[XB_XGEN(b.x)]) == gen, bar);
            __builtin_amdgcn_fence(__ATOMIC_ACQUIRE, "agent");
            asm volatile("s_waitcnt vmcnt(0)" ::: "memory");
        }
    }
    __syncthreads();
}


namespace pg8 {
constexpr int BM = 256, BK = 64, HALF = 128, HTB = HALF * BK * 2, STAGE_BYTES = 8 * HTB, NXCD = 8, WGM = 8;
__host__ __device__ __forceinline__ int lds_byte(int r, int c) { const int st = (r >> 4) * 2 + (c >> 5), rr = r & 15, cc = c & 31, ob = rr * 64 + cc * 2; return st * 1024 + (ob ^ (((ob >> 9) & 1) << 5)); }
__host__ __device__ __forceinline__ void stage_rc(int b, int& R, int& C) { const int st = b / 1024, sb = b % 1024, swz = sb ^ (((sb >> 9) & 1) << 5); R = (st >> 1) * 16 + swz / 64; C = (st & 1) * 32 + (swz % 64) / 2; }
__host__ __device__ __forceinline__ int perm32(int rho) { const int n = rho >> 4, i = rho & 15; return 8 * (i >> 2) + 4 * n + (i & 3); }
struct Unit { int pm, pn; };
struct Gemm { const bf16_t* A; const bf16_t* Bt; int M, N, K; };
struct StaticOrder {
    int nM, nN, nwg, G, c;
    __device__ void init(int M, int N, int G_, int c_) { nM = M / BM; nN = N / BM; nwg = nM * nN; G = G_; c = c_; }
    __device__ void init_tiles(int nM_, int nN_, int G_, int c_) { nM = nM_; nN = nN_; nwg = nM * nN; G = G_; c = c_; }
    __device__ bool next(int i, Unit& u) const {
        const long L = (long)i * G + c; if (L >= nwg) return false;
        int wgid = (int)L; { const int q = nwg / NXCD, r = nwg % NXCD, xcd = wgid % NXCD, off = wgid / NXCD; wgid = (xcd < r ? xcd * (q + 1) : r * (q + 1) + (xcd - r) * q) + off; }
        const int nig = WGM * nN, gid = wgid / nig, fm = gid * WGM, gsz = (nM - fm) < WGM ? (nM - fm) : WGM;
        u.pm = fm + ((wgid % nig) % gsz); u.pn = (wgid % nig) / gsz; return true;
    }
};
struct EpiBf16 {
    static constexpr bool PERM = true, CONV = false; static constexpr int GAPA = 0;
    bf16_t* O; int ldc;
    __device__ __forceinline__ void operator()(const f32x4 (&acc)[2][2][4][2], const Unit& u, int wr, int wc, int fr, int fq) const {
        const int row0 = u.pm * BM + wr * 64 + fr; const int col0 = u.pn * BM + wc * 32 + 8 * fq;
#pragma unroll
        for (int ai = 0; ai < 2; ++ai)
#pragma unroll
            for (int m = 0; m < 4; ++m) { bf16_t* rowp = O + (size_t)(row0 + ai * HALF + m * 16) * ldc + col0;
#pragma unroll
                for (int bj = 0; bj < 2; ++bj) { const f32x4 v0 = acc[ai][bj][m][0], v1 = acc[ai][bj][m][1];
                    u32x4 w; w.x = cvt_pk_bf16(v0[0], v0[1]); w.y = cvt_pk_bf16(v0[2], v0[3]); w.z = cvt_pk_bf16(v1[0], v1[1]); w.w = cvt_pk_bf16(v1[2], v1[3]);
                    *(u32x4*)(rowp + bj * HALF) = w; } }
    }
};
struct EpiBf16Gm {
    static constexpr bool PERM = true, CONV = false; static constexpr int GAPA = D_MODEL * 2;
    bf16_t* O; int ldc; float* stats;
    __device__ __forceinline__ void operator()(const f32x4 (&acc)[2][2][4][2], const Unit& u, int wr, int wc, int fr, int fq) const {
        const int row0 = u.pm * BM + wr * 64 + fr; const int col0 = u.pn * BM + wc * 32 + 8 * fq;
        const bool act = u.pn >= 11, st = u.pn >= 14;
#pragma unroll
        for (int ai = 0; ai < 2; ++ai)
#pragma unroll
            for (int m = 0; m < 4; ++m) { const int row = row0 + ai * HALF + m * 16; bf16_t* rowp = O + (size_t)row * ldc + col0; float s1 = 0.f, s2 = 0.f;
#pragma unroll
                for (int bj = 0; bj < 2; ++bj) { f32x4 v0 = acc[ai][bj][m][0], v1 = acc[ai][bj][m][1];
                    if (act) {
#pragma unroll
                        for (int j = 0; j < 4; ++j) { v0[j] = gelu_tanh(v0[j]); v1[j] = gelu_tanh(v1[j]); s1 += v0[j] + v1[j]; s2 += v0[j] * v0[j] + v1[j] * v1[j]; } }
                    u32x4 w; w.x = cvt_pk_bf16(v0[0], v0[1]); w.y = cvt_pk_bf16(v0[2], v0[3]); w.z = cvt_pk_bf16(v1[0], v1[1]); w.w = cvt_pk_bf16(v1[2], v1[3]);
                    *(u32x4*)(rowp + bj * HALF) = w; }
                if (st) { s1 += __shfl_xor(s1, 16, 64); s2 += __shfl_xor(s2, 16, 64); s1 += __shfl_xor(s1, 32, 64); s2 += __shfl_xor(s2, 32, 64);
                    if (fq == 0) { atomicAdd(stats + 2 * row, s1); atomicAdd(stats + 2 * row + 1, s2); } } }
    }
};
__device__ __forceinline__ float dpp_ror1(float v) { return __builtin_bit_cast(float, __builtin_amdgcn_mov_dpp(__builtin_bit_cast(int, v), 0x121, 0xf, 0xf, true)); }
__device__ __forceinline__ float dpp_rol1(float v) { return __builtin_bit_cast(float, __builtin_amdgcn_mov_dpp(__builtin_bit_cast(int, v), 0x12F, 0xf, 0xf, true)); }
struct EpiConvAct {
    static constexpr bool PERM = true, CONV = true; static constexpr int GAPA = 0;
    bf16_t* ACT; const float* cw; const float* cb;
    __device__ __forceinline__ void operator()(const f32x4 (&acc)[2][2][4][2], const Unit& u, int wr, int wc, int fr, int fq) const {
        const bool f0 = fr == 0, f15 = fr == 15;
#pragma unroll
        for (int n = 0; n < 2; ++n) {
            const int cg = 128 * u.pn + 32 * wc + 8 * fq + 4 * n;
            f32x4 wg[3], wv[3];
#pragma unroll
            for (int k = 0; k < 3; ++k) { wg[k] = *(const f32x4*)(cw + k * D_UP + cg); wv[k] = *(const f32x4*)(cw + k * D_UP + D_FF + cg); }
            const f32x4 bg = *(const f32x4*)(cb + cg), bv = *(const f32x4*)(cb + D_FF + cg);
#pragma unroll
            for (int ai = 0; ai < 2; ++ai) { const int pbase = 248 * u.pm + 62 * (2 * ai + wr);
                float rpg[4], rpv[4], lcg[4], lcv[4];
#pragma unroll
                for (int j = 0; j < 4; ++j) { rpg[j] = 0.f; rpv[j] = 0.f; lcg[j] = dpp_rol1(acc[ai][0][0][n][j]); lcv[j] = dpp_rol1(acc[ai][1][0][n][j]); }
#pragma unroll
                for (int m = 0; m < 4; ++m) { const int q = 16 * m + fr, pr = pbase + q; const int G = pr - 1 - (pr > 4097 ? 1 : 0);
                    const f32x4 gc = acc[ai][0][m][n], vc = acc[ai][1][m][n]; float o[4];
#pragma unroll
                    for (int j = 0; j < 4; ++j) {
                        const float rg = dpp_ror1(gc[j]), rv = dpp_ror1(vc[j]);
                        const float gp = (m > 0 && f0) ? rpg[j] : rg, vp = (m > 0 && f0) ? rpv[j] : rv;
                        float gn = lcg[j], vn = lcv[j];
                        if (m < 3) { const float a = dpp_rol1(acc[ai][0][m + 1][n][j]), b = dpp_rol1(acc[ai][1][m + 1][n][j]); gn = f15 ? a : gn; vn = f15 ? b : vn; lcg[j] = a; lcv[j] = b; }
                        rpg[j] = rg; rpv[j] = rv;
                        const float ga = __builtin_fmaf(wg[0][j], gp, __builtin_fmaf(wg[1][j], gc[j], __builtin_fmaf(wg[2][j], gn, bg[j])));
                        float va = __builtin_fmaf(wv[2][j], vn, bv[j]); asm volatile("" : "+v"(va));
                        va = __builtin_fmaf(wv[1][j], vc[j], va); asm volatile("" : "+v"(va));
                        va = __builtin_fmaf(wv[0][j], vp, va);
                        o[j] = silu(ga) * va; }
                    if (q >= 1 && q <= 62 && pr >= 1 && pr != 4097 && pr <= 8193) { u32x2 ow; ow.x = cvt_pk_bf16(o[0], o[1]); ow.y = cvt_pk_bf16(o[2], o[3]); *(u32x2*)(ACT + (size_t)G * D_FF + cg) = ow; } } }
        }
    }
};
struct EpiRes {
    static constexpr bool PERM = false, CONV = false; static constexpr int GAPA = 0;
    float* C; const float* R; int ldc;
    __device__ __forceinline__ void operator()(const f32x4 (&acc)[2][2][4][2], const Unit& u, int wr, int wc, int fr, int fq) const {
        const int row0 = u.pm * BM + wr * 64 + fr, col0 = u.pn * BM + wc * 32 + 4 * fq;
#pragma unroll
        for (int ai = 0; ai < 2; ++ai)
#pragma unroll
            for (int m = 0; m < 4; ++m) { const size_t ro = (size_t)(row0 + ai * HALF + m * 16) * ldc + col0;
#pragma unroll
                for (int bj = 0; bj < 2; ++bj)
#pragma unroll
                    for (int n = 0; n < 2; ++n) { const f32x4 r = *(const f32x4*)(R + ro + bj * HALF + n * 16); *(f32x4*)(C + ro + bj * HALF + n * 16) = acc[ai][bj][m][n] + r; } }
    }
};

template <class Epi, class Sched, int KDIM>
__device__ __forceinline__ void gemm_phase(LAS unsigned char* lds, const Gemm g, const Sched& S, const Epi& E) {
    int tid_ = threadIdx.x; asm volatile("" : "+v"(tid_));
    const int tid = tid_, wid = __builtin_amdgcn_readfirstlane(tid >> 6), lane = tid & 63, wr = wid >> 2, wc = wid & 3, fr = lane & 15, fq = lane >> 4;
    constexpr int K = KDIM, nt = K / BK;
    unsigned voffA[2], voffB[2];
#pragma unroll
    for (int i = 0; i < 2; ++i) { int R, C; stage_rc(tid * 16 + i * 8192, R, C); const int Rb = Epi::PERM ? ((R & ~31) + perm32(R & 31)) : R;
        const int Ra = Epi::CONV ? (62 * (R >> 6) + (R & 63)) : R;
        voffA[i] = (unsigned)(Ra * K + C) * 2u; voffB[i] = (unsigned)(Rb * K + C) * 2u; }
    const size_t kstep = (size_t)(BK * 2);
    const size_t hstep = (size_t)HALF * K * 2;
    const size_t tstep = 2 * hstep;
    const size_t hstepA = Epi::CONV ? (size_t)124 * K * 2 : hstep, tstepA = 2 * hstepA;
    const unsigned ldsw = (unsigned)wid * 1024u;
    const int aoff = lds_byte(wr * 64 + fr, fq * 8), boff = lds_byte(wc * 32 + fr, fq * 8);
#define PG8_SA(b, h) (((b) * 2 + (h)) * HTB)
#define PG8_SB(b, h) ((4 + (b) * 2 + (h)) * HTB)
#define PG8_STAGE(bufoff, gbase, voff) do { _Pragma("unroll") for (int _i = 0; _i < 2; ++_i) \
        __builtin_amdgcn_global_load_lds((const unsigned*)((const char*)(gbase) + (voff)[_i]), (LAS unsigned*)(lds + (bufoff) + ldsw + _i * 8192), 16, 0, 0); } while (0)
#define PG8_LDA(dst, b, h) do { _Pragma("unroll") for (int m = 0; m < 4; ++m) _Pragma("unroll") for (int k = 0; k < 2; ++k) dst[m][k] = *(const LAS bf16x8*)(lds + PG8_SA(b, h) + aoff + m * 2048 + k * 1024); } while (0)
#define PG8_LDB(dst, b, h) do { _Pragma("unroll") for (int n = 0; n < 2; ++n) _Pragma("unroll") for (int k = 0; k < 2; ++k) dst[n][k] = *(const LAS bf16x8*)(lds + PG8_SB(b, h) + boff + n * 2048 + k * 1024); } while (0)
#define PG8_MMA(ai, bj, At, Bt) do { __builtin_amdgcn_s_setprio(1); _Pragma("unroll") for (int m = 0; m < 4; ++m) _Pragma("unroll") for (int n = 0; n < 2; ++n) _Pragma("unroll") for (int k = 0; k < 2; ++k) \
        acc[ai][bj][m][n] = __builtin_amdgcn_mfma_f32_16x16x32_bf16(Bt[n][k], At[m][k], acc[ai][bj][m][n], 0, 0, 0); __builtin_amdgcn_s_setprio(0); } while (0)
#define PG8_WAIT_V(n) asm volatile("s_waitcnt vmcnt(" #n ")" ::: "memory")
#define PG8_WAIT_L(n) asm volatile("s_waitcnt lgkmcnt(" #n ")" ::: "memory")
#define PG8_BAR __builtin_amdgcn_s_barrier()
#define PG8_SCHED __builtin_amdgcn_sched_barrier(0)
    Unit cur, nxt; int ui = 0;
    if (!S.next(0, cur)) return;
    f32x4 acc[2][2][4][2];
#pragma unroll
    for (int a = 0; a < 2; ++a)
#pragma unroll
        for (int b = 0; b < 2; ++b)
#pragma unroll
            for (int m = 0; m < 4; ++m)
#pragma unroll
                for (int n = 0; n < 2; ++n) acc[a][b][m][n] = (f32x4){0.f, 0.f, 0.f, 0.f};
    bf16x8 At[4][2], B0[2][2], B1[2][2];
    const char* cA = (const char*)g.A + (size_t)cur.pm * tstepA + (cur.pm >= 16 ? Epi::GAPA : 0); const char* cB = (const char*)g.Bt + (size_t)cur.pn * tstep;
    PG8_STAGE(PG8_SB(0, 0), cB, voffB); PG8_STAGE(PG8_SA(0, 0), cA, voffA); PG8_STAGE(PG8_SB(0, 1), cB + hstep, voffB); PG8_STAGE(PG8_SA(0, 1), cA + hstepA, voffA);
    if (wr == 1) PG8_BAR;
    PG8_WAIT_V(4); PG8_BAR;
    PG8_STAGE(PG8_SB(1, 0), cB + kstep, voffB); PG8_STAGE(PG8_SA(1, 0), cA + kstep, voffA); PG8_STAGE(PG8_SB(1, 1), cB + hstep + kstep, voffB);
    PG8_WAIT_V(6); PG8_BAR;
    for (;;) {
        const bool has_next = S.next(ui + 1, nxt);
        const char* nA = has_next ? (const char*)g.A + (size_t)nxt.pm * tstepA + (nxt.pm >= 16 ? Epi::GAPA : 0) : cA; const char* nB = has_next ? (const char*)g.Bt + (size_t)nxt.pn * tstep : cB;
        for (int t = 0; t < nt; t += 2) {
            const bool last = (t == nt - 2);
            const char* a1 = cA + (size_t)(t + 1) * kstep;
            const char* a2 = last ? nA : cA + (size_t)(t + 2) * kstep; const char* b2 = last ? nB : cB + (size_t)(t + 2) * kstep;
            const char* a3 = a2 + kstep; const char* b3 = b2 + kstep;
            PG8_LDB(B0, 0, 0); PG8_SCHED; PG8_LDA(At, 0, 0); PG8_STAGE(PG8_SA(1, 1), a1 + hstepA, voffA);
            PG8_WAIT_L(8); PG8_BAR; PG8_WAIT_L(0); PG8_MMA(0, 0, At, B0); PG8_BAR; PG8_SCHED;
            PG8_LDB(B1, 0, 1); PG8_STAGE(PG8_SB(0, 0), b2, voffB);
            PG8_BAR; PG8_WAIT_L(0); PG8_MMA(0, 1, At, B1); PG8_BAR;
            PG8_LDA(At, 0, 1); PG8_STAGE(PG8_SA(0, 0), a2, voffA);
            PG8_BAR; PG8_WAIT_L(0); PG8_MMA(1, 0, At, B0); PG8_BAR; PG8_SCHED;
            PG8_STAGE(PG8_SB(0, 1), b2 + hstep, voffB);
            PG8_WAIT_V(6); PG8_BAR; PG8_MMA(1, 1, At, B1); PG8_BAR;
            PG8_LDB(B0, 1, 0); PG8_SCHED; PG8_LDA(At, 1, 0); PG8_STAGE(PG8_SA(0, 1), a2 + hstepA, voffA);
            PG8_WAIT_L(8); PG8_BAR; PG8_WAIT_L(0); PG8_MMA(0, 0, At, B0); PG8_BAR; PG8_SCHED;
            PG8_LDB(B1, 1, 1); PG8_STAGE(PG8_SB(1, 0), b3, voffB);
            PG8_BAR; PG8_WAIT_L(0); PG8_MMA(0, 1, At, B1); PG8_BAR;
            PG8_LDA(At, 1, 1); PG8_STAGE(PG8_SA(1, 0), a3, voffA);
            PG8_BAR; PG8_WAIT_L(0); PG8_MMA(1, 0, At, B0); PG8_BAR; PG8_SCHED;
            PG8_STAGE(PG8_SB(1, 1), b3 + hstep, voffB);
            PG8_WAIT_V(6); PG8_BAR; PG8_MMA(1, 1, At, B1); PG8_BAR;
        }
        E(acc, cur, wr, wc, fr, fq);
        if (!has_next) break;
#pragma unroll
        for (int a = 0; a < 2; ++a)
#pragma unroll
            for (int b = 0; b < 2; ++b)
#pragma unroll
                for (int m = 0; m < 4; ++m)
#pragma unroll
                    for (int n = 0; n < 2; ++n) acc[a][b][m][n] = (f32x4){0.f, 0.f, 0.f, 0.f};
        cur = nxt; cA = nA; cB = nB; ++ui;
    }
    PG8_WAIT_V(0);
    if (wr == 0) PG8_BAR;
    PG8_BAR;
#undef PG8_SA
#undef PG8_SB
#undef PG8_STAGE
#undef PG8_LDA
#undef PG8_LDB
#undef PG8_MMA
#undef PG8_WAIT_V
#undef PG8_WAIT_L
#undef PG8_BAR
#undef PG8_SCHED
}
}

__device__ __forceinline__ void convert_tile(const float* __restrict__ W, int K, int N, bf16_t* __restrict__ Wt, int k0, int n0, int orow0, float* tile) {
    const int tid = tid_l();
    { const int r = tid >> 4, c4 = (tid & 15) * 4;
#pragma unroll
      for (int ps = 0; ps < 2; ++ps) { const int rr = r + ps * 32; const float4 v = *(const float4*)(W + (size_t)(k0 + rr) * N + n0 + c4);
          tile[rr * 65 + c4 + 0] = v.x; tile[rr * 65 + c4 + 1] = v.y; tile[rr * 65 + c4 + 2] = v.z; tile[rr * 65 + c4 + 3] = v.w; } }
    __syncthreads();
    { const int n = tid >> 3, k8 = (tid & 7) * 8; float v[8];
#pragma unroll
      for (int j = 0; j < 8; ++j) v[j] = tile[(k8 + j) * 65 + n];
      u32x4 w; w.x = cvt_pk_bf16(v[0], v[1]); w.y = cvt_pk_bf16(v[2], v[3]); w.z = cvt_pk_bf16(v[4], v[5]); w.w = cvt_pk_bf16(v[6], v[7]);
      *(u32x4*)(Wt + (size_t)(orow0 + n) * K + k0 + k8) = w; }
    __syncthreads();
}

constexpr int NI_IN = 32 * 68, NI_OUT = 32 * 32, NI_UP = 32 * 176, NI_DN = 88 * 32, NI_POOL = 16, NI_LAYER = NI_IN + NI_OUT + NI_UP + NI_DN + NI_POOL;
constexpr int NI_FILT = 256;
constexpr int NT3 = 1600;
constexpr int R_OUT = NI_IN, R_UP = NI_IN + NI_OUT, R_DN = NI_IN + NI_OUT + NI_UP, R_POOL = NI_IN + NI_OUT + NI_UP + NI_DN;
__device__ void convert_item(const Params& p, int l, int r, float* lds) {
    if (r < NI_IN) { const int tn = r / 32, tk = r % 32;
        convert_tile(inp(2) + (size_t)l * D_MODEL * D_INP, D_MODEL, D_INP, (bf16_t*)(p.ws + OFF_WT_IN + l * SZ_WT_IN), tk * 64, tn * 64, tn * 64, lds); return; }
    r -= NI_IN;
    if (r < NI_OUT) { const int tn = r / 32, tk = r % 32;
        convert_tile(inp(20) + (size_t)l * D_MODEL * D_MODEL, D_MODEL, D_MODEL, (bf16_t*)(p.ws + OFF_WT_OUT + l * SZ_WT_OUT), tk * 64, tn * 64, tn * 64, lds); return; }
    r -= NI_OUT;
    if (r < NI_UP) { const int tn = r / 32, tk = r % 32; const int n0 = tn * 64, s = n0 / D_FF, rem = n0 % D_FF, j = rem / 128, i = rem % 128;
        convert_tile(inp(22) + (size_t)l * D_MODEL * D_UP, D_MODEL, D_UP, (bf16_t*)(p.ws + OFF_WT_UP + l * SZ_WT_UP), tk * 64, n0, 256 * j + 128 * s + i, lds); return; }
    r -= NI_UP;
    if (r < NI_DN) { const int tn = r / 88, tk = r % 88;
        convert_tile(inp(25) + (size_t)l * D_FF * D_MODEL, D_FF, D_MODEL, (bf16_t*)(p.ws + OFF_WT_DN + l * SZ_WT_DN), tk * 64, tn * 64, tn * 64, lds); return; }
    r -= NI_DN;
    { const int g = r >> 2, tn = (r >> 1) & 1, tk = r & 1;
        convert_tile(inp(3) + (size_t)(l * 4 + g) * 128 * 128, 128, 128, (bf16_t*)(p.ws + OFF_POOLWT + l * SZ_POOLWT) + g * 128 * 128, tk * 64, tn * 64, tn * 64, lds); }
}

__device__ __forceinline__ float sin_rad(float x) { return __builtin_amdgcn_sinf(x * 0.15915494309f); }

struct CvDesc { const float* W; bf16_t* Wt; int K, N, k0, n0, orow0; };
__device__ __forceinline__ CvDesc cv_desc(const Params& p, int l, int r) {
    CvDesc d;
    if (r < R_OUT) { const int tn = r / 32, tk = r % 32; d.W = inp(2) + (size_t)l * D_MODEL * D_INP; d.Wt = (bf16_t*)(p.ws + OFF_WT_IN + l * SZ_WT_IN); d.K = D_MODEL; d.N = D_INP; d.k0 = tk * 64; d.n0 = tn * 64; d.orow0 = tn * 64; }
    else if (r < R_UP) { r -= R_OUT; const int tn = r / 32, tk = r % 32; d.W = inp(20) + (size_t)l * D_MODEL * D_MODEL; d.Wt = (bf16_t*)(p.ws + OFF_WT_OUT + l * SZ_WT_OUT); d.K = D_MODEL; d.N = D_MODEL; d.k0 = tk * 64; d.n0 = tn * 64; d.orow0 = tn * 64; }
    else if (r < R_DN) { r -= R_UP; const int tn = r / 32, tk = r % 32; const int n0 = tn * 64, sg = n0 / D_FF, rem = n0 % D_FF, j = rem / 128, i = rem % 128;
        d.W = inp(22) + (size_t)l * D_MODEL * D_UP; d.Wt = (bf16_t*)(p.ws + OFF_WT_UP + l * SZ_WT_UP); d.K = D_MODEL; d.N = D_UP; d.k0 = tk * 64; d.n0 = n0; d.orow0 = 256 * j + 128 * sg + i; }
    else if (r < R_POOL) { r -= R_DN; const int tn = r / 88, tk = r % 88; d.W = inp(25) + (size_t)l * D_FF * D_MODEL; d.Wt = (bf16_t*)(p.ws + OFF_WT_DN + l * SZ_WT_DN); d.K = D_FF; d.N = D_MODEL; d.k0 = tk * 64; d.n0 = tn * 64; d.orow0 = tn * 64; }
    else { r -= R_POOL; const int g = r >> 2, tn = (r >> 1) & 1, tk = r & 1; d.W = inp(3) + (size_t)(l * 4 + g) * 128 * 128; d.Wt = (bf16_t*)(p.ws + OFF_POOLWT + l * SZ_POOLWT) + g * 128 * 128; d.K = 128; d.N = 128; d.k0 = tk * 64; d.n0 = tn * 64; d.orow0 = tn * 64; }
    return d;
}
__device__ __forceinline__ CvDesc cv_pick(const Params& p, int mode, int l, int base, int i) {
    if (mode == 0) { if (i < R_DN) return cv_desc(p, 0, i); if (i < R_DN + NI_POOL) return cv_desc(p, 0, R_POOL + i - R_DN); return cv_desc(p, 1, R_POOL + i - R_DN - NI_POOL); }
    return cv_desc(p, l, base + i);
}
__device__ __forceinline__ void cv_load(const CvDesc& d, int tid, float4 (&v)[2]) {
    const int r = tid >> 4, c4 = (tid & 15) * 4;
#pragma unroll
    for (int ps = 0; ps < 2; ++ps) v[ps] = *(const float4*)(d.W + (size_t)(d.k0 + r + ps * 32) * d.N + d.n0 + c4);
}
__device__ void convert_range(const Params& p, int mode, int l, int base, int count, int start, int stride, float* tile) {
    int i = start; if (i >= count) return;
    const int tid = tid_l();
    CvDesc d = cv_pick(p, mode, l, base, i); float4 v[2]; cv_load(d, tid, v);
    for (;;) {
        { const int r = tid >> 4, c4 = (tid & 15) * 4;
#pragma unroll
          for (int ps = 0; ps < 2; ++ps) { float* tp = tile + (r + ps * 32) * 65 + c4; tp[0] = v[ps].x; tp[1] = v[ps].y; tp[2] = v[ps].z; tp[3] = v[ps].w; } }
        __syncthreads();
        const int ni = i + stride; const bool more = ni < count; CvDesc dn = d;
        if (more) { dn = cv_pick(p, mode, l, base, ni); cv_load(dn, tid, v); }
        { const int n = tid >> 3, k8 = (tid & 7) * 8; float u[8];
#pragma unroll
          for (int j = 0; j < 8; ++j) u[j] = tile[(k8 + j) * 65 + n];
          u32x4 w; w.x = cvt_pk_bf16(u[0], u[1]); w.y = cvt_pk_bf16(u[2], u[3]); w.z = cvt_pk_bf16(u[4], u[5]); w.w = cvt_pk_bf16(u[6], u[7]);
          *(u32x4*)(d.Wt + (size_t)(d.orow0 + n) * d.K + d.k0 + k8) = w; }
        __syncthreads();
        if (!more) break;
        d = dn; i = ni;
    }
}

__device__ void filter_item(const Params& p, int item, float* lds) {
    const int l = item >> 7, rem = item & 127, ti = rem >> 1, half = rem & 1;
    const int tid = tid_l(), lane = tid & 63, w = __builtin_amdgcn_readfirstlane(tid >> 6);
    const int t = ti * 64 + lane;
    const float* w1 = inp(8) + l * 33 * 64; const float* b1 = inp(9) + l * 64; const float* fr1 = inp(10) + l * 64;
    const float* w2 = inp(11) + l * 64 * 64; const float* b2 = inp(12) + l * 64; const float* fr2 = inp(13) + l * 64;
    const float* w3 = inp(14) + (size_t)l * 64 * 1536;
    float* h1s = lds; float* h2s = lds + 64 * 65;
    const float tt = (float)t / 4095.0f;
    float a[8];
#pragma unroll
    for (int j = 0; j < 8; ++j) a[j] = b1[8 * w + j] + tt * w1[8 * w + j];
    for (int band = 0; band < 16; ++band) {
        const float f = 1e-4f + (float)band * ((15.0f - 1e-4f) / 15.0f);
        float r = f * (float)t * (1.0f / 4096.0f); r -= floorf(r);
        const float cs = __builtin_amdgcn_cosf(r), sn = -__builtin_amdgcn_sinf(r);
#pragma unroll
        for (int j = 0; j < 8; ++j) a[j] += cs * w1[(1 + band) * 64 + 8 * w + j] + sn * w1[(17 + band) * 64 + 8 * w + j];
    }
#pragma unroll
    for (int j = 0; j < 8; ++j) h1s[lane * 65 + 8 * w + j] = sin_rad(fr1[8 * w + j] * a[j]);
    __syncthreads();
#pragma unroll
    for (int j = 0; j < 8; ++j) a[j] = b2[8 * w + j];
    for (int i = 0; i < 64; ++i) { const float h = h1s[lane * 65 + i];
#pragma unroll
        for (int j = 0; j < 8; ++j) a[j] += h * w2[i * 64 + 8 * w + j]; }
#pragma unroll
    for (int j = 0; j < 8; ++j) h2s[lane * 65 + 8 * w + j] = sin_rad(fr2[8 * w + j] * a[j]);
    __syncthreads();
    float* KT = (float*)(p.ws + OFF_ACT) + (size_t)l * 768 * 8192;
    const float d0 = -3.0701134573f, d1 = -15.3505672865f;
    typedef const __attribute__((address_space(4))) f32x4 cf4;
    for (int ci = 0; ci < 24; ++ci) {
        const int c = w * 96 + ci * 4;
        cf4* wc = (cf4*)(unsigned long long)(w3 + half * 768 + c);
        float o0 = 0.f, o1 = 0.f, o2 = 0.f, o3 = 0.f;
#pragma unroll 8
        for (int i = 0; i < 64; ++i) { const float h = h2s[lane * 65 + i]; const f32x4 wv = wc[i * 384]; o0 += h * wv[0]; o1 += h * wv[1]; o2 += h * wv[2]; o3 += h * wv[3]; }
        float o[4] = {o0, o1, o2, o3};
#pragma unroll
        for (int j = 0; j < 4; ++j) {
            const float delta = d0 + (float)(c + j) * ((d1 - d0) / 767.0f);
            const float val = o[j] * __expf(-tt * fabsf(delta));
            float* kt = KT + (size_t)(c + j) * 8192;
            if (half == 0) kt[t] = val; else { if (t == 0) kt[4096] = 0.f; else kt[8192 - t] = val; }
        }
    }
    __syncthreads();
}

__device__ __forceinline__ int phys(int i) { return i + (i >> 5); }
__device__ __forceinline__ float launder_f(float v) { asm volatile("" : "+v"(v)); return v; }
constexpr int FFT_BUF = 8192 + 256;
__device__ __forceinline__ constexpr float c32(int i) { constexpr float T[16] = {1.0f, 0.98078528040f, 0.92387953251f, 0.83146961230f, 0.70710678119f, 0.55557023302f, 0.38268343237f, 0.19509032202f, 0.0f, -0.19509032202f, -0.38268343237f, -0.55557023302f, -0.70710678119f, -0.83146961230f, -0.92387953251f, -0.98078528040f}; return T[i]; }
__device__ __forceinline__ constexpr float s32(int i) { constexpr float T[16] = {0.0f, 0.19509032202f, 0.38268343237f, 0.55557023302f, 0.70710678119f, 0.83146961230f, 0.92387953251f, 0.98078528040f, 1.0f, 0.98078528040f, 0.92387953251f, 0.83146961230f, 0.70710678119f, 0.55557023302f, 0.38268343237f, 0.19509032202f}; return T[i]; }
template <bool INV> __device__ __forceinline__ void radix16(float2 (&x)[16], float rfrac) {
#pragma unroll
    for (int jj = 0; jj < 4; ++jj) { const int j = INV ? 3 - jj : jj; const int half = 8 >> j;
        const float ab = rfrac * (float)(8 / half); const float cb = __builtin_amdgcn_cosf(ab), sb = __builtin_amdgcn_sinf(ab);
#pragma unroll
        for (int kk = 0; kk < half; ++kk) {
            const int idx = kk * (16 / half);
            float cs, sp;
            if (idx == 0) { cs = cb; sp = sb; }
            else if (idx == 8) { cs = -sb; sp = cb; }
            else { cs = cb * c32(idx) - sb * s32(idx); sp = cb * s32(idx) + sb * c32(idx); }
            const float sn = INV ? sp : -sp;
#pragma unroll
            for (int g = 0; g < 16; g += 2 * half) { const int i0 = g + kk, i1 = i0 + half; const float2 a = x[i0], b = x[i1];
                if (!INV) { const float dx = a.x - b.x, dy = a.y - b.y; x[i0] = make_float2(a.x + b.x, a.y + b.y); x[i1] = make_float2(dx * cs - dy * sn, dx * sn + dy * cs); }
                else { const float bx = b.x * cs - b.y * sn, by = b.x * sn + b.y * cs; x[i0] = make_float2(a.x + bx, a.y + by); x[i1] = make_float2(a.x - bx, a.y - by); } }
        }
    }
}
template <bool INV> __device__ __forceinline__ void radix32(float2 (&y)[32]) {
#pragma unroll
    for (int jj = 0; jj < 5; ++jj) { const int j = INV ? 4 - jj : jj; const int half = 16 >> j;
#pragma unroll
        for (int kk = 0; kk < half; ++kk) { const int idx = kk * (16 / half); const float cs = c32(idx), sn = INV ? s32(idx) : -s32(idx);
#pragma unroll
            for (int g = 0; g < 32; g += 2 * half) { const int i0 = g + kk, i1 = i0 + half; const float2 a = y[i0], b = y[i1];
                if (!INV) { const float dx = a.x - b.x, dy = a.y - b.y; y[i0] = make_float2(a.x + b.x, a.y + b.y);
                    if (idx == 0) y[i1] = make_float2(dx, dy);
                    else if (idx == 8) y[i1] = make_float2(dy, -dx);
                    else y[i1] = make_float2(dx * cs - dy * sn, dx * sn + dy * cs); }
                else { float bx, by;
                    if (idx == 0) { bx = b.x; by = b.y; }
                    else if (idx == 8) { bx = -b.y; by = b.x; }
                    else { bx = b.x * cs - b.y * sn; by = b.x * sn + b.y * cs; }
                    y[i0] = make_float2(a.x + bx, a.y + by); y[i1] = make_float2(a.x - bx, a.y - by); } }
        }
    }
}
template <bool INV> __device__ __forceinline__ void fft_pass2(float2* B, int tid, float rfr) {
    const int blk = tid >> 5, r = tid & 31; float2 x[16]; float2* b = B + blk * 528 + r;
#pragma unroll
    for (int k = 0; k < 16; ++k) x[k] = b[33 * k];
    radix16<INV>(x, rfr);
#pragma unroll
    for (int k = 0; k < 16; ++k) b[33 * k] = x[k];
}

__device__ void kf_item(const Params& p, int item, unsigned char* smem) {
    const int l = item / 384, cp = item % 384, c0 = 2 * cp;
    const int tid = tid_l();
    float2* B0 = (float2*)smem; float2* B1 = B0 + FFT_BUF;
    const float* KT = (const float*)(p.ws + OFF_ACT) + ((size_t)l * 768 + c0) * 8192 + tid;
    float2 x0[16], x1[16];
#pragma unroll
    for (int k = 0; k < 16; ++k) { x0[k] = make_float2(KT[512 * k], 0.f); x1[k] = make_float2(KT[8192 + 512 * k], 0.f); }
    const float rf = (float)tid * (1.0f / 8192.0f);
    radix16<false>(x0, rf); radix16<false>(x1, rf);
#pragma unroll
    for (int k = 0; k < 16; ++k) { B0[phys(tid + 512 * k)] = x0[k]; B1[phys(tid + 512 * k)] = x1[k]; }
    __syncthreads();
    { const float r2 = launder_f((float)(tid & 31) * (1.0f / 512.0f)); fft_pass2<false>(B0, tid, r2); fft_pass2<false>(B1, tid, r2); }
    __syncthreads();
    { const int blk = tid & 255, ch = tid >> 8; float2* B = ch ? B1 : B0; float2 y[32];
#pragma unroll
      for (int k = 0; k < 32; ++k) y[k] = B[blk * 33 + k];
      radix32<false>(y);
      float2* KF = (float2*)(p.ws + OFF_KF) + ((size_t)l * 768 + c0 + ch) * 8192 + blk * 2; const float sc = 1.0f / 8192.0f;
#pragma unroll
      for (int k = 0; k < 32; k += 2) *(float4*)(KF + (k >> 1) * 512) = make_float4(y[k].x * sc, y[k].y * sc, y[k + 1].x * sc, y[k + 1].y * sc); }
    __syncthreads();
}

__device__ void norm_phase(const float* __restrict__ x, const float* __restrict__ g, bf16_t* hb, float* hf) {
    const int tid = tid_l(); const int lane = tid & 63; const int gw = blockIdx.x * 8 + (tid >> 6), nw = gridDim.x * 8;
    for (int row = gw; row < NTOK; row += nw) {
        const float* xr = x + (size_t)row * D_MODEL;
        float4 v[8]; float ss = 0.f;
#pragma unroll
        for (int i = 0; i < 8; ++i) { v[i] = *(const float4*)(xr + i * 256 + lane * 4); ss += v[i].x * v[i].x + v[i].y * v[i].y + v[i].z * v[i].z + v[i].w * v[i].w; }
        ss = wave_sum(ss);
        const float rs = rsqrtf(ss * (1.0f / D_MODEL) + 1e-6f);
#pragma unroll
        for (int i = 0; i < 8; ++i) { const float4 gg = *(const float4*)(g + i * 256 + lane * 4);
            const float y0 = v[i].x * rs * gg.x, y1 = v[i].y * rs * gg.y, y2 = v[i].z * rs * gg.z, y3 = v[i].w * rs * gg.w;
            if (hb) { u32x2 w; w.x = cvt_pk_bf16(y0, y1); w.y = cvt_pk_bf16(y2, y3); *(u32x2*)(hb + (size_t)(row + 1 + (row >> 12)) * D_MODEL + i * 256 + lane * 4) = w; }
            else { *(float4*)(hf + (size_t)row * D_MODEL + i * 256 + lane * 4) = make_float4(y0, y1, y2, y3); } }
    }
}

__device__ void pool_item(const Params& p, int l, int item, unsigned char* smem) {
    const int tt = item >> 2, g = item & 3;
    const int tid = tid_l(), lane = tid & 63, w = tid >> 6, fr = lane & 15, fq = lane >> 4;
    const bf16_t* P = (const bf16_t*)(p.ws + OFF_P); bf16_t* MIX = (bf16_t*)(p.ws + OFF_MIX);
    const int row0 = tt * 128, b0 = (row0 / SEQ) * SEQ;
    float* X = (float*)smem;
    bf16_t* A = (bf16_t*)(smem + 144 * 129 * 4);
    for (int idx = tid; idx < 144 * 16; idx += 512) { const int r = idx >> 4, c8 = (idx & 15) * 8; const int row = row0 - 8 + r;
        u32x4 v = (u32x4){0u, 0u, 0u, 0u};
        if (row >= b0 && row < b0 + SEQ) v = *(const u32x4*)(P + (size_t)row * D_INP + g * 128 + c8);
        float* xp = X + r * 129 + c8;
        xp[0] = lo_bf(v.x); xp[1] = hi_bf(v.x); xp[2] = lo_bf(v.y); xp[3] = hi_bf(v.y); xp[4] = lo_bf(v.z); xp[5] = hi_bf(v.z); xp[6] = lo_bf(v.w); xp[7] = hi_bf(v.w); }
    __syncthreads();
    { const int c = tid & 127, tq = tid >> 7; const int hw = 1 << g;
      const float* xc = X + (tq * 32 + 8) * 129 + c;
      float s = 0.f;
      for (int q = -hw; q < hw; ++q) s += xc[q * 129];
      const int tb = row0 + tq * 32 - b0;
#pragma unroll 8
      for (int i = 0; i < 32; ++i) { const int t = tb + i; const int lo = max(t - hw, 0), hi = min(t + hw - 1, SEQ - 1);
          const float d = s * __builtin_amdgcn_rcpf((float)(hi - lo + 1)) - xc[i * 129];
          A[(tq * 32 + i) * 136 + c] = (bf16_t)(cvt_pk_bf16(d, 0.f) & 0xffffu);
          s += xc[(i + hw) * 129] - xc[(i - hw) * 129]; } }
    __syncthreads();
    const bf16_t* Wt = (const bf16_t*)(p.ws + OFF_POOLWT + l * SZ_POOLWT) + g * 128 * 128;
    f32x4 acc[8];
#pragma unroll
    for (int nb = 0; nb < 8; ++nb) acc[nb] = (f32x4){0.f, 0.f, 0.f, 0.f};
#pragma unroll
    for (int ks = 0; ks < 4; ++ks) {
        const bf16x8 af = *(const bf16x8*)(A + (16 * w + fr) * 136 + ks * 32 + fq * 8);
#pragma unroll
        for (int nb = 0; nb < 8; ++nb) { const bf16x8 bfr = *(const bf16x8*)(Wt + (nb * 16 + fr) * 128 + ks * 32 + fq * 8);
            acc[nb] = __builtin_amdgcn_mfma_f32_16x16x32_bf16(bfr, af, acc[nb], 0, 0, 0); }
    }
    const float* pb = inp(4) + l * 512 + g * 128; const float* psc = inp(5) + l * 512 + g * 128;
    const int row = row0 + 16 * w + fr;
#pragma unroll
    for (int nb = 0; nb < 8; ++nb) { const int d = nb * 16 + 4 * fq; const float4 bb = *(const float4*)(pb + d), sc = *(const float4*)(psc + d);
        u32x2 o; o.x = cvt_pk_bf16((acc[nb][0] + bb.x) * sc.x, (acc[nb][1] + bb.y) * sc.y); o.y = cvt_pk_bf16((acc[nb][2] + bb.z) * sc.z, (acc[nb][3] + bb.w) * sc.w);
        *(u32x2*)(MIX + (size_t)row * D_MODEL + g * 128 + d) = o; }
    __syncthreads();
}

__device__ void hypre_item(const Params& p, int l, int item, unsigned char* smem) {
    const int tt = item / 6, ct = item % 6; const int tid = tid_l();
    const bf16_t* P = (const bf16_t*)(p.ws + OFF_P); float* ZT = (float*)(p.ws + OFF_ZT); float* X0T = (float*)(p.ws + OFF_X0T);
    const float* sw = inp(6) + (size_t)l * 3 * 2304; const float* sb = inp(7) + (size_t)l * 2304;
    float* zt = (float*)smem;
    float* xt = zt + 128 * 65;
    const int row0 = tt * 64;
    { const int cpq = tid & 63, tr = tid >> 6; const int ch = ct * 128 + 2 * cpq;
      float w[3][3][2], bb[3][2];
#pragma unroll
      for (int s3 = 0; s3 < 3; ++s3) {
#pragma unroll
          for (int k = 0; k < 3; ++k) { const float2 v = *(const float2*)(sw + k * 2304 + s3 * 768 + ch); w[s3][k][0] = v.x; w[s3][k][1] = v.y; }
          const float2 v = *(const float2*)(sb + s3 * 768 + ch); bb[s3][0] = v.x; bb[s3][1] = v.y; }
      const int r0 = row0 + tr * 8; const bf16_t* pr = P + (size_t)r0 * D_INP + COL_HY + ch;
      unsigned pm[3], pc[3], pn[3];
#pragma unroll
      for (int s3 = 0; s3 < 3; ++s3) { pm[s3] = ((r0 & (SEQ - 1)) != 0) ? *(const unsigned*)(pr - D_INP + s3 * 768) : 0u; pc[s3] = *(const unsigned*)(pr + s3 * 768); }
#pragma unroll
      for (int i = 0; i < 8; ++i) { const int row = r0 + i;
#pragma unroll
          for (int s3 = 0; s3 < 3; ++s3) pn[s3] = ((row & (SEQ - 1)) != SEQ - 1) ? *(const unsigned*)(pr + (size_t)(i + 1) * D_INP + s3 * 768) : 0u;
          float o[3][2];
#pragma unroll
          for (int s3 = 0; s3 < 3; ++s3) { o[s3][0] = w[s3][0][0] * lo_bf(pm[s3]) + w[s3][1][0] * lo_bf(pc[s3]) + w[s3][2][0] * lo_bf(pn[s3]) + bb[s3][0];
                                           o[s3][1] = w[s3][0][1] * hi_bf(pm[s3]) + w[s3][1][1] * hi_bf(pc[s3]) + w[s3][2][1] * hi_bf(pn[s3]) + bb[s3][1]; }
          const int tl = tr * 8 + i;
          zt[(2 * cpq) * 65 + tl] = o[1][0] * o[2][0]; zt[(2 * cpq + 1) * 65 + tl] = o[1][1] * o[2][1];
          xt[(2 * cpq) * 65 + tl] = o[0][0]; xt[(2 * cpq + 1) * 65 + tl] = o[0][1];
#pragma unroll
          for (int s3 = 0; s3 < 3; ++s3) { pm[s3] = pc[s3]; pc[s3] = pn[s3]; } } }
    __syncthreads();
    { const int tl = tid & 63, cr = tid >> 6; const int row = row0 + tl, b = row >> 12, t = row & (SEQ - 1);
#pragma unroll
      for (int i = 0; i < 16; ++i) { const int c = cr * 16 + i; const size_t o = (size_t)(ct * 128 + c) * 8192 + b * 4096 + t; ZT[o] = zt[c * 65 + tl]; X0T[o] = xt[c * 65 + tl]; } }
    __syncthreads();
}

constexpr int GM_NH = 3;
__device__ void gmlp_item(const Params& p, int l, int item, unsigned char* smem) {
    const int n = item / (6 / GM_NH), e0 = (item % (6 / GM_NH)) * GM_NH;
    const int tid = tid_l(), lane = tid & 63, w = tid >> 6, fr = lane & 15, fq = lane >> 4;
    const bf16_t* P = (const bf16_t*)(p.ws + OFF_P); bf16_t* MIX = (bf16_t*)(p.ws + OFF_MIX);
    const float* stats = (const float*)(p.ws + OFF_STATS) + (size_t)l * NTOK * 2;
    const float* lng = inp(16) + l * 768; const float* lnb = inp(17) + l * 768;
    bf16_t* VT = (bf16_t*)smem;
    const int t0 = n * 128;
    const int q = 16 * w + fr; const size_t qrow = (size_t)(t0 + q);
    float g0[GM_NH], g1[GM_NH], be0[GM_NH], be1[GM_NH], bq[GM_NH]; u32x2 uu[GM_NH][8]; bf16x8 wf[GM_NH][4];
#pragma unroll
    for (int h = 0; h < GM_NH; ++h) { const int e = e0 + h;
        g0[h] = lng[e * 128 + lane]; g1[h] = lng[e * 128 + 64 + lane]; be0[h] = lnb[e * 128 + lane]; be1[h] = lnb[e * 128 + 64 + lane];
        bq[h] = (inp(19) + (l * 6 + e) * 128)[q];
#pragma unroll
        for (int cb = 0; cb < 8; ++cb) uu[h][cb] = *(const u32x2*)(P + qrow * D_INP + COL_GM + e * 128 + cb * 16 + 4 * fq);
        const float* ws_ = inp(18) + (size_t)(l * 6 + e) * 128 * 128;
#pragma unroll
        for (int ks = 0; ks < 4; ++ks) { const float* wp = ws_ + (16 * w + fr) * 128 + ks * 32 + fq * 8; const float4 a = *(const float4*)wp, b = *(const float4*)(wp + 4);
            u32x4 t; t.x = cvt_pk_bf16(a.x, a.y); t.y = cvt_pk_bf16(a.z, a.w); t.z = cvt_pk_bf16(b.x, b.y); t.w = cvt_pk_bf16(b.z, b.w); wf[h][ks] = __builtin_bit_cast(bf16x8, t); } }
#pragma unroll
    for (int i = 0; i < 16; ++i) { const int pl = 16 * w + i; const size_t row = (size_t)(t0 + pl); const bf16_t* pr = P + row * D_INP + COL_GM + 768 + e0 * 128;
        const float2 st = *(const float2*)(stats + 2 * row);
        const float mean = st.x * (1.0f / 768.0f); const float rstd = rsqrtf(fmaxf(st.y * (1.0f / 768.0f) - mean * mean, 0.f) + 1e-5f);
#pragma unroll
        for (int h = 0; h < GM_NH; ++h) {
            const float y0 = (bf2f(pr[h * 128 + lane]) - mean) * rstd * g0[h] + be0[h], y1 = (bf2f(pr[h * 128 + 64 + lane]) - mean) * rstd * g1[h] + be1[h];
            const unsigned pk = cvt_pk_bf16(y0, y1);
            VT[(h * 128 + lane) * 132 + pl] = (bf16_t)(pk & 0xffffu); VT[(h * 128 + 64 + lane) * 132 + pl] = (bf16_t)(pk >> 16); } }
    __syncthreads();
#pragma unroll
    for (int h = 0; h < GM_NH; ++h) { const int e = e0 + h;
        f32x4 acc[8];
#pragma unroll
        for (int cb = 0; cb < 8; ++cb) acc[cb] = (f32x4){0.f, 0.f, 0.f, 0.f};
#pragma unroll
        for (int ks = 0; ks < 4; ++ks)
#pragma unroll
            for (int cb = 0; cb < 8; ++cb) { const bf16_t* vp = VT + (h * 128 + cb * 16 + fr) * 132 + ks * 32 + fq * 8; const u32x2 lo = *(const u32x2*)vp, hi = *(const u32x2*)(vp + 4);
                u32x4 t; t.x = lo.x; t.y = lo.y; t.z = hi.x; t.w = hi.y;
                acc[cb] = __builtin_amdgcn_mfma_f32_16x16x32_bf16(__builtin_bit_cast(bf16x8, t), wf[h][ks], acc[cb], 0, 0, 0); }
#pragma unroll
        for (int cb = 0; cb < 8; ++cb) { const int c = cb * 16 + 4 * fq;
            const float u0 = lo_bf(uu[h][cb].x), u1 = hi_bf(uu[h][cb].x), u2 = lo_bf(uu[h][cb].y), u3 = hi_bf(uu[h][cb].y);
            u32x2 o; o.x = cvt_pk_bf16(u0 * (acc[cb][0] + bq[h]), u1 * (acc[cb][1] + bq[h])); o.y = cvt_pk_bf16(u2 * (acc[cb][2] + bq[h]), u3 * (acc[cb][3] + bq[h]));
            *(u32x2*)(MIX + qrow * D_MODEL + MIX_GM + e * 128 + c) = o; } }
    __syncthreads();
}

__device__ void fft_item(const Params& p, int l, int cp, unsigned char* smem) {
    const int tid = tid_l(); const int c0 = 2 * cp;
    float2* B0 = (float2*)smem;
    const float* ZT = (const float*)(p.ws + OFF_ZT) + (size_t)c0 * 8192; const float* X0T = (const float*)(p.ws + OFF_X0T) + (size_t)c0 * 8192;
    const float rf = (float)tid * (1.0f / 8192.0f);
#pragma unroll
    for (int ch = 0; ch < 2; ++ch) { float2 x[16]; float2* B = B0 + ch * FFT_BUF; const float* z = ZT + ch * 8192 + tid;
#pragma unroll
        for (int k = 0; k < 8; ++k) { x[k] = make_float2(z[512 * k], z[4096 + 512 * k]); x[k + 8] = make_float2(0.f, 0.f); }
        radix16<false>(x, rf);
#pragma unroll
        for (int k = 0; k < 16; ++k) B[phys(tid + 512 * k)] = x[k]; }
    __syncthreads();
    { const float r2 = launder_f((float)(tid & 31) * (1.0f / 512.0f));
#pragma unroll
      for (int ch = 0; ch < 2; ++ch) fft_pass2<false>(B0 + ch * FFT_BUF, tid, r2); }
    __syncthreads();
    { const int blk = tid & 255, ch = tid >> 8; float2* B = B0 + ch * FFT_BUF + blk * 33; float2 y[32];
#pragma unroll
      for (int k = 0; k < 32; ++k) y[k] = B[k];
      radix32<false>(y);
      const float2* KF = (const float2*)(p.ws + OFF_KF) + ((size_t)l * 768 + c0 + ch) * 8192 + blk * 2;
#pragma unroll
      for (int k = 0; k < 32; k += 2) { const float4 kq = *(const float4*)(KF + (k >> 1) * 512);
          y[k] = make_float2(y[k].x * kq.x - y[k].y * kq.y, y[k].x * kq.y + y[k].y * kq.x); y[k + 1] = make_float2(y[k + 1].x * kq.z - y[k + 1].y * kq.w, y[k + 1].x * kq.w + y[k + 1].y * kq.z); }
      radix32<true>(y);
#pragma unroll
      for (int k = 0; k < 32; ++k) B[k] = y[k]; }
    __syncthreads();
    { const float r2 = launder_f((float)(tid & 31) * (1.0f / 512.0f));
#pragma unroll
      for (int ch = 0; ch < 2; ++ch) fft_pass2<true>(B0 + ch * FFT_BUF, tid, r2); }
    __syncthreads();
    bf16_t* MIX = (bf16_t*)(p.ws + OFF_MIX);
    const float2 dsk = *(const float2*)(inp(15) + l * 768 + c0);
    const float rfi = launder_f(rf);
    { unsigned long long zp = (unsigned long long)ZT; asm volatile("" : "+s"(zp)); ZT = (const float*)zp; }
#pragma unroll 1
    for (int ch = 0; ch < 2; ++ch) { float2 x[16]; float2* B = B0 + ch * FFT_BUF;
#pragma unroll
        for (int k = 0; k < 16; ++k) x[k] = B[phys(tid + 512 * k)];
        radix16<true>(x, rfi);
        const float d = ch ? dsk.y : dsk.x; const float* z = ZT + ch * 8192 + tid; const float* x0 = X0T + ch * 8192 + tid;
        if (ch == 0) {
#pragma unroll
            for (int k = 0; k < 8; ++k) B0[phys(tid + 512 * k)] = make_float2(x0[512 * k] * (x[k].x + d * z[512 * k]), x0[4096 + 512 * k] * (x[k].y + d * z[4096 + 512 * k]));
        } else {
#pragma unroll
            for (int k = 0; k < 8; ++k) { const int t = tid + 512 * k; const float2 r0 = B0[phys(t)];
                const float r1a = x0[512 * k] * (x[k].x + d * z[512 * k]), r1b = x0[4096 + 512 * k] * (x[k].y + d * z[4096 + 512 * k]);
                *(unsigned*)(MIX + (size_t)t * D_MODEL + MIX_HY + c0) = cvt_pk_bf16(r0.x, r1a);
                *(unsigned*)(MIX + (size_t)(4096 + t) * D_MODEL + MIX_HY + c0) = cvt_pk_bf16(r0.y, r1b); }
        } }
    __syncthreads();
}

__device__ void convact_phase(const Params& p, int l) {
    const bf16_t* UP = (const bf16_t*)(p.ws + OFF_UP); bf16_t* ACT = (bf16_t*)(p.ws + OFF_ACT);
    const float* cw = inp(23) + (size_t)l * 3 * D_UP; const float* cb = inp(24) + (size_t)l * D_UP;
    const int nthr = gridDim.x * 512;
    const int tid = tid_l();
    for (int idx = blockIdx.x * 512 + tid; idx < 704 * 512; idx += nthr) {
        const int cg8 = idx % 704, run = idx / 704; const int j = cg8 >> 4, i8 = (cg8 & 15) * 8;
        const int ncol = j * 128 + i8;
        float wg[3][8], wv[3][8], bg[8], bv[8];
#pragma unroll
        for (int k = 0; k < 3; ++k) { const float4 a = *(const float4*)(cw + k * D_UP + ncol), b = *(const float4*)(cw + k * D_UP + ncol + 4);
            wg[k][0] = a.x; wg[k][1] = a.y; wg[k][2] = a.z; wg[k][3] = a.w; wg[k][4] = b.x; wg[k][5] = b.y; wg[k][6] = b.z; wg[k][7] = b.w;
            const float4 c = *(const float4*)(cw + k * D_UP + D_FF + ncol), d = *(const float4*)(cw + k * D_UP + D_FF + ncol + 4);
            wv[k][0] = c.x; wv[k][1] = c.y; wv[k][2] = c.z; wv[k][3] = c.w; wv[k][4] = d.x; wv[k][5] = d.y; wv[k][6] = d.z; wv[k][7] = d.w; }
        { const float4 a = *(const float4*)(cb + ncol), b = *(const float4*)(cb + ncol + 4); bg[0] = a.x; bg[1] = a.y; bg[2] = a.z; bg[3] = a.w; bg[4] = b.x; bg[5] = b.y; bg[6] = b.z; bg[7] = b.w;
          const float4 c = *(const float4*)(cb + D_FF + ncol), d = *(const float4*)(cb + D_FF + ncol + 4); bv[0] = c.x; bv[1] = c.y; bv[2] = c.z; bv[3] = c.w; bv[4] = d.x; bv[5] = d.y; bv[6] = d.z; bv[7] = d.w; }
        const int r0 = run * 16; const size_t colg = (size_t)j * 256 + i8, colv = colg + 128;
        u32x4 gm = (u32x4){0u, 0u, 0u, 0u}, vm = gm, gc, vc, gn, vn;
        if ((r0 & (SEQ - 1)) != 0) { gm = *(const u32x4*)(UP + (size_t)(r0 - 1) * D_UP + colg); vm = *(const u32x4*)(UP + (size_t)(r0 - 1) * D_UP + colv); }
        gc = *(const u32x4*)(UP + (size_t)r0 * D_UP + colg); vc = *(const u32x4*)(UP + (size_t)r0 * D_UP + colv);
        for (int r = r0; r < r0 + 16; ++r) {
            if ((r & (SEQ - 1)) != SEQ - 1) { gn = *(const u32x4*)(UP + (size_t)(r + 1) * D_UP + colg); vn = *(const u32x4*)(UP + (size_t)(r + 1) * D_UP + colv); }
            else { gn = (u32x4){0u, 0u, 0u, 0u}; vn = gn; }
            float o[8];
#pragma unroll
            for (int q = 0; q < 4; ++q) {
                const float ga = wg[0][2 * q] * lo_bf(gm[q]) + wg[1][2 * q] * lo_bf(gc[q]) + wg[2][2 * q] * lo_bf(gn[q]) + bg[2 * q];
                const float gb = wg[0][2 * q + 1] * hi_bf(gm[q]) + wg[1][2 * q + 1] * hi_bf(gc[q]) + wg[2][2 * q + 1] * hi_bf(gn[q]) + bg[2 * q + 1];
                const float va = wv[0][2 * q] * lo_bf(vm[q]) + wv[1][2 * q] * lo_bf(vc[q]) + wv[2][2 * q] * lo_bf(vn[q]) + bv[2 * q];
                const float vb = wv[0][2 * q + 1] * hi_bf(vm[q]) + wv[1][2 * q + 1] * hi_bf(vc[q]) + wv[2][2 * q + 1] * hi_bf(vn[q]) + bv[2 * q + 1];
                o[2 * q] = silu(ga) * va; o[2 * q + 1] = silu(gb) * vb; }
            u32x4 ow; ow.x = cvt_pk_bf16(o[0], o[1]); ow.y = cvt_pk_bf16(o[2], o[3]); ow.z = cvt_pk_bf16(o[4], o[5]); ow.w = cvt_pk_bf16(o[6], o[7]);
            *(u32x4*)(ACT + (size_t)r * D_FF + ncol) = ow;
            gm = gc; vm = vc; gc = gn; vc = vn;
        }
    }
}

__global__ void __launch_bounds__(512, 2) fwd_megakernel(Params p) {
    extern __shared__ __attribute__((aligned(16))) unsigned char smem[];
    cg::grid_group grid = cg::this_grid();
    const int G = gridDim.x, bid = blockIdx.x;
    int step = 0;
    if (p.ph_hi < 0) grid.sync();
    volatile LAS unsigned* xst = (volatile LAS unsigned*)(LAS unsigned char*)(smem + LDS_BYTES - 16);
    if (threadIdx.x < 4) xst[threadIdx.x] = 0u;
    __syncthreads();
    XcdBarrier xb = xcd_barrier_post((unsigned*)(p.ws + OFF_BAR), xst);
#define STEP_BEGIN if (step >= p.ph_lo && step < p.ph_hi) {
#define STEP_END } ++step; if (step > p.ph_lo && step < p.ph_hi) xcd_barrier(xb);

    bf16_t* H = (bf16_t*)(p.ws + OFF_H);
    float* XA = (float*)(p.ws + OFF_XA);
#if PROBE == 6
    for (int i = 0; i < 20; ++i) xcd_barrier(xb);
#endif

    STEP_BEGIN
        for (int it = bid; it < NI_FILT; it += G) filter_item(p, it, (float*)smem);
        convert_range(p, 0, 0, 0, R_DN + 2 * NI_POOL, bid, G, (float*)smem);
        { float* st = (float*)(p.ws + OFF_STATS); for (int i = bid * 512 + tid_l(); i < 2 * NTOK * 2; i += G * 512) st[i] = 0.f; }
        if (bid < 3) { const int zr = bid == 0 ? 0 : (bid == 1 ? 4097 : 8194); for (int i = tid_l(); i < D_MODEL / 2; i += 512) ((unsigned*)(H + (size_t)zr * D_MODEL))[i] = 0u; }
        norm_phase(inp(0), inp(1), H, nullptr);
    STEP_END

    for (int l = 0; l < 2; ++l) {
        STEP_BEGIN
            pg8::Gemm g{H + D_MODEL, (const bf16_t*)(p.ws + OFF_WT_IN + l * SZ_WT_IN), NTOK, D_INP, D_MODEL}; pg8::StaticOrder S; S.init(NTOK, D_INP, G, bid);
            pg8::EpiBf16Gm E{(bf16_t*)(p.ws + OFF_P), D_INP, (float*)(p.ws + OFF_STATS) + (size_t)l * NTOK * 2};
            pg8::gemm_phase<pg8::EpiBf16Gm, pg8::StaticOrder, D_MODEL>((LAS unsigned char*)smem, g, S, E);
            { const int rem = (NTOK / 256) * (D_INP / 256) % G;
              if (bid >= rem) for (int rep_ = 0; rep_ < (PROBE == 11 ? 2 : 1); ++rep_) {
                  if (l == 0) { for (int it = bid - rem; it < 768; it += G - rem) kf_item(p, it, smem); convert_range(p, 1, 1, 0, NI_IN, bid - rem, G - rem, (float*)smem); convert_range(p, 1, 0, R_DN + NT3, NI_DN - NT3, bid - rem, G - rem, (float*)smem); }
                  else { convert_range(p, 1, 1, R_OUT, NI_OUT + NI_UP, bid - rem, G - rem, (float*)smem); convert_range(p, 1, 1, R_DN + NT3, NI_DN - NT3, bid - rem, G - rem, (float*)smem); } } }
        STEP_END
        STEP_BEGIN
            for (int it = bid; it < 768; it += G) hypre_item(p, l, it, smem);
        STEP_END
        STEP_BEGIN
            for (int rep_ = 0; rep_ < (PROBE == 13 ? 2 : 1); ++rep_) {
            for (int it = bid; it < 256; it += G) fft_item(p, l, (it & 7) * 48 + (it >> 3), smem);
            unsigned* wq = (unsigned*)(p.ws + OFF_BAR) + 3500 + l + 8 * rep_;
            for (;;) {
                __syncthreads();
                if (threadIdx.x == 0) xst[2] = atomicAdd(wq, 1u);
                __syncthreads();
                const int it = __builtin_amdgcn_readfirstlane((int)xst[2]);
                if (it >= 128 + 128 + 256) break;
                if (it < 128) fft_item(p, l, (it & 7) * 48 + 32 + (it >> 3), smem); else if (it < 256) gmlp_item(p, l, it - 128, smem); else pool_item(p, l, it - 256, smem);
            }
            }
#if PROBE == 21
            for (int it = bid; it < 256; it += G) pool_item(p, l, it, smem);
#elif PROBE == 22
            for (int it = bid; it < 128; it += G) gmlp_item(p, l, it, smem);
#elif PROBE == 3
            for (int it = bid; it < 384; it += G) fft_item(p, l, it, smem);
#endif
        STEP_END
        STEP_BEGIN
            pg8::Gemm g{(const bf16_t*)(p.ws + OFF_MIX), (const bf16_t*)(p.ws + OFF_WT_OUT + l * SZ_WT_OUT), NTOK, D_MODEL, D_MODEL}; pg8::StaticOrder S; S.init(NTOK, D_MODEL, G, bid);
            pg8::EpiRes E{XA, l == 0 ? inp(0) : XA, D_MODEL};
            pg8::gemm_phase<pg8::EpiRes, pg8::StaticOrder, D_MODEL>((LAS unsigned char*)smem, g, S, E);
        STEP_END
        STEP_BEGIN
            REP(5) norm_phase(XA, inp(21) + l * D_MODEL, H, nullptr);
        STEP_END
        STEP_BEGIN
            pg8::Gemm g{H, (const bf16_t*)(p.ws + OFF_WT_UP + l * SZ_WT_UP), NTOK, D_UP, D_MODEL}; pg8::StaticOrder S; S.init_tiles(34, D_UP / 256, G, bid);
            pg8::EpiConvAct E{(bf16_t*)(p.ws + OFF_ACT), inp(23) + (size_t)l * 3 * D_UP, inp(24) + (size_t)l * D_UP};
            pg8::gemm_phase<pg8::EpiConvAct, pg8::StaticOrder, D_MODEL>((LAS unsigned char*)smem, g, S, E);
#if PROBE == 7
            pg8::gemm_phase<pg8::EpiConvAct, pg8::StaticOrder, D_MODEL>((LAS unsigned char*)smem, g, S, E);
#endif
            { const int rem = (34 * (D_UP / 256)) % G; if (bid >= rem) convert_range(p, 1, l, R_DN, NT3, bid - rem, G - rem, (float*)smem); }
        STEP_END
        STEP_BEGIN
            pg8::Gemm g{(const bf16_t*)(p.ws + OFF_ACT), (const bf16_t*)(p.ws + OFF_WT_DN + l * SZ_WT_DN), NTOK, D_MODEL, D_FF}; pg8::StaticOrder S; S.init(NTOK, D_MODEL, G, bid);
            pg8::EpiRes E{XA, XA, D_MODEL};
            pg8::gemm_phase<pg8::EpiRes, pg8::StaticOrder, D_FF>((LAS unsigned char*)smem, g, S, E);
        STEP_END
        STEP_BEGIN
            if (l == 0) norm_phase(XA, inp(1) + D_MODEL, H, nullptr); else norm_phase(XA, inp(26), nullptr, p.out);
        STEP_END
    }
}

constexpr int N_STEPS = 17;
#ifndef MULTI_LAUNCH
#define MULTI_LAUNCH 0
#endif

extern "C" void kernel_launch(void* const* d_in, const int* in_sizes, int n_in, void* d_out, int out_size, void* d_ws, size_t ws_size, hipStream_t stream) {
    static int grid = 0;
    if (grid == 0) {
        if (n_in != 27 || ws_size < WS_END) { fprintf(stderr, "kernel_launch: need 27 inputs and %zu bytes of workspace (got %d, %zu)\n", (size_t)WS_END, n_in, ws_size); grid = -1; return; }
        int dev = 0, cus = 0, per_cu = 0;
        hipGetDevice(&dev); hipDeviceGetAttribute(&cus, hipDeviceAttributeMultiprocessorCount, dev);
        if (hipFuncSetAttribute((const void*)fwd_megakernel, hipFuncAttributeMaxDynamicSharedMemorySize, LDS_BYTES) != hipSuccess) { fprintf(stderr, "kernel_launch: hipFuncSetAttribute failed\n"); grid = -1; return; }
        if (hipOccupancyMaxActiveBlocksPerMultiprocessor(&per_cu, (const void*)fwd_megakernel, 512, LDS_BYTES) != hipSuccess || per_cu < 1) { fprintf(stderr, "kernel_launch: occupancy query gave %d\n", per_cu); per_cu = 1; }
        (void)hipGetLastError();
        grid = cus * 1;
    }
    if (grid < 0) return;
    if (hipMemsetAsync((char*)d_ws + OFF_BAR, 0, 16384, stream) != hipSuccess) { fprintf(stderr, "kernel_launch: memset failed\n"); return; }
    Params p{};
    for (int i = 0; i < 27; ++i) p.in[i] = (const float*)d_in[i];
    p.out = (float*)d_out; p.ws = (unsigned char*)d_ws;
#if MULTI_LAUNCH
    for (int s = 0; s < N_STEPS; ++s) { p.ph_lo = s; p.ph_hi = s + 1; hipLaunchKernelGGL(fwd_megakernel, dim3(grid), dim3(512), LDS_BYTES, stream, p); }
#else
    p.ph_lo = 0; p.ph_hi = N_STEPS;
    void* args[] = {&p};
    hipError_t e = hipLaunchCooperativeKernel((const void*)fwd_megakernel, dim3(grid), dim3(512), args, LDS_BYTES, stream);
    if (e != hipSuccess) fprintf(stderr, "cooperative launch failed: %s (grid %d)\n", hipGetErrorString(e), grid);
#endif
}
```

```cpp
#include <hip/hip_runtime.h>
#include <hip/hip_cooperative_groups.h>
#include <cstdio>
namespace cg = cooperative_groups;

#define LAS __attribute__((address_space(3)))
typedef unsigned short bf16_t;
typedef short bf16x8 __attribute__((ext_vector_type(8)));
typedef float f32x4 __attribute__((ext_vector_type(4)));
typedef unsigned u32x4 __attribute__((ext_vector_type(4)));
typedef unsigned u32x2 __attribute__((ext_vector_type(2)));

constexpr int D_MODEL = 2048, SEQ = 4096, NTOK = 8192, D_INP = 4352, D_FF = 5632, D_UP = 11264;
constexpr int D_HY = 768, D_GM = 768;
constexpr int COL_HY = 512, COL_GM = 2816;
constexpr int MIX_HY = 512, MIX_GM = 1280;

constexpr size_t SZ_WT_IN = (size_t)D_INP * D_MODEL * 2, SZ_WT_OUT = (size_t)D_MODEL * D_MODEL * 2, SZ_WT_UP = (size_t)D_UP * D_MODEL * 2, SZ_WT_DN = (size_t)D_MODEL * D_FF * 2;
constexpr size_t SZ_POOLWT = 4 * 128 * 128 * 2, SZ_KF = (size_t)768 * 8192 * 8, SZ_H2 = (size_t)4096 * 64 * 4, SZ_STATS = (size_t)NTOK * 12 * 2 * 4;
constexpr size_t OFF_WT_IN = 0;
constexpr size_t OFF_WT_OUT = OFF_WT_IN + 2 * SZ_WT_IN;
constexpr size_t OFF_WT_UP = OFF_WT_OUT + 2 * SZ_WT_OUT;
constexpr size_t OFF_WT_DN = OFF_WT_UP + 2 * SZ_WT_UP;
constexpr size_t OFF_POOLWT = OFF_WT_DN + 2 * SZ_WT_DN;
constexpr size_t OFF_KF = OFF_POOLWT + 2 * SZ_POOLWT;
constexpr size_t OFF_H2 = OFF_KF + 2 * SZ_KF;
constexpr size_t OFF_STATS = OFF_H2 + 2 * SZ_H2;
constexpr size_t OFF_XA = OFF_STATS + 2 * SZ_STATS;
constexpr size_t OFF_H = OFF_XA + (size_t)NTOK * D_MODEL * 4;
constexpr size_t OFF_R1 = OFF_H + (size_t)(NTOK + 512) * D_MODEL * 2;
constexpr size_t OFF_P = OFF_R1;
constexpr size_t OFF_MIX = OFF_P + (size_t)NTOK * D_INP * 2;
constexpr size_t OFF_ZT = OFF_MIX + (size_t)NTOK * D_MODEL * 2;
constexpr size_t OFF_X0T = OFF_ZT + (size_t)768 * 8192 * 4;
constexpr size_t OFF_UP = OFF_R1;
constexpr size_t OFF_ACT = OFF_R1 + (size_t)NTOK * D_UP * 2;
constexpr size_t OFF_BAR = OFF_ACT + (size_t)NTOK * D_FF * 2;
constexpr size_t WS_END = OFF_BAR + 16384;
static_assert(OFF_X0T + (size_t)768 * 8192 * 4 <= OFF_ACT, "alias region");

constexpr int LDS_BYTES = 139264;
#ifndef PROBE
#define PROBE 0
#endif
#define REP(k) for (int rep_ = 0; rep_ < ((PROBE == (k)) ? 2 : 1); ++rep_)

struct Params {
    const float* in[27];
    float* out;
    unsigned char* ws;
    int ph_lo, ph_hi;
};


__device__ __forceinline__ const float* inp(int i) {
    const __attribute__((address_space(4))) char* ka = (const __attribute__((address_space(4))) char*)__builtin_amdgcn_kernarg_segment_ptr();
    int off = i * 8; asm volatile("" : "+s"(off));
    return *(const float* const __attribute__((address_space(4)))*)(ka + off);
}

__device__ __forceinline__ int tid_l() { int t = threadIdx.x; asm volatile("" : "+v"(t)); return t; }
__device__ __forceinline__ float bf2f(bf16_t b) { return __uint_as_float(((unsigned)b) << 16); }
__device__ __forceinline__ unsigned cvt_pk_bf16(float lo, float hi) { unsigned r; asm volatile("v_cvt_pk_bf16_f32 %0, %1, %2" : "=v"(r) : "v"(lo), "v"(hi)); return r; }
__device__ __forceinline__ float lo_bf(unsigned u) { return __uint_as_float(u << 16); }
__device__ __forceinline__ float hi_bf(unsigned u) { return __uint_as_float(u & 0xffff0000u); }
__device__ __forceinline__ float gelu_tanh(float x) {
    const float y2 = 1.5957691216f * (x + 0.044715f * x * x * x);
    return x * __builtin_amdgcn_rcpf(1.0f + __expf(-y2));
}
__device__ __forceinline__ float silu(float x) { return x * __builtin_amdgcn_rcpf(1.0f + __expf(-x)); }
__device__ __forceinline__ float wave_sum(float v) {
#pragma unroll
    for (int o = 32; o > 0; o >>= 1) v += __shfl_xor(v, o, 64);
    return v;
}

#define XB_TMO      128
#define XB_XCNT(j)  (256  + 64 * (j))
#define XB_XSUB(j)  (1280 + 64 * (j))
#define XB_XGEN(j)  (2304 + 64 * (j))
#define XB_TOP      3328
#define XB_TOPGEN   3392
#define XCD_BAR_WORDS 3456
#define XB_SPIN_CAP (1u << 18)

__device__ __forceinline__ unsigned xb_ld(unsigned* p)              { return __hip_atomic_load(p, __ATOMIC_RELAXED, __HIP_MEMORY_SCOPE_AGENT); }
__device__ __forceinline__ unsigned xb_add(unsigned* p, unsigned v) { return __hip_atomic_fetch_add(p, v, __ATOMIC_RELAXED, __HIP_MEMORY_SCOPE_AGENT); }
__device__ __forceinline__ unsigned xb_xcc_id() { return (unsigned)__builtin_amdgcn_s_getreg((3 << 11) | 20) & 0xFu; }
#define XB_SPIN(cond, bar) do { unsigned _sp = 0; while (cond) { __builtin_amdgcn_s_sleep(1); \
    if ((++_sp & 255u) == 0u) { if (xb_ld(&(bar)[XB_TMO])) break; if (_sp > XB_SPIN_CAP) { atomicAdd(&(bar)[XB_TMO], 1u); break; } } } } while (0)

struct XcdBarrier {
    unsigned* bar; unsigned x;
    volatile LAS unsigned* st;
};

__device__ __forceinline__ XcdBarrier xcd_barrier_post(unsigned* bar, volatile LAS unsigned* st) {
    XcdBarrier b; b.bar = bar; b.x = xb_xcc_id(); b.st = st;
    if (threadIdx.x == 0) (void)xb_add(&bar[XB_XCNT(b.x)], 1u);
    return b;
}
__device__ __forceinline__ void xcd_barrier_complete(unsigned* bar, unsigned x, unsigned& nloc, unsigned& nx) {
    const unsigned G = gridDim.x * gridDim.y * gridDim.z;
    unsigned sum, cnt, mine, sp = 0u;
    for (;;) {
        sum = 0u; cnt = 0u; mine = 0u;
#pragma unroll
        for (unsigned j = 0; j < 16; ++j) { const unsigned c = xb_ld(&bar[XB_XCNT(j)]); sum += c; cnt += (c > 0u) ? 1u : 0u; mine = (j == x) ? c : mine; }
        if (sum == G) break;
        __builtin_amdgcn_s_sleep(1);
        if ((++sp & 255u) == 0u) { if (xb_ld(&bar[XB_TMO])) break; if (sp > XB_SPIN_CAP) { atomicAdd(&bar[XB_TMO], 1u); break; } }
    }
    nloc = mine > 0u ? mine : 1u; nx = cnt > 0u ? cnt : 1u;
}

__device__ __forceinline__ void xcd_barrier(const XcdBarrier& b) {
    asm volatile("s_waitcnt vmcnt(0)" ::: "memory");
    __syncthreads();
    if (threadIdx.x == 0) {
        unsigned* bar = b.bar;
        __builtin_amdgcn_s_waitcnt(0);
        unsigned nloc = b.st[0], nx = b.st[1];
        if (nloc == 0u) { xcd_barrier_complete(bar, b.x, nloc, nx); b.st[0] = nloc; b.st[1] = nx; }
        const unsigned old = xb_add(&bar[XB_XSUB(b.x)], 1u);
        const unsigned gen = old / nloc;
        if (old + 1u == (gen + 1u) * nloc) {
            __builtin_amdgcn_fence(__ATOMIC_RELEASE, "agent");
            asm volatile("s_waitcnt vmcnt(0)" ::: "memory");
            const unsigned og = xb_add(&bar[XB_TOP], 1u);
            const unsigned tg = og / nx;
            if (og + 1u == (tg + 1u) * nx) xb_add(&bar[XB_TOPGEN], 1u);
            else XB_SPIN(xb_ld(&bar[XB_TOPGEN]) == tg, bar);
            __builtin_amdgcn_fence(__ATOMIC_ACQUIRE, "agent");
            xb_add(&bar[XB_XGEN(b.x)], 1u);
            asm volatile("s_waitcnt vmcnt(0)" ::: "memory");
        } else {
            XB_SPIN(xb_ld(&bar[XB_XGEN(b.x)]) == gen, bar);
            __builtin_amdgcn_fence(__ATOMIC_ACQUIRE, "agent");
            asm volatile("s_waitcnt vmcnt(0)" ::: "memory");
        }
    }
    __syncthreads();
}


namespace pg8 {
constexpr int BM = 256, BK = 64, HALF = 128, HTB = HALF * BK * 2, STAGE_BYTES = 8 * HTB, NXCD = 8, WGM = 8;
__host__ __device__ __forceinline__ int lds_byte(int r, int c) { const int st = (r >> 4) * 2 + (c >> 5), rr = r & 15, cc = c & 31, ob = rr * 64 + cc * 2; return st * 1024 + (ob ^ (((ob >> 9) & 1) << 5)); }
__host__ __device__ __forceinline__ void stage_rc(int b, int& R, int& C) { const int st = b / 1024, sb = b % 1024, swz = sb ^ (((sb >> 9) & 1) << 5); R = (st >> 1) * 16 + swz / 64; C = (st & 1) * 32 + (swz % 64) / 2; }
__host__ __device__ __forceinline__ int perm32(int rho) { const int n = rho >> 4, i = rho & 15; return 8 * (i >> 2) + 4 * n + (i & 3); }
struct Unit { int pm, pn; };
struct Gemm { const bf16_t* A; const bf16_t* Bt; int M, N, K; };
struct StaticOrder {
    int nM, nN, nwg, G, c;
    __device__ void init(int M, int N, int G_, int c_) { nM = M / BM; nN = N / BM; nwg = nM * nN; G = G_; c = c_; }
    __device__ void init_tiles(int nM_, int nN_, int G_, int c_) { nM = nM_; nN = nN_; nwg = nM * nN; G = G_; c = c_; }
    __device__ bool next(int i, Unit& u) const {
        const long L = (long)i * G + c; if (L >= nwg) return false;
        int wgid = (int)L; { const int q = nwg / NXCD, r = nwg % NXCD, xcd = wgid % NXCD, off = wgid / NXCD; wgid = (xcd < r ? xcd * (q + 1) : r * (q + 1) + (xcd - r) * q) + off; }
        const int nig = WGM * nN, gid = wgid / nig, fm = gid * WGM, gsz = (nM - fm) < WGM ? (nM - fm) : WGM;
        u.pm = fm + ((wgid % nig) % gsz); u.pn = (wgid % nig) / gsz; return true;
    }
};
struct EpiBf16 {
    static constexpr bool PERM = true, CONV = false; static constexpr int GAPA = 0;
    bf16_t* O; int ldc;
    __device__ __forceinline__ void operator()(const f32x4 (&acc)[2][2][4][2], const Unit& u, int wr, int wc, int fr, int fq) const {
        const int row0 = u.pm * BM + wr * 64 + fr; const int col0 = u.pn * BM + wc * 32 + 8 * fq;
#pragma unroll
        for (int ai = 0; ai < 2; ++ai)
#pragma unroll
            for (int m = 0; m < 4; ++m) { bf16_t* rowp = O + (size_t)(row0 + ai * HALF + m * 16) * ldc + col0;
#pragma unroll
                for (int bj = 0; bj < 2; ++bj) { const f32x4 v0 = acc[ai][bj][m][0], v1 = acc[ai][bj][m][1];
                    u32x4 w; w.x = cvt_pk_bf16(v0[0], v0[1]); w.y = cvt_pk_bf16(v0[2], v0[3]); w.z = cvt_pk_bf16(v1[0], v1[1]); w.w = cvt_pk_bf16(v1[2], v1[3]);
                    *(u32x4*)(rowp + bj * HALF) = w; } }
    }
};
struct EpiBf16Gm {
    static constexpr bool PERM = true, CONV = false; static constexpr int GAPA = D_MODEL * 2;
    bf16_t* O; int ldc; float* stats;
    __device__ __forceinline__ void operator()(const f32x4 (&acc)[2][2][4][2], const Unit& u, int wr, int wc, int fr, int fq) const {
        const int row0 = u.pm * BM + wr * 64 + fr; const int col0 = u.pn * BM + wc * 32 + 8 * fq;
        const bool act = u.pn >= 11, st = u.pn >= 14;
#pragma unroll
        for (int ai = 0; ai < 2; ++ai)
#pragma unroll
            for (int m = 0; m < 4; ++m) { const int row = row0 + ai * HALF + m * 16; bf16_t* rowp = O + (size_t)row * ldc + col0; float s1 = 0.f, s2 = 0.f;
#pragma unroll
                for (int bj = 0; bj < 2; ++bj) { f32x4 v0 = acc[ai][bj][m][0], v1 = acc[ai][bj][m][1];
                    if (act) {
#pragma unroll
                        for (int j = 0; j < 4; ++j) { v0[j] = gelu_tanh(v0[j]); v1[j] = gelu_tanh(v1[j]); s1 += v0[j] + v1[j]; s2 += v0[j] * v0[j] + v1[j] * v1[j]; } }
                    u32x4 w; w.x = cvt_pk_bf16(v0[0], v0[1]); w.y = cvt_pk_bf16(v0[2], v0[3]); w.z = cvt_pk_bf16(v1[0], v1[1]); w.w = cvt_pk_bf16(v1[2], v1[3]);
                    *(u32x4*)(rowp + bj * HALF) = w; }
                if (st) { s1 += __shfl_xor(s1, 16, 64); s2 += __shfl_xor(s2, 16, 64); s1 += __shfl_xor(s1, 32, 64); s2 += __shfl_xor(s2, 32, 64);
                    if (fq == 0) *(float2*)(stats + ((size_t)row * 12 + (u.pn - 14) * 4 + wc) * 2) = make_float2(s1, s2); } }
    }
};
__device__ __forceinline__ float dpp_ror1(float v) { return __builtin_bit_cast(float, __builtin_amdgcn_mov_dpp(__builtin_bit_cast(int, v), 0x121, 0xf, 0xf, true)); }
__device__ __forceinline__ float dpp_rol1(float v) { return __builtin_bit_cast(float, __builtin_amdgcn_mov_dpp(__builtin_bit_cast(int, v), 0x12F, 0xf, 0xf, true)); }
struct EpiConvAct {
    static constexpr bool PERM = true, CONV = true; static constexpr int GAPA = 0;
    bf16_t* ACT; const float* cw; const float* cb;
    __device__ __forceinline__ void operator()(const f32x4 (&acc)[2][2][4][2], const Unit& u, int wr, int wc, int fr, int fq) const {
        const bool f0 = fr == 0, f15 = fr == 15;
#pragma unroll
        for (int n = 0; n < 2; ++n) {
            const int cg = 128 * u.pn + 32 * wc + 8 * fq + 4 * n;
            f32x4 wg[3], wv[3];
#pragma unroll
            for (int k = 0; k < 3; ++k) { wg[k] = *(const f32x4*)(cw + k * D_UP + cg); wv[k] = *(const f32x4*)(cw + k * D_UP + D_FF + cg); }
            const f32x4 bg = *(const f32x4*)(cb + cg), bv = *(const f32x4*)(cb + D_FF + cg);
#pragma unroll
            for (int ai = 0; ai < 2; ++ai) { const int pbase = 248 * u.pm + 62 * (2 * ai + wr);
                float rpg[4], rpv[4], lcg[4], lcv[4];
#pragma unroll
                for (int j = 0; j < 4; ++j) { rpg[j] = 0.f; rpv[j] = 0.f; lcg[j] = dpp_rol1(acc[ai][0][0][n][j]); lcv[j] = dpp_rol1(acc[ai][1][0][n][j]); }
#pragma unroll
                for (int m = 0; m < 4; ++m) { const int q = 16 * m + fr, pr = pbase + q; const int G = pr - 1 - (pr > 4097 ? 1 : 0);
                    const f32x4 gc = acc[ai][0][m][n], vc = acc[ai][1][m][n]; float o[4];
#pragma unroll
                    for (int j = 0; j < 4; ++j) {
                        const float rg = dpp_ror1(gc[j]), rv = dpp_ror1(vc[j]);
                        const float gp = (m > 0 && f0) ? rpg[j] : rg, vp = (m > 0 && f0) ? rpv[j] : rv;
                        float gn = lcg[j], vn = lcv[j];
                        if (m < 3) { const float a = dpp_rol1(acc[ai][0][m + 1][n][j]), b = dpp_rol1(acc[ai][1][m + 1][n][j]); gn = f15 ? a : gn; vn = f15 ? b : vn; lcg[j] = a; lcv[j] = b; }
                        rpg[j] = rg; rpv[j] = rv;
                        const float ga = __builtin_fmaf(wg[0][j], gp, __builtin_fmaf(wg[1][j], gc[j], __builtin_fmaf(wg[2][j], gn, bg[j])));
                        float va = __builtin_fmaf(wv[2][j], vn, bv[j]); asm volatile("" : "+v"(va));
                        va = __builtin_fmaf(wv[1][j], vc[j], va); asm volatile("" : "+v"(va));
                        va = __builtin_fmaf(wv[0][j], vp, va);
                        o[j] = silu(ga) * va; }
                    if (q >= 1 && q <= 62 && pr >= 1 && pr != 4097 && pr <= 8193) { u32x2 ow; ow.x = cvt_pk_bf16(o[0], o[1]); ow.y = cvt_pk_bf16(o[2], o[3]); *(u32x2*)(ACT + (size_t)G * D_FF + cg) = ow; } } }
        }
    }
};
template <bool RF32> struct EpiRes {
    static constexpr bool PERM = true, CONV = false; static constexpr int GAPA = 0;
    bf16_t* C; const void* R; int ldc;
    __device__ __forceinline__ void operator()(const f32x4 (&acc)[2][2][4][2], const Unit& u, int wr, int wc, int fr, int fq) const {
        const int row0 = u.pm * BM + wr * 64 + fr, col0 = u.pn * BM + wc * 32 + 8 * fq;
#pragma unroll
        for (int ai = 0; ai < 2; ++ai)
#pragma unroll
            for (int m = 0; m < 4; ++m) { const size_t ro = (size_t)(row0 + ai * HALF + m * 16) * ldc + col0;
#pragma unroll
                for (int bj = 0; bj < 2; ++bj) { f32x4 r0, r1;
                    if (RF32) { const float* rp = (const float*)R + ro + bj * HALF; r0 = *(const f32x4*)rp; r1 = *(const f32x4*)(rp + 4); }
                    else { const u32x4 rr = *(const u32x4*)((const bf16_t*)R + ro + bj * HALF);
                        r0 = (f32x4){lo_bf(rr.x), hi_bf(rr.x), lo_bf(rr.y), hi_bf(rr.y)}; r1 = (f32x4){lo_bf(rr.z), hi_bf(rr.z), lo_bf(rr.w), hi_bf(rr.w)}; }
                    const f32x4 o0 = acc[ai][bj][m][0] + r0, o1 = acc[ai][bj][m][1] + r1;
                    u32x4 w; w.x = cvt_pk_bf16(o0[0], o0[1]); w.y = cvt_pk_bf16(o0[2], o0[3]); w.z = cvt_pk_bf16(o1[0], o1[1]); w.w = cvt_pk_bf16(o1[2], o1[3]);
                    *(u32x4*)(C + ro + bj * HALF) = w; } }
    }
};

template <class Epi, class Sched, int KDIM>
__device__ __forceinline__ void gemm_phase(LAS unsigned char* lds, const Gemm g, const Sched& S, const Epi& E) {
    int tid_ = threadIdx.x; asm volatile("" : "+v"(tid_));
    const int tid = tid_, wid = __builtin_amdgcn_readfirstlane(tid >> 6), lane = tid & 63, wr = wid >> 2, wc = wid & 3, fr = lane & 15, fq = lane >> 4;
    constexpr int K = KDIM, nt = K / BK;
    unsigned voffA[2], voffB[2];
#pragma unroll
    for (int i = 0; i < 2; ++i) { int R, C; stage_rc(tid * 16 + i * 8192, R, C); const int Rb = Epi::PERM ? ((R & ~31) + perm32(R & 31)) : R;
        const int Ra = Epi::CONV ? (62 * (R >> 6) + (R & 63)) : R;
        voffA[i] = (unsigned)(Ra * K + C) * 2u; voffB[i] = (unsigned)(Rb * K + C) * 2u; }
    const size_t kstep = (size_t)(BK * 2);
    const size_t hstep = (size_t)HALF * K * 2;
    const size_t tstep = 2 * hstep;
    const size_t hstepA = Epi::CONV ? (size_t)124 * K * 2 : hstep, tstepA = 2 * hstepA;
    const unsigned ldsw = (unsigned)wid * 1024u;
    const int aoff = lds_byte(wr * 64 + fr, fq * 8), boff = lds_byte(wc * 32 + fr, fq * 8);
#define PG8_SA(b, h) (((b) * 2 + (h)) * HTB)
#define PG8_SB(b, h) ((4 + (b) * 2 + (h)) * HTB)
#define PG8_STAGE(bufoff, gbase, voff) do { _Pragma("unroll") for (int _i = 0; _i < 2; ++_i) \
        __builtin_amdgcn_global_load_lds((const unsigned*)((const char*)(gbase) + (voff)[_i]), (LAS unsigned*)(lds + (bufoff) + ldsw + _i * 8192), 16, 0, 0); } while (0)
#define PG8_LDA(dst, b, h) do { _Pragma("unroll") for (int m = 0; m < 4; ++m) _Pragma("unroll") for (int k = 0; k < 2; ++k) dst[m][k] = *(const LAS bf16x8*)(lds + PG8_SA(b, h) + aoff + m * 2048 + k * 1024); } while (0)
#define PG8_LDB(dst, b, h) do { _Pragma("unroll") for (int n = 0; n < 2; ++n) _Pragma("unroll") for (int k = 0; k < 2; ++k) dst[n][k] = *(const LAS bf16x8*)(lds + PG8_SB(b, h) + boff + n * 2048 + k * 1024); } while (0)
#define PG8_MMA(ai, bj, At, Bt) do { __builtin_amdgcn_s_setprio(1); _Pragma("unroll") for (int m = 0; m < 4; ++m) _Pragma("unroll") for (int n = 0; n < 2; ++n) _Pragma("unroll") for (int k = 0; k < 2; ++k) \
        acc[ai][bj][m][n] = __builtin_amdgcn_mfma_f32_16x16x32_bf16(Bt[n][k], At[m][k], acc[ai][bj][m][n], 0, 0, 0); __builtin_amdgcn_s_setprio(0); } while (0)
#define PG8_WAIT_V(n) asm volatile("s_waitcnt vmcnt(" #n ")" ::: "memory")
#define PG8_WAIT_L(n) asm volatile("s_waitcnt lgkmcnt(" #n ")" ::: "memory")
#define PG8_BAR __builtin_amdgcn_s_barrier()
#define PG8_SCHED __builtin_amdgcn_sched_barrier(0)
    Unit cur, nxt; int ui = 0;
    if (!S.next(0, cur)) return;
    f32x4 acc[2][2][4][2];
#pragma unroll
    for (int a = 0; a < 2; ++a)
#pragma unroll
        for (int b = 0; b < 2; ++b)
#pragma unroll
            for (int m = 0; m < 4; ++m)
#pragma unroll
                for (int n = 0; n < 2; ++n) acc[a][b][m][n] = (f32x4){0.f, 0.f, 0.f, 0.f};
    bf16x8 At[4][2], B0[2][2], B1[2][2];
    const char* cA = (const char*)g.A + (size_t)cur.pm * tstepA + (cur.pm >= 16 ? Epi::GAPA : 0); const char* cB = (const char*)g.Bt + (size_t)cur.pn * tstep;
    PG8_STAGE(PG8_SB(0, 0), cB, voffB); PG8_STAGE(PG8_SA(0, 0), cA, voffA); PG8_STAGE(PG8_SB(0, 1), cB + hstep, voffB); PG8_STAGE(PG8_SA(0, 1), cA + hstepA, voffA);
    if (wr == 1) PG8_BAR;
    PG8_WAIT_V(4); PG8_BAR;
    PG8_STAGE(PG8_SB(1, 0), cB + kstep, voffB); PG8_STAGE(PG8_SA(1, 0), cA + kstep, voffA); PG8_STAGE(PG8_SB(1, 1), cB + hstep + kstep, voffB);
    PG8_WAIT_V(6); PG8_BAR;
    for (;;) {
        const bool has_next = S.next(ui + 1, nxt);
        const char* nA = has_next ? (const char*)g.A + (size_t)nxt.pm * tstepA + (nxt.pm >= 16 ? Epi::GAPA : 0) : cA; const char* nB = has_next ? (const char*)g.Bt + (size_t)nxt.pn * tstep : cB;
        for (int t = 0; t < nt; t += 2) {
            const bool last = (t == nt - 2);
            const char* a1 = cA + (size_t)(t + 1) * kstep;
            const char* a2 = last ? nA : cA + (size_t)(t + 2) * kstep; const char* b2 = last ? nB : cB + (size_t)(t + 2) * kstep;
            const char* a3 = a2 + kstep; const char* b3 = b2 + kstep;
            PG8_LDB(B0, 0, 0); PG8_SCHED; PG8_LDA(At, 0, 0); PG8_STAGE(PG8_SA(1, 1), a1 + hstepA, voffA);
            PG8_WAIT_L(8); PG8_BAR; PG8_WAIT_L(0); PG8_MMA(0, 0, At, B0); PG8_BAR; PG8_SCHED;
            PG8_LDB(B1, 0, 1); PG8_STAGE(PG8_SB(0, 0), b2, voffB);
            PG8_BAR; PG8_WAIT_L(0); PG8_MMA(0, 1, At, B1); PG8_BAR;
            PG8_LDA(At, 0, 1); PG8_STAGE(PG8_SA(0, 0), a2, voffA);
            PG8_BAR; PG8_WAIT_L(0); PG8_MMA(1, 0, At, B0); PG8_BAR; PG8_SCHED;
            PG8_STAGE(PG8_SB(0, 1), b2 + hstep, voffB);
            PG8_WAIT_V(6); PG8_BAR; PG8_MMA(1, 1, At, B1); PG8_BAR;
            PG8_LDB(B0, 1, 0); PG8_SCHED; PG8_LDA(At, 1, 0); PG8_STAGE(PG8_SA(0, 1), a2 + hstepA, voffA);
            PG8_WAIT_L(8); PG8_BAR; PG8_WAIT_L(0); PG8_MMA(0, 0, At, B0); PG8_BAR; PG8_SCHED;
            PG8_LDB(B1, 1, 1); PG8_STAGE(PG8_SB(1, 0), b3, voffB);
            PG8_BAR; PG8_WAIT_L(0); PG8_MMA(0, 1, At, B1); PG8_BAR;
            PG8_LDA(At, 1, 1); PG8_STAGE(PG8_SA(1, 0), a3, voffA);
            PG8_BAR; PG8_WAIT_L(0); PG8_MMA(1, 0, At, B0); PG8_BAR; PG8_SCHED;
            PG8_STAGE(PG8_SB(1, 1), b3 + hstep, voffB);
            PG8_WAIT_V(6); PG8_BAR; PG8_MMA(1, 1, At, B1); PG8_BAR;
        }
        E(acc, cur, wr, wc, fr, fq);
        if (!has_next) break;
#pragma unroll
        for (int a = 0; a < 2; ++a)
#pragma unroll
            for (int b = 0; b < 2; ++b)
#pragma unroll
                for (int m = 0; m < 4; ++m)
#pragma unroll
                    for (int n = 0; n < 2; ++n) acc[a][b][m][n] = (f32x4){0.f, 0.f, 0.f, 0.f};
        cur = nxt; cA = nA; cB = nB; ++ui;
    }
    PG8_WAIT_V(0);
    if (wr == 0) PG8_BAR;
    PG8_BAR;
#undef PG8_SA
#undef PG8_SB
#undef PG8_STAGE
#undef PG8_LDA
#undef PG8_LDB
#undef PG8_MMA
#undef PG8_WAIT_V
#undef PG8_WAIT_L
#undef PG8_BAR
#undef PG8_SCHED
}
}

__device__ __forceinline__ void convert_tile(const float* __restrict__ W, int K, int N, bf16_t* __restrict__ Wt, int k0, int n0, int orow0, float* tile) {
    const int tid = tid_l();
    { const int r = tid >> 4, c4 = (tid & 15) * 4;
#pragma unroll
      for (int ps = 0; ps < 2; ++ps) { const int rr = r + ps * 32; const float4 v = *(const float4*)(W + (size_t)(k0 + rr) * N + n0 + c4);
          tile[rr * 65 + c4 + 0] = v.x; tile[rr * 65 + c4 + 1] = v.y; tile[rr * 65 + c4 + 2] = v.z; tile[rr * 65 + c4 + 3] = v.w; } }
    __syncthreads();
    { const int n = tid >> 3, k8 = (tid & 7) * 8; float v[8];
#pragma unroll
      for (int j = 0; j < 8; ++j) v[j] = tile[(k8 + j) * 65 + n];
      u32x4 w; w.x = cvt_pk_bf16(v[0], v[1]); w.y = cvt_pk_bf16(v[2], v[3]); w.z = cvt_pk_bf16(v[4], v[5]); w.w = cvt_pk_bf16(v[6], v[7]);
      *(u32x4*)(Wt + (size_t)(orow0 + n) * K + k0 + k8) = w; }
    __syncthreads();
}

constexpr int NI_IN = 32 * 68, NI_OUT = 32 * 32, NI_UP = 32 * 176, NI_DN = 88 * 32, NI_POOL = 16, NI_LAYER = NI_IN + NI_OUT + NI_UP + NI_DN + NI_POOL;
constexpr int NI_FILT = 256;
constexpr int NT3 = 1600;
constexpr int R_OUT = NI_IN, R_UP = NI_IN + NI_OUT, R_DN = NI_IN + NI_OUT + NI_UP, R_POOL = NI_IN + NI_OUT + NI_UP + NI_DN;
__device__ void convert_item(const Params& p, int l, int r, float* lds) {
    if (r < NI_IN) { const int tn = r / 32, tk = r % 32;
        convert_tile(inp(2) + (size_t)l * D_MODEL * D_INP, D_MODEL, D_INP, (bf16_t*)(p.ws + OFF_WT_IN + l * SZ_WT_IN), tk * 64, tn * 64, tn * 64, lds); return; }
    r -= NI_IN;
    if (r < NI_OUT) { const int tn = r / 32, tk = r % 32;
        convert_tile(inp(20) + (size_t)l * D_MODEL * D_MODEL, D_MODEL, D_MODEL, (bf16_t*)(p.ws + OFF_WT_OUT + l * SZ_WT_OUT), tk * 64, tn * 64, tn * 64, lds); return; }
    r -= NI_OUT;
    if (r < NI_UP) { const int tn = r / 32, tk = r % 32; const int n0 = tn * 64, s = n0 / D_FF, rem = n0 % D_FF, j = rem / 128, i = rem % 128;
        convert_tile(inp(22) + (size_t)l * D_MODEL * D_UP, D_MODEL, D_UP, (bf16_t*)(p.ws + OFF_WT_UP + l * SZ_WT_UP), tk * 64, n0, 256 * j + 128 * s + i, lds); return; }
    r -= NI_UP;
    if (r < NI_DN) { const int tn = r / 88, tk = r % 88;
        convert_tile(inp(25) + (size_t)l * D_FF * D_MODEL, D_FF, D_MODEL, (bf16_t*)(p.ws + OFF_WT_DN + l * SZ_WT_DN), tk * 64, tn * 64, tn * 64, lds); return; }
    r -= NI_DN;
    { const int g = r >> 2, tn = (r >> 1) & 1, tk = r & 1;
        convert_tile(inp(3) + (size_t)(l * 4 + g) * 128 * 128, 128, 128, (bf16_t*)(p.ws + OFF_POOLWT + l * SZ_POOLWT) + g * 128 * 128, tk * 64, tn * 64, tn * 64, lds); }
}

__device__ __forceinline__ float sin_rad(float x) { return __builtin_amdgcn_sinf(x * 0.15915494309f); }

struct CvDesc { const float* W; bf16_t* Wt; int K, N, k0, n0, orow0; };
__device__ __forceinline__ CvDesc cv_desc(const Params& p, int l, int r) {
    CvDesc d;
    if (r < R_OUT) { const int tn = r / 32, tk = r % 32; d.W = inp(2) + (size_t)l * D_MODEL * D_INP; d.Wt = (bf16_t*)(p.ws + OFF_WT_IN + l * SZ_WT_IN); d.K = D_MODEL; d.N = D_INP; d.k0 = tk * 64; d.n0 = tn * 64; d.orow0 = tn * 64; }
    else if (r < R_UP) { r -= R_OUT; const int tn = r / 32, tk = r % 32; d.W = inp(20) + (size_t)l * D_MODEL * D_MODEL; d.Wt = (bf16_t*)(p.ws + OFF_WT_OUT + l * SZ_WT_OUT); d.K = D_MODEL; d.N = D_MODEL; d.k0 = tk * 64; d.n0 = tn * 64; d.orow0 = tn * 64; }
    else if (r < R_DN) { r -= R_UP; const int tn = r / 32, tk = r % 32; const int n0 = tn * 64, sg = n0 / D_FF, rem = n0 % D_FF, j = rem / 128, i = rem % 128;
        d.W = inp(22) + (size_t)l * D_MODEL * D_UP; d.Wt = (bf16_t*)(p.ws + OFF_WT_UP + l * SZ_WT_UP); d.K = D_MODEL; d.N = D_UP; d.k0 = tk * 64; d.n0 = n0; d.orow0 = 256 * j + 128 * sg + i; }
    else if (r < R_POOL) { r -= R_DN; const int tn = r / 88, tk = r % 88; d.W = inp(25) + (size_t)l * D_FF * D_MODEL; d.Wt = (bf16_t*)(p.ws + OFF_WT_DN + l * SZ_WT_DN); d.K = D_FF; d.N = D_MODEL; d.k0 = tk * 64; d.n0 = tn * 64; d.orow0 = tn * 64; }
    else { r -= R_POOL; const int g = r >> 2, tn = (r >> 1) & 1, tk = r & 1; d.W = inp(3) + (size_t)(l * 4 + g) * 128 * 128; d.Wt = (bf16_t*)(p.ws + OFF_POOLWT + l * SZ_POOLWT) + g * 128 * 128; d.K = 128; d.N = 128; d.k0 = tk * 64; d.n0 = tn * 64; d.orow0 = tn * 64; }
    return d;
}
__device__ __forceinline__ CvDesc cv_pick(const Params& p, int mode, int l, int base, int i) {
    if (mode == 0) { if (i < R_DN) return cv_desc(p, 0, i); if (i < R_DN + NI_POOL) return cv_desc(p, 0, R_POOL + i - R_DN); return cv_desc(p, 1, R_POOL + i - R_DN - NI_POOL); }
    return cv_desc(p, l, base + i);
}
__device__ __forceinline__ void cv_load(const CvDesc& d, int tid, float4 (&v)[2]) {
    const int r = tid >> 4, c4 = (tid & 15) * 4;
#pragma unroll
    for (int ps = 0; ps < 2; ++ps) v[ps] = *(const float4*)(d.W + (size_t)(d.k0 + r + ps * 32) * d.N + d.n0 + c4);
}
__device__ void convert_range(const Params& p, int mode, int l, int base, int count, int start, int stride, float* tile) {
    int i = start; if (i >= count) return;
    const int tid = tid_l();
    CvDesc d = cv_pick(p, mode, l, base, i); float4 v[2]; cv_load(d, tid, v);
    for (;;) {
        { const int r = tid >> 4, c4 = (tid & 15) * 4;
#pragma unroll
          for (int ps = 0; ps < 2; ++ps) { float* tp = tile + (r + ps * 32) * 65 + c4; tp[0] = v[ps].x; tp[1] = v[ps].y; tp[2] = v[ps].z; tp[3] = v[ps].w; } }
        __syncthreads();
        const int ni = i + stride; const bool more = ni < count; CvDesc dn = d;
        if (more) { dn = cv_pick(p, mode, l, base, ni); cv_load(dn, tid, v); }
        { const int n = tid >> 3, k8 = (tid & 7) * 8; float u[8];
#pragma unroll
          for (int j = 0; j < 8; ++j) u[j] = tile[(k8 + j) * 65 + n];
          u32x4 w; w.x = cvt_pk_bf16(u[0], u[1]); w.y = cvt_pk_bf16(u[2], u[3]); w.z = cvt_pk_bf16(u[4], u[5]); w.w = cvt_pk_bf16(u[6], u[7]);
          *(u32x4*)(d.Wt + (size_t)(d.orow0 + n) * d.K + d.k0 + k8) = w; }
        __syncthreads();
        if (!more) break;
        d = dn; i = ni;
    }
}

__device__ void filter_item(const Params& p, int item, float* lds) {
    const int l = item >> 7, rem = item & 127, ti = rem >> 1, half = rem & 1;
    const int tid = tid_l(), lane = tid & 63, w = __builtin_amdgcn_readfirstlane(tid >> 6);
    const int t = ti * 64 + lane;
    const float* w1 = inp(8) + l * 33 * 64; const float* b1 = inp(9) + l * 64; const float* fr1 = inp(10) + l * 64;
    const float* w2 = inp(11) + l * 64 * 64; const float* b2 = inp(12) + l * 64; const float* fr2 = inp(13) + l * 64;
    const float* w3 = inp(14) + (size_t)l * 64 * 1536;
    float* h1s = lds; float* h2s = lds + 64 * 65;
    const float tt = (float)t / 4095.0f;
    float a[8];
#pragma unroll
    for (int j = 0; j < 8; ++j) a[j] = b1[8 * w + j] + tt * w1[8 * w + j];
    for (int band = 0; band < 16; ++band) {
        const float f = 1e-4f + (float)band * ((15.0f - 1e-4f) / 15.0f);
        float r = f * (float)t * (1.0f / 4096.0f); r -= floorf(r);
        const float cs = __builtin_amdgcn_cosf(r), sn = -__builtin_amdgcn_sinf(r);
#pragma unroll
        for (int j = 0; j < 8; ++j) a[j] += cs * w1[(1 + band) * 64 + 8 * w + j] + sn * w1[(17 + band) * 64 + 8 * w + j];
    }
#pragma unroll
    for (int j = 0; j < 8; ++j) h1s[lane * 65 + 8 * w + j] = sin_rad(fr1[8 * w + j] * a[j]);
    __syncthreads();
#pragma unroll
    for (int j = 0; j < 8; ++j) a[j] = b2[8 * w + j];
    for (int i = 0; i < 64; ++i) { const float h = h1s[lane * 65 + i];
#pragma unroll
        for (int j = 0; j < 8; ++j) a[j] += h * w2[i * 64 + 8 * w + j]; }
#pragma unroll
    for (int j = 0; j < 8; ++j) h2s[lane * 65 + 8 * w + j] = sin_rad(fr2[8 * w + j] * a[j]);
    __syncthreads();
    float* KT = (float*)(p.ws + OFF_ACT) + (size_t)l * 768 * 8192;
    const float d0 = -3.0701134573f, d1 = -15.3505672865f;
    typedef const __attribute__((address_space(4))) f32x4 cf4;
    for (int ci = 0; ci < 24; ++ci) {
        const int c = w * 96 + ci * 4;
        cf4* wc = (cf4*)(unsigned long long)(w3 + half * 768 + c);
        float o0 = 0.f, o1 = 0.f, o2 = 0.f, o3 = 0.f;
#pragma unroll 8
        for (int i = 0; i < 64; ++i) { const float h = h2s[lane * 65 + i]; const f32x4 wv = wc[i * 384]; o0 += h * wv[0]; o1 += h * wv[1]; o2 += h * wv[2]; o3 += h * wv[3]; }
        float o[4] = {o0, o1, o2, o3};
#pragma unroll
        for (int j = 0; j < 4; ++j) {
            const float delta = d0 + (float)(c + j) * ((d1 - d0) / 767.0f);
            const float val = o[j] * __expf(-tt * fabsf(delta));
            float* kt = KT + (size_t)(c + j) * 8192;
            if (half == 0) kt[t] = val; else { if (t == 0) kt[4096] = 0.f; else kt[8192 - t] = val; }
        }
    }
    __syncthreads();
}

__device__ __forceinline__ int phys(int i) { return i + (i >> 5); }
__device__ __forceinline__ float launder_f(float v) { asm volatile("" : "+v"(v)); return v; }
constexpr int FFT_BUF = 8192 + 256;
__device__ __forceinline__ constexpr float c32(int i) { constexpr float T[16] = {1.0f, 0.98078528040f, 0.92387953251f, 0.83146961230f, 0.70710678119f, 0.55557023302f, 0.38268343237f, 0.19509032202f, 0.0f, -0.19509032202f, -0.38268343237f, -0.55557023302f, -0.70710678119f, -0.83146961230f, -0.92387953251f, -0.98078528040f}; return T[i]; }
__device__ __forceinline__ constexpr float s32(int i) { constexpr float T[16] = {0.0f, 0.19509032202f, 0.38268343237f, 0.55557023302f, 0.70710678119f, 0.83146961230f, 0.92387953251f, 0.98078528040f, 1.0f, 0.98078528040f, 0.92387953251f, 0.83146961230f, 0.70710678119f, 0.55557023302f, 0.38268343237f, 0.19509032202f}; return T[i]; }
template <bool INV> __device__ __forceinline__ void radix16(float2 (&x)[16], float rfrac) {
#pragma unroll
    for (int jj = 0; jj < 4; ++jj) { const int j = INV ? 3 - jj : jj; const int half = 8 >> j;
        const float ab = rfrac * (float)(8 / half); const float cb = __builtin_amdgcn_cosf(ab), sb = __builtin_amdgcn_sinf(ab);
#pragma unroll
        for (int kk = 0; kk < half; ++kk) {
            const int idx = kk * (16 / half);
            float cs, sp;
            if (idx == 0) { cs = cb; sp = sb; }
            else if (idx == 8) { cs = -sb; sp = cb; }
            else { cs = cb * c32(idx) - sb * s32(idx); sp = cb * s32(idx) + sb * c32(idx); }
            const float sn = INV ? sp : -sp;
#pragma unroll
            for (int g = 0; g < 16; g += 2 * half) { const int i0 = g + kk, i1 = i0 + half; const float2 a = x[i0], b = x[i1];
                if (!INV) { const float dx = a.x - b.x, dy = a.y - b.y; x[i0] = make_float2(a.x + b.x, a.y + b.y); x[i1] = make_float2(dx * cs - dy * sn, dx * sn + dy * cs); }
                else { const float bx = b.x * cs - b.y * sn, by = b.x * sn + b.y * cs; x[i0] = make_float2(a.x + bx, a.y + by); x[i1] = make_float2(a.x - bx, a.y - by); } }
        }
    }
}
template <bool INV> __device__ __forceinline__ void radix32(float2 (&y)[32]) {
#pragma unroll
    for (int jj = 0; jj < 5; ++jj) { const int j = INV ? 4 - jj : jj; const int half = 16 >> j;
#pragma unroll
        for (int kk = 0; kk < half; ++kk) { const int idx = kk * (16 / half); const float cs = c32(idx), sn = INV ? s32(idx) : -s32(idx);
#pragma unroll
            for (int g = 0; g < 32; g += 2 * half) { const int i0 = g + kk, i1 = i0 + half; const float2 a = y[i0], b = y[i1];
                if (!INV) { const float dx = a.x - b.x, dy = a.y - b.y; y[i0] = make_float2(a.x + b.x, a.y + b.y);
                    if (idx == 0) y[i1] = make_float2(dx, dy);
                    else if (idx == 8) y[i1] = make_float2(dy, -dx);
                    else y[i1] = make_float2(dx * cs - dy * sn, dx * sn + dy * cs); }
                else { float bx, by;
                    if (idx == 0) { bx = b.x; by = b.y; }
                    else if (idx == 8) { bx = -b.y; by = b.x; }
                    else { bx = b.x * cs - b.y * sn; by = b.x * sn + b.y * cs; }
                    y[i0] = make_float2(a.x + bx, a.y + by); y[i1] = make_float2(a.x - bx, a.y - by); } }
        }
    }
}
template <bool INV> __device__ __forceinline__ void fft_pass2(float2* B, int tid, float rfr) {
    const int blk = tid >> 5, r = tid & 31; float2 x[16]; float2* b = B + blk * 528 + r;
#pragma unroll
    for (int k = 0; k < 16; ++k) x[k] = b[33 * k];
    radix16<INV>(x, rfr);
#pragma unroll
    for (int k = 0; k < 16; ++k) b[33 * k] = x[k];
}

__device__ void kf_item(const Params& p, int item, unsigned char* smem) {
    const int l = item / 384, cp = item % 384, c0 = 2 * cp;
    const int tid = tid_l();
    float2* B0 = (float2*)smem; float2* B1 = B0 + FFT_BUF;
    const float* KT = (const float*)(p.ws + OFF_ACT) + ((size_t)l * 768 + c0) * 8192 + tid;
    float2 x0[16], x1[16];
#pragma unroll
    for (int k = 0; k < 16; ++k) { x0[k] = make_float2(KT[512 * k], 0.f); x1[k] = make_float2(KT[8192 + 512 * k], 0.f); }
    const float rf = (float)tid * (1.0f / 8192.0f);
    radix16<false>(x0, rf); radix16<false>(x1, rf);
#pragma unroll
    for (int k = 0; k < 16; ++k) { B0[phys(tid + 512 * k)] = x0[k]; B1[phys(tid + 512 * k)] = x1[k]; }
    __syncthreads();
    { const float r2 = launder_f((float)(tid & 31) * (1.0f / 512.0f)); fft_pass2<false>(B0, tid, r2); fft_pass2<false>(B1, tid, r2); }
    __syncthreads();
    { const int blk = tid & 255, ch = tid >> 8; float2* B = ch ? B1 : B0; float2 y[32];
#pragma unroll
      for (int k = 0; k < 32; ++k) y[k] = B[blk * 33 + k];
      radix32<false>(y);
      float2* KF = (float2*)(p.ws + OFF_KF) + ((size_t)l * 768 + c0 + ch) * 8192 + blk * 2; const float sc = 1.0f / 8192.0f;
#pragma unroll
      for (int k = 0; k < 32; k += 2) *(float4*)(KF + (k >> 1) * 512) = make_float4(y[k].x * sc, y[k].y * sc, y[k + 1].x * sc, y[k + 1].y * sc); }
    __syncthreads();
}

template <bool XF32> __device__ void norm_phase(const void* __restrict__ xin, const float* __restrict__ g, bf16_t* hb, float* hf) {
    const int tid = tid_l(); const int lane = tid & 63; const int gw = blockIdx.x * 8 + (tid >> 6), nw = gridDim.x * 8;
    for (int row = gw; row < NTOK; row += nw) {
        float4 v[8]; float ss = 0.f;
#pragma unroll
        for (int i = 0; i < 8; ++i) {
            if (XF32) v[i] = *(const float4*)((const float*)xin + (size_t)row * D_MODEL + i * 256 + lane * 4);
            else { const u32x2 u = *(const u32x2*)((const bf16_t*)xin + (size_t)row * D_MODEL + i * 256 + lane * 4); v[i] = make_float4(lo_bf(u.x), hi_bf(u.x), lo_bf(u.y), hi_bf(u.y)); }
            ss += v[i].x * v[i].x + v[i].y * v[i].y + v[i].z * v[i].z + v[i].w * v[i].w; }
        ss = wave_sum(ss);
        const float rs = rsqrtf(ss * (1.0f / D_MODEL) + 1e-6f);
#pragma unroll
        for (int i = 0; i < 8; ++i) { const float4 gg = *(const float4*)(g + i * 256 + lane * 4);
            const float y0 = v[i].x * rs * gg.x, y1 = v[i].y * rs * gg.y, y2 = v[i].z * rs * gg.z, y3 = v[i].w * rs * gg.w;
            if (hb) { u32x2 w; w.x = cvt_pk_bf16(y0, y1); w.y = cvt_pk_bf16(y2, y3); *(u32x2*)(hb + (size_t)(row + 1 + (row >> 12)) * D_MODEL + i * 256 + lane * 4) = w; }
            else { *(float4*)(hf + (size_t)row * D_MODEL + i * 256 + lane * 4) = make_float4(y0, y1, y2, y3); } }
    }
}

__device__ void pool_item(const Params& p, int l, int item, unsigned char* smem) {
    const int tt = item >> 2, g = item & 3;
    const int tid = tid_l(), lane = tid & 63, w = tid >> 6, fr = lane & 15, fq = lane >> 4;
    const bf16_t* P = (const bf16_t*)(p.ws + OFF_P); bf16_t* MIX = (bf16_t*)(p.ws + OFF_MIX);
    const int row0 = tt * 128, b0 = (row0 / SEQ) * SEQ;
    float* X = (float*)smem;
    bf16_t* A = (bf16_t*)(smem + 144 * 129 * 4);
    for (int idx = tid; idx < 144 * 16; idx += 512) { const int r = idx >> 4, c8 = (idx & 15) * 8; const int row = row0 - 8 + r;
        u32x4 v = (u32x4){0u, 0u, 0u, 0u};
        if (row >= b0 && row < b0 + SEQ) v = *(const u32x4*)(P + (size_t)row * D_INP + g * 128 + c8);
        float* xp = X + r * 129 + c8;
        xp[0] = lo_bf(v.x); xp[1] = hi_bf(v.x); xp[2] = lo_bf(v.y); xp[3] = hi_bf(v.y); xp[4] = lo_bf(v.z); xp[5] = hi_bf(v.z); xp[6] = lo_bf(v.w); xp[7] = hi_bf(v.w); }
    __syncthreads();
    { const int c = tid & 127, tq = tid >> 7; const int hw = 1 << g;
      const float* xc = X + (tq * 32 + 8) * 129 + c;
      float s = 0.f;
      for (int q = -hw; q < hw; ++q) s += xc[q * 129];
      const int tb = row0 + tq * 32 - b0;
#pragma unroll 8
      for (int i = 0; i < 32; ++i) { const int t = tb + i; const int lo = max(t - hw, 0), hi = min(t + hw - 1, SEQ - 1);
          const float d = s * __builtin_amdgcn_rcpf((float)(hi - lo + 1)) - xc[i * 129];
          A[(tq * 32 + i) * 136 + c] = (bf16_t)(cvt_pk_bf16(d, 0.f) & 0xffffu);
          s += xc[(i + hw) * 129] - xc[(i - hw) * 129]; } }
    __syncthreads();
    const bf16_t* Wt = (const bf16_t*)(p.ws + OFF_POOLWT + l * SZ_POOLWT) + g * 128 * 128;
    f32x4 acc[8];
#pragma unroll
    for (int nb = 0; nb < 8; ++nb) acc[nb] = (f32x4){0.f, 0.f, 0.f, 0.f};
#pragma unroll
    for (int ks = 0; ks < 4; ++ks) {
        const bf16x8 af = *(const bf16x8*)(A + (16 * w + fr) * 136 + ks * 32 + fq * 8);
#pragma unroll
        for (int nb = 0; nb < 8; ++nb) { const bf16x8 bfr = *(const bf16x8*)(Wt + (nb * 16 + fr) * 128 + ks * 32 + fq * 8);
            acc[nb] = __builtin_amdgcn_mfma_f32_16x16x32_bf16(bfr, af, acc[nb], 0, 0, 0); }
    }
    const float* pb = inp(4) + l * 512 + g * 128; const float* psc = inp(5) + l * 512 + g * 128;
    const int row = row0 + 16 * w + fr;
#pragma unroll
    for (int nb = 0; nb < 8; ++nb) { const int d = nb * 16 + 4 * fq; const float4 bb = *(const float4*)(pb + d), sc = *(const float4*)(psc + d);
        u32x2 o; o.x = cvt_pk_bf16((acc[nb][0] + bb.x) * sc.x, (acc[nb][1] + bb.y) * sc.y); o.y = cvt_pk_bf16((acc[nb][2] + bb.z) * sc.z, (acc[nb][3] + bb.w) * sc.w);
        *(u32x2*)(MIX + (size_t)row * D_MODEL + g * 128 + d) = o; }
    __syncthreads();
}

__device__ void hypre_item(const Params& p, int l, int item, unsigned char* smem) {
    const int tt = item / 6, ct = item % 6; const int tid = tid_l();
    const bf16_t* P = (const bf16_t*)(p.ws + OFF_P); float* ZT = (float*)(p.ws + OFF_ZT); float* X0T = (float*)(p.ws + OFF_X0T);
    const float* sw = inp(6) + (size_t)l * 3 * 2304; const float* sb = inp(7) + (size_t)l * 2304;
    float* zt = (float*)smem;
    float* xt = zt + 128 * 65;
    const int row0 = tt * 64;
    { const int cpq = tid & 63, tr = tid >> 6; const int ch = ct * 128 + 2 * cpq;
      float w[3][3][2], bb[3][2];
#pragma unroll
      for (int s3 = 0; s3 < 3; ++s3) {
#pragma unroll
          for (int k = 0; k < 3; ++k) { const float2 v = *(const float2*)(sw + k * 2304 + s3 * 768 + ch); w[s3][k][0] = v.x; w[s3][k][1] = v.y; }
          const float2 v = *(const float2*)(sb + s3 * 768 + ch); bb[s3][0] = v.x; bb[s3][1] = v.y; }
      const int r0 = row0 + tr * 8; const bf16_t* pr = P + (size_t)r0 * D_INP + COL_HY + ch;
      unsigned pm[3], pc[3], pn[3];
#pragma unroll
      for (int s3 = 0; s3 < 3; ++s3) { pm[s3] = ((r0 & (SEQ - 1)) != 0) ? *(const unsigned*)(pr - D_INP + s3 * 768) : 0u; pc[s3] = *(const unsigned*)(pr + s3 * 768); }
#pragma unroll
      for (int i = 0; i < 8; ++i) { const int row = r0 + i;
#pragma unroll
          for (int s3 = 0; s3 < 3; ++s3) pn[s3] = ((row & (SEQ - 1)) != SEQ - 1) ? *(const unsigned*)(pr + (size_t)(i + 1) * D_INP + s3 * 768) : 0u;
          float o[3][2];
#pragma unroll
          for (int s3 = 0; s3 < 3; ++s3) { o[s3][0] = w[s3][0][0] * lo_bf(pm[s3]) + w[s3][1][0] * lo_bf(pc[s3]) + w[s3][2][0] * lo_bf(pn[s3]) + bb[s3][0];
                                           o[s3][1] = w[s3][0][1] * hi_bf(pm[s3]) + w[s3][1][1] * hi_bf(pc[s3]) + w[s3][2][1] * hi_bf(pn[s3]) + bb[s3][1]; }
          const int tl = tr * 8 + i;
          zt[(2 * cpq) * 65 + tl] = o[1][0] * o[2][0]; zt[(2 * cpq + 1) * 65 + tl] = o[1][1] * o[2][1];
          xt[(2 * cpq) * 65 + tl] = o[0][0]; xt[(2 * cpq + 1) * 65 + tl] = o[0][1];
#pragma unroll
          for (int s3 = 0; s3 < 3; ++s3) { pm[s3] = pc[s3]; pc[s3] = pn[s3]; } } }
    __syncthreads();
    { const int tl = tid & 63, cr = tid >> 6; const int row = row0 + tl, b = row >> 12, t = row & (SEQ - 1);
#pragma unroll
      for (int i = 0; i < 16; ++i) { const int c = cr * 16 + i; const size_t o = (size_t)(ct * 128 + c) * 8192 + b * 4096 + t; ZT[o] = zt[c * 65 + tl]; X0T[o] = xt[c * 65 + tl]; } }
    __syncthreads();
}

constexpr int GM_NH = 3;
__device__ void gmlp_item(const Params& p, int l, int item, unsigned char* smem) {
    const int n = item / (6 / GM_NH), e0 = (item % (6 / GM_NH)) * GM_NH;
    const int tid = tid_l(), lane = tid & 63, w = tid >> 6, fr = lane & 15, fq = lane >> 4;
    const bf16_t* P = (const bf16_t*)(p.ws + OFF_P); bf16_t* MIX = (bf16_t*)(p.ws + OFF_MIX);
    const float* stats = (const float*)(p.ws + OFF_STATS) + (size_t)l * NTOK * 24;
    const float* lng = inp(16) + l * 768; const float* lnb = inp(17) + l * 768;
    bf16_t* VT = (bf16_t*)smem;
    const int t0 = n * 128;
    const int q = 16 * w + fr; const size_t qrow = (size_t)(t0 + q);
    float g0[GM_NH], g1[GM_NH], be0[GM_NH], be1[GM_NH], bq[GM_NH]; u32x2 uu[GM_NH][8]; bf16x8 wf[GM_NH][4];
#pragma unroll
    for (int h = 0; h < GM_NH; ++h) { const int e = e0 + h;
        g0[h] = lng[e * 128 + lane]; g1[h] = lng[e * 128 + 64 + lane]; be0[h] = lnb[e * 128 + lane]; be1[h] = lnb[e * 128 + 64 + lane];
        bq[h] = (inp(19) + (l * 6 + e) * 128)[q];
#pragma unroll
        for (int cb = 0; cb < 8; ++cb) uu[h][cb] = *(const u32x2*)(P + qrow * D_INP + COL_GM + e * 128 + cb * 16 + 4 * fq);
        const float* ws_ = inp(18) + (size_t)(l * 6 + e) * 128 * 128;
#pragma unroll
        for (int ks = 0; ks < 4; ++ks) { const float* wp = ws_ + (16 * w + fr) * 128 + ks * 32 + fq * 8; const float4 a = *(const float4*)wp, b = *(const float4*)(wp + 4);
            u32x4 t; t.x = cvt_pk_bf16(a.x, a.y); t.y = cvt_pk_bf16(a.z, a.w); t.z = cvt_pk_bf16(b.x, b.y); t.w = cvt_pk_bf16(b.z, b.w); wf[h][ks] = __builtin_bit_cast(bf16x8, t); } }
#pragma unroll
    for (int i = 0; i < 16; ++i) { const int pl = 16 * w + i; const size_t row = (size_t)(t0 + pl); const bf16_t* pr = P + row * D_INP + COL_GM + 768 + e0 * 128;
        float2 st; { const f32x4* sp = (const f32x4*)(stats + row * 24); f32x4 a = sp[0];
#pragma unroll
          for (int k = 1; k < 6; ++k) a += sp[k];
          st = make_float2(a[0] + a[2], a[1] + a[3]); }
        const float mean = st.x * (1.0f / 768.0f); const float rstd = rsqrtf(fmaxf(st.y * (1.0f / 768.0f) - mean * mean, 0.f) + 1e-5f);
#pragma unroll
        for (int h = 0; h < GM_NH; ++h) {
            const float y0 = (bf2f(pr[h * 128 + lane]) - mean) * rstd * g0[h] + be0[h], y1 = (bf2f(pr[h * 128 + 64 + lane]) - mean) * rstd * g1[h] + be1[h];
            const unsigned pk = cvt_pk_bf16(y0, y1);
            VT[(h * 128 + lane) * 132 + pl] = (bf16_t)(pk & 0xffffu); VT[(h * 128 + 64 + lane) * 132 + pl] = (bf16_t)(pk >> 16); } }
    __syncthreads();
#pragma unroll
    for (int h = 0; h < GM_NH; ++h) { const int e = e0 + h;
        f32x4 acc[8];
#pragma unroll
        for (int cb = 0; cb < 8; ++cb) acc[cb] = (f32x4){0.f, 0.f, 0.f, 0.f};
#pragma unroll
        for (int ks = 0; ks < 4; ++ks)
#pragma unroll
            for (int cb = 0; cb < 8; ++cb) { const bf16_t* vp = VT + (h * 128 + cb * 16 + fr) * 132 + ks * 32 + fq * 8; const u32x2 lo = *(const u32x2*)vp, hi = *(const u32x2*)(vp + 4);
                u32x4 t; t.x = lo.x; t.y = lo.y; t.z = hi.x; t.w = hi.y;
                acc[cb] = __builtin_amdgcn_mfma_f32_16x16x32_bf16(__builtin_bit_cast(bf16x8, t), wf[h][ks], acc[cb], 0, 0, 0); }
#pragma unroll
        for (int cb = 0; cb < 8; ++cb) { const int c = cb * 16 + 4 * fq;
            const float u0 = lo_bf(uu[h][cb].x), u1 = hi_bf(uu[h][cb].x), u2 = lo_bf(uu[h][cb].y), u3 = hi_bf(uu[h][cb].y);
            u32x2 o; o.x = cvt_pk_bf16(u0 * (acc[cb][0] + bq[h]), u1 * (acc[cb][1] + bq[h])); o.y = cvt_pk_bf16(u2 * (acc[cb][2] + bq[h]), u3 * (acc[cb][3] + bq[h]));
            *(u32x2*)(MIX + qrow * D_MODEL + MIX_GM + e * 128 + c) = o; } }
    __syncthreads();
}

__device__ void fft_item(const Params& p, int l, int cp, unsigned char* smem) {
    const int tid = tid_l(); const int c0 = 2 * cp;
    float2* B0 = (float2*)smem;
    const float* ZT = (const float*)(p.ws + OFF_ZT) + (size_t)c0 * 8192; const float* X0T = (const float*)(p.ws + OFF_X0T) + (size_t)c0 * 8192;
    const float rf = (float)tid * (1.0f / 8192.0f);
#pragma unroll
    for (int ch = 0; ch < 2; ++ch) { float2 x[16]; float2* B = B0 + ch * FFT_BUF; const float* z = ZT + ch * 8192 + tid;
#pragma unroll
        for (int k = 0; k < 8; ++k) { x[k] = make_float2(z[512 * k], z[4096 + 512 * k]); x[k + 8] = make_float2(0.f, 0.f); }
        radix16<false>(x, rf);
#pragma unroll
        for (int k = 0; k < 16; ++k) B[phys(tid + 512 * k)] = x[k]; }
    __syncthreads();
    { const float r2 = launder_f((float)(tid & 31) * (1.0f / 512.0f));
#pragma unroll
      for (int ch = 0; ch < 2; ++ch) fft_pass2<false>(B0 + ch * FFT_BUF, tid, r2); }
    __syncthreads();
    { const int blk = tid & 255, ch = tid >> 8; float2* B = B0 + ch * FFT_BUF + blk * 33; float2 y[32];
#pragma unroll
      for (int k = 0; k < 32; ++k) y[k] = B[k];
      radix32<false>(y);
      const float2* KF = (const float2*)(p.ws + OFF_KF) + ((size_t)l * 768 + c0 + ch) * 8192 + blk * 2;
#pragma unroll
      for (int k = 0; k < 32; k += 2) { const float4 kq = *(const float4*)(KF + (k >> 1) * 512);
          y[k] = make_float2(y[k].x * kq.x - y[k].y * kq.y, y[k].x * kq.y + y[k].y * kq.x); y[k + 1] = make_float2(y[k + 1].x * kq.z - y[k + 1].y * kq.w, y[k + 1].x * kq.w + y[k + 1].y * kq.z); }
      radix32<true>(y);
#pragma unroll
      for (int k = 0; k < 32; ++k) B[k] = y[k]; }
    __syncthreads();
    { const float r2 = launder_f((float)(tid & 31) * (1.0f / 512.0f));
#pragma unroll
      for (int ch = 0; ch < 2; ++ch) fft_pass2<true>(B0 + ch * FFT_BUF, tid, r2); }
    __syncthreads();
    bf16_t* MIX = (bf16_t*)(p.ws + OFF_MIX);
    const float2 dsk = *(const float2*)(inp(15) + l * 768 + c0);
    const float rfi = launder_f(rf);
    { unsigned long long zp = (unsigned long long)ZT; asm volatile("" : "+s"(zp)); ZT = (const float*)zp; }
#pragma unroll 1
    for (int ch = 0; ch < 2; ++ch) { float2 x[16]; float2* B = B0 + ch * FFT_BUF;
#pragma unroll
        for (int k = 0; k < 16; ++k) x[k] = B[phys(tid + 512 * k)];
        radix16<true>(x, rfi);
        const float d = ch ? dsk.y : dsk.x; const float* z = ZT + ch * 8192 + tid; const float* x0 = X0T + ch * 8192 + tid;
        if (ch == 0) {
#pragma unroll
            for (int k = 0; k < 8; ++k) B0[phys(tid + 512 * k)] = make_float2(x0[512 * k] * (x[k].x + d * z[512 * k]), x0[4096 + 512 * k] * (x[k].y + d * z[4096 + 512 * k]));
        } else {
#pragma unroll
            for (int k = 0; k < 8; ++k) { const int t = tid + 512 * k; const float2 r0 = B0[phys(t)];
                const float r1a = x0[512 * k] * (x[k].x + d * z[512 * k]), r1b = x0[4096 + 512 * k] * (x[k].y + d * z[4096 + 512 * k]);
                *(unsigned*)(MIX + (size_t)t * D_MODEL + MIX_HY + c0) = cvt_pk_bf16(r0.x, r1a);
                *(unsigned*)(MIX + (size_t)(4096 + t) * D_MODEL + MIX_HY + c0) = cvt_pk_bf16(r0.y, r1b); }
        } }
    __syncthreads();
}

__device__ void convact_phase(const Params& p, int l) {
    const bf16_t* UP = (const bf16_t*)(p.ws + OFF_UP); bf16_t* ACT = (bf16_t*)(p.ws + OFF_ACT);
    const float* cw = inp(23) + (size_t)l * 3 * D_UP; const float* cb = inp(24) + (size_t)l * D_UP;
    const int nthr = gridDim.x * 512;
    const int tid = tid_l();
    for (int idx = blockIdx.x * 512 + tid; idx < 704 * 512; idx += nthr) {
        const int cg8 = idx % 704, run = idx / 704; const int j = cg8 >> 4, i8 = (cg8 & 15) * 8;
        const int ncol = j * 128 + i8;
        float wg[3][8], wv[3][8], bg[8], bv[8];
#pragma unroll
        for (int k = 0; k < 3; ++k) { const float4 a = *(const float4*)(cw + k * D_UP + ncol), b = *(const float4*)(cw + k * D_UP + ncol + 4);
            wg[k][0] = a.x; wg[k][1] = a.y; wg[k][2] = a.z; wg[k][3] = a.w; wg[k][4] = b.x; wg[k][5] = b.y; wg[k][6] = b.z; wg[k][7] = b.w;
            const float4 c = *(const float4*)(cw + k * D_UP + D_FF + ncol), d = *(const float4*)(cw + k * D_UP + D_FF + ncol + 4);
            wv[k][0] = c.x; wv[k][1] = c.y; wv[k][2] = c.z; wv[k][3] = c.w; wv[k][4] = d.x; wv[k][5] = d.y; wv[k][6] = d.z; wv[k][7] = d.w; }
        { const float4 a = *(const float4*)(cb + ncol), b = *(const float4*)(cb + ncol + 4); bg[0] = a.x; bg[1] = a.y; bg[2] = a.z; bg[3] = a.w; bg[4] = b.x; bg[5] = b.y; bg[6] = b.z; bg[7] = b.w;
          const float4 c = *(const float4*)(cb + D_FF + ncol), d = *(const float4*)(cb + D_FF + ncol + 4); bv[0] = c.x; bv[1] = c.y; bv[2] = c.z; bv[3] = c.w; bv[4] = d.x; bv[5] = d.y; bv[6] = d.z; bv[7] = d.w; }
        const int r0 = run * 16; const size_t colg = (size_t)j * 256 + i8, colv = colg + 128;
        u32x4 gm = (u32x4){0u, 0u, 0u, 0u}, vm = gm, gc, vc, gn, vn;
        if ((r0 & (SEQ - 1)) != 0) { gm = *(const u32x4*)(UP + (size_t)(r0 - 1) * D_UP + colg); vm = *(const u32x4*)(UP + (size_t)(r0 - 1) * D_UP + colv); }
        gc = *(const u32x4*)(UP + (size_t)r0 * D_UP + colg); vc = *(const u32x4*)(UP + (size_t)r0 * D_UP + colv);
        for (int r = r0; r < r0 + 16; ++r) {
            if ((r & (SEQ - 1)) != SEQ - 1) { gn = *(const u32x4*)(UP + (size_t)(r + 1) * D_UP + colg); vn = *(const u32x4*)(UP + (size_t)(r + 1) * D_UP + colv); }
            else { gn = (u32x4){0u, 0u, 0u, 0u}; vn = gn; }
            float o[8];
#pragma unroll
            for (int q = 0; q < 4; ++q) {
                const float ga = wg[0][2 * q] * lo_bf(gm[q]) + wg[1][2 * q] * lo_bf(gc[q]) + wg[2][2 * q] * lo_bf(gn[q]) + bg[2 * q];
                const float gb = wg[0][2 * q + 1] * hi_bf(gm[q]) + wg[1][2 * q + 1] * hi_bf(gc[q]) + wg[2][2 * q + 1] * hi_bf(gn[q]) + bg[2 * q + 1];
                const float va = wv[0][2 * q] * lo_bf(vm[q]) + wv[1][2 * q] * lo_bf(vc[q]) + wv[2][2 * q] * lo_bf(vn[q]) + bv[2 * q];
                const float vb = wv[0][2 * q + 1] * hi_bf(vm[q]) + wv[1][2 * q + 1] * hi_bf(vc[q]) + wv[2][2 * q + 1] * hi_bf(vn[q]) + bv[2 * q + 1];
                o[2 * q] = silu(ga) * va; o[2 * q + 1] = silu(gb) * vb; }
            u32x4 ow; ow.x = cvt_pk_bf16(o[0], o[1]); ow.y = cvt_pk_bf16(o[2], o[3]); ow.z = cvt_pk_bf16(o[4], o[5]); ow.w = cvt_pk_bf16(o[6], o[7]);
            *(u32x4*)(ACT + (size_t)r * D_FF + ncol) = ow;
            gm = gc; vm = vc; gc = gn; vc = vn;
        }
    }
}

__global__ void __launch_bounds__(512, 2) fwd_megakernel(Params p) {
    extern __shared__ __attribute__((aligned(16))) unsigned char smem[];
    cg::grid_group grid = cg::this_grid();
    const int G = gridDim.x, bid = blockIdx.x;
    int step = 0;
    if (p.ph_hi < 0) grid.sync();
    volatile LAS unsigned* xst = (volatile LAS unsigned*)(LAS unsigned char*)(smem + LDS_BYTES - 16);
    if (threadIdx.x < 4) xst[threadIdx.x] = 0u;
    __syncthreads();
    XcdBarrier xb = xcd_barrier_post((unsigned*)(p.ws + OFF_BAR), xst);
#define STEP_BEGIN if (step >= p.ph_lo && step < p.ph_hi) {
#define STEP_END } ++step; if (step > p.ph_lo && step < p.ph_hi) xcd_barrier(xb);

    bf16_t* H = (bf16_t*)(p.ws + OFF_H);
    bf16_t* XA = (bf16_t*)(p.ws + OFF_XA);
#if PROBE == 6
    for (int i = 0; i < 20; ++i) xcd_barrier(xb);
#endif

    STEP_BEGIN
        for (int it = bid; it < NI_FILT; it += G) filter_item(p, it, (float*)smem);
        convert_range(p, 0, 0, 0, R_DN + 2 * NI_POOL, bid, G, (float*)smem);
        if (bid < 3) { const int zr = bid == 0 ? 0 : (bid == 1 ? 4097 : 8194); for (int i = tid_l(); i < D_MODEL / 2; i += 512) ((unsigned*)(H + (size_t)zr * D_MODEL))[i] = 0u; }
        norm_phase<true>(inp(0), inp(1), H, nullptr);
    STEP_END

    for (int l = 0; l < 2; ++l) {
        STEP_BEGIN
            pg8::Gemm g{H + D_MODEL, (const bf16_t*)(p.ws + OFF_WT_IN + l * SZ_WT_IN), NTOK, D_INP, D_MODEL}; pg8::StaticOrder S; S.init(NTOK, D_INP, G, bid);
            pg8::EpiBf16Gm E{(bf16_t*)(p.ws + OFF_P), D_INP, (float*)(p.ws + OFF_STATS) + (size_t)l * NTOK * 24};
            pg8::gemm_phase<pg8::EpiBf16Gm, pg8::StaticOrder, D_MODEL>((LAS unsigned char*)smem, g, S, E);
            { const int rem = (NTOK / 256) * (D_INP / 256) % G;
              if (bid >= rem) for (int rep_ = 0; rep_ < (PROBE == 11 ? 2 : 1); ++rep_) {
                  if (l == 0) { for (int it = bid - rem; it < 768; it += G - rem) kf_item(p, it, smem); convert_range(p, 1, 1, 0, NI_IN, bid - rem, G - rem, (float*)smem); convert_range(p, 1, 0, R_DN + NT3, NI_DN - NT3, bid - rem, G - rem, (float*)smem); }
                  else { convert_range(p, 1, 1, R_OUT, NI_OUT + NI_UP, bid - rem, G - rem, (float*)smem); convert_range(p, 1, 1, R_DN + NT3, NI_DN - NT3, bid - rem, G - rem, (float*)smem); } } }
        STEP_END
        STEP_BEGIN
            for (int it = bid; it < 768; it += G) hypre_item(p, l, it, smem);
        STEP_END
        STEP_BEGIN
            for (int rep_ = 0; rep_ < (PROBE == 13 ? 2 : 1); ++rep_) {
            unsigned* wq = (unsigned*)(p.ws + OFF_BAR) + 3500 + l + 8 * rep_;
            for (;;) {
                __syncthreads();
                if (threadIdx.x == 0) xst[2] = atomicAdd(wq, 1u);
                __syncthreads();
                const int it = __builtin_amdgcn_readfirstlane((int)xst[2]);
                if (it >= 384 + 128 + 256) break;
                if (it < 384) fft_item(p, l, it, smem); else if (it < 512) gmlp_item(p, l, it - 384, smem); else pool_item(p, l, it - 512, smem);
            }
            }
#if PROBE == 21
            for (int it = bid; it < 256; it += G) pool_item(p, l, it, smem);
#elif PROBE == 22
            for (int it = bid; it < 128; it += G) gmlp_item(p, l, it, smem);
#elif PROBE == 3
            for (int it = bid; it < 384; it += G) fft_item(p, l, it, smem);
#endif
        STEP_END
        STEP_BEGIN
            pg8::Gemm g{(const bf16_t*)(p.ws + OFF_MIX), (const bf16_t*)(p.ws + OFF_WT_OUT + l * SZ_WT_OUT), NTOK, D_MODEL, D_MODEL}; pg8::StaticOrder S; S.init(NTOK, D_MODEL, G, bid);
            if (l == 0) { pg8::EpiRes<true> E{XA, inp(0), D_MODEL}; pg8::gemm_phase<pg8::EpiRes<true>, pg8::StaticOrder, D_MODEL>((LAS unsigned char*)smem, g, S, E); }
            else { pg8::EpiRes<false> E{XA, XA, D_MODEL}; pg8::gemm_phase<pg8::EpiRes<false>, pg8::StaticOrder, D_MODEL>((LAS unsigned char*)smem, g, S, E); }
        STEP_END
        STEP_BEGIN
            norm_phase<false>(XA, inp(21) + l * D_MODEL, H, nullptr);
        STEP_END
        STEP_BEGIN
            pg8::Gemm g{H, (const bf16_t*)(p.ws + OFF_WT_UP + l * SZ_WT_UP), NTOK, D_UP, D_MODEL}; pg8::StaticOrder S; S.init_tiles(34, D_UP / 256, G, bid);
            pg8::EpiConvAct E{(bf16_t*)(p.ws + OFF_ACT), inp(23) + (size_t)l * 3 * D_UP, inp(24) + (size_t)l * D_UP};
            pg8::gemm_phase<pg8::EpiConvAct, pg8::StaticOrder, D_MODEL>((LAS unsigned char*)smem, g, S, E);
#if PROBE == 7
            pg8::gemm_phase<pg8::EpiConvAct, pg8::StaticOrder, D_MODEL>((LAS unsigned char*)smem, g, S, E);
#endif
            { const int rem = (34 * (D_UP / 256)) % G; if (bid >= rem) convert_range(p, 1, l, R_DN, NT3, bid - rem, G - rem, (float*)smem); }
        STEP_END
        STEP_BEGIN
            pg8::Gemm g{(const bf16_t*)(p.ws + OFF_ACT), (const bf16_t*)(p.ws + OFF_WT_DN + l * SZ_WT_DN), NTOK, D_MODEL, D_FF}; pg8::StaticOrder S; S.init(NTOK, D_MODEL, G, bid);
            pg8::EpiRes<false> E{XA, XA, D_MODEL};
            pg8::gemm_phase<pg8::EpiRes<false>, pg8::StaticOrder, D_FF>((LAS unsigned char*)smem, g, S, E);
        STEP_END
        STEP_BEGIN
            if (l == 0) norm_phase<false>(XA, inp(1) + D_MODEL, H, nullptr); else norm_phase<false>(XA, inp(26), nullptr, p.out);
        STEP_END
    }
}

constexpr int N_STEPS = 17;
#ifndef MULTI_LAUNCH
#define MULTI_LAUNCH 0
#endif

extern "C" void kernel_launch(void* const* d_in, const int* in_sizes, int n_in, void* d_out, int out_size, void* d_ws, size_t ws_size, hipStream_t stream) {
    static int grid = 0;
    if (grid == 0) {
        if (n_in != 27 || ws_size < WS_END) { fprintf(stderr, "kernel_launch: need 27 inputs and %zu bytes of workspace (got %d, %zu)\n", (size_t)WS_END, n_in, ws_size); grid = -1; return; }
        int dev = 0, cus = 0, per_cu = 0;
        hipGetDevice(&dev); hipDeviceGetAttribute(&cus, hipDeviceAttributeMultiprocessorCount, dev);
        if (hipFuncSetAttribute((const void*)fwd_megakernel, hipFuncAttributeMaxDynamicSharedMemorySize, LDS_BYTES) != hipSuccess) { fprintf(stderr, "kernel_launch: hipFuncSetAttribute failed\n"); grid = -1; return; }
        if (hipOccupancyMaxActiveBlocksPerMultiprocessor(&per_cu, (const void*)fwd_megakernel, 512, LDS_BYTES) != hipSuccess || per_cu < 1) { fprintf(stderr, "kernel_launch: occupancy query gave %d\n", per_cu); per_cu = 1; }
        (void)hipGetLastError();
        grid = cus * 1;
    }
    if (grid < 0) return;
    if (hipMemsetAsync((char*)d_ws + OFF_BAR, 0, 16384, stream) != hipSuccess) { fprintf(stderr, "kernel_launch: memset failed\n"); return; }
    Params p{};
    for (int i = 0; i < 27; ++i) p.in[i] = (const float*)d_in[i];
    p.out = (float*)d_out; p.ws = (unsigned char*)d_ws;
#if MULTI_LAUNCH
    for (int s = 0; s < N_STEPS; ++s) { p.ph_lo = s; p.ph_hi = s + 1; hipLaunchKernelGGL(fwd_megakernel, dim3(grid), dim3(512), LDS_BYTES, stream, p); }
#else
    p.ph_lo = 0; p.ph_hi = N_STEPS;
    void* args[] = {&p};
    hipError_t e = hipLaunchCooperativeKernel((const void*)fwd_megakernel, dim3(grid), dim3(512), args, LDS_BYTES, stream);
    if (e != hipSuccess) fprintf(stderr, "cooperative launch failed: %s (grid %d)\n", hipGetErrorString(e), grid);
#endif
}
```

```cpp
#include <hip/hip_runtime.h>
#include <hip/hip_cooperative_groups.h>
#include <cstdio>
namespace cg = cooperative_groups;

#define LAS __attribute__((address_space(3)))
typedef unsigned short bf16_t;
typedef short bf16x8 __attribute__((ext_vector_type(8)));
typedef float f32x4 __attribute__((ext_vector_type(4)));
typedef unsigned u32x4 __attribute__((ext_vector_type(4)));
typedef unsigned u32x2 __attribute__((ext_vector_type(2)));

constexpr int D_MODEL = 2048, SEQ = 4096, NTOK = 8192, D_INP = 4352, D_FF = 5632, D_UP = 11264;
constexpr int D_HY = 768, D_GM = 768;
constexpr int COL_HY = 512, COL_GM = 2816;
constexpr int MIX_HY = 512, MIX_GM = 1280;

constexpr size_t SZ_WT_IN = (size_t)D_INP * D_MODEL * 2, SZ_WT_OUT = (size_t)D_MODEL * D_MODEL * 2, SZ_WT_UP = (size_t)D_UP * D_MODEL * 2, SZ_WT_DN = (size_t)D_MODEL * D_FF * 2;
constexpr size_t SZ_POOLWT = 4 * 128 * 128 * 2, SZ_KF = (size_t)768 * 8192 * 8, SZ_H2 = (size_t)4096 * 64 * 4, SZ_STATS = (size_t)NTOK * 12 * 2 * 4;
constexpr size_t OFF_WT_IN = 0;
constexpr size_t OFF_WT_OUT = OFF_WT_IN + 2 * SZ_WT_IN;
constexpr size_t OFF_WT_UP = OFF_WT_OUT + 2 * SZ_WT_OUT;
constexpr size_t OFF_WT_DN = OFF_WT_UP + 2 * SZ_WT_UP;
constexpr size_t OFF_POOLWT = OFF_WT_DN + 2 * SZ_WT_DN;
constexpr size_t OFF_KF = OFF_POOLWT + 2 * SZ_POOLWT;
constexpr size_t OFF_H2 = OFF_KF + 2 * SZ_KF;
constexpr size_t OFF_STATS = OFF_H2 + 2 * SZ_H2;
constexpr size_t OFF_XA = OFF_STATS + 2 * SZ_STATS;
constexpr size_t OFF_H = OFF_XA + (size_t)NTOK * D_MODEL * 4;
constexpr size_t OFF_R1 = OFF_H + (size_t)(NTOK + 512) * D_MODEL * 2;
constexpr size_t OFF_P = OFF_R1;
constexpr size_t OFF_MIX = OFF_P + (size_t)NTOK * D_INP * 2;
constexpr size_t OFF_ZT = OFF_MIX + (size_t)NTOK * D_MODEL * 2;
constexpr size_t OFF_X0T = OFF_ZT + (size_t)768 * 8192 * 4;
constexpr size_t OFF_UP = OFF_R1;
constexpr size_t OFF_ACT = OFF_R1 + (size_t)NTOK * D_UP * 2;
constexpr size_t OFF_BAR = OFF_ACT + (size_t)NTOK * D_FF * 2;
constexpr size_t WS_END = OFF_BAR + 16384;
static_assert(OFF_X0T + (size_t)768 * 8192 * 4 <= OFF_ACT, "alias region");

constexpr int LDS_BYTES = 139264;
#ifndef PROBE
#define PROBE 0
#endif
#define REP(k) for (int rep_ = 0; rep_ < ((PROBE == (k)) ? 2 : 1); ++rep_)

struct Params {
    const float* in[27];
    float* out;
    unsigned char* ws;
    int ph_lo, ph_hi;
};


__device__ __forceinline__ const float* inp(int i) {
    const __attribute__((address_space(4))) char* ka = (const __attribute__((address_space(4))) char*)__builtin_amdgcn_kernarg_segment_ptr();
    int off = i * 8; asm volatile("" : "+s"(off));
    return *(const float* const __attribute__((address_space(4)))*)(ka + off);
}

__device__ __forceinline__ int tid_l() { int t = threadIdx.x; asm volatile("" : "+v"(t)); return t; }
__device__ __forceinline__ float bf2f(bf16_t b) { return __uint_as_float(((unsigned)b) << 16); }
__device__ __forceinline__ unsigned cvt_pk_bf16(float lo, float hi) { unsigned r; asm volatile("v_cvt_pk_bf16_f32 %0, %1, %2" : "=v"(r) : "v"(lo), "v"(hi)); return r; }
__device__ __forceinline__ float lo_bf(unsigned u) { return __uint_as_float(u << 16); }
__device__ __forceinline__ float hi_bf(unsigned u) { return __uint_as_float(u & 0xffff0000u); }
__device__ __forceinline__ float gelu_tanh(float x) {
    const float y2 = 1.5957691216f * (x + 0.044715f * x * x * x);
    return x * __builtin_amdgcn_rcpf(1.0f + __expf(-y2));
}
__device__ __forceinline__ float silu(float x) { return x * __builtin_amdgcn_rcpf(1.0f + __expf(-x)); }
__device__ __forceinline__ float wave_sum(float v) {
#pragma unroll
    for (int o = 32; o > 0; o >>= 1) v += __shfl_xor(v, o, 64);
    return v;
}

#define XB_TMO      128
#define XB_XCNT(j)  (256  + 64 * (j))
#define XB_XSUB(j)  (1280 + 64 * (j))
#define XB_XGEN(j)  (2304 + 64 * (j))
#define XB_TOP      3328
#define XB_TOPGEN   3392
#define XCD_BAR_WORDS 3456
#define XB_SPIN_CAP (1u << 18)

__device__ __forceinline__ unsigned xb_ld(unsigned* p)              { return __hip_atomic_load(p, __ATOMIC_RELAXED, __HIP_MEMORY_SCOPE_AGENT); }
__device__ __forceinline__ unsigned xb_add(unsigned* p, unsigned v) { return __hip_atomic_fetch_add(p, v, __ATOMIC_RELAXED, __HIP_MEMORY_SCOPE_AGENT); }
__device__ __forceinline__ unsigned xb_xcc_id() { return (unsigned)__builtin_amdgcn_s_getreg((3 << 11) | 20) & 0xFu; }
#define XB_SPIN(cond, bar) do { unsigned _sp = 0; while (cond) { __builtin_amdgcn_s_sleep(1); \
    if ((++_sp & 255u) == 0u) { if (xb_ld(&(bar)[XB_TMO])) break; if (_sp > XB_SPIN_CAP) { atomicAdd(&(bar)[XB_TMO], 1u); break; } } } } while (0)

struct XcdBarrier {
    unsigned* bar; unsigned x;
    volatile LAS unsigned* st;
};

__device__ __forceinline__ XcdBarrier xcd_barrier_post(unsigned* bar, volatile LAS unsigned* st) {
    XcdBarrier b; b.bar = bar; b.x = xb_xcc_id(); b.st = st;
    if (threadIdx.x == 0) (void)xb_add(&bar[XB_XCNT(b.x)], 1u);
    return b;
}
__device__ __forceinline__ void xcd_barrier_complete(unsigned* bar, unsigned x, unsigned& nloc, unsigned& nx) {
    const unsigned G = gridDim.x * gridDim.y * gridDim.z;
    unsigned sum, cnt, mine, sp = 0u;
    for (;;) {
        sum = 0u; cnt = 0u; mine = 0u;
#pragma unroll
        for (unsigned j = 0; j < 16; ++j) { const unsigned c = xb_ld(&bar[XB_XCNT(j)]); sum += c; cnt += (c > 0u) ? 1u : 0u; mine = (j == x) ? c : mine; }
        if (sum == G) break;
        __builtin_amdgcn_s_sleep(1);
        if ((++sp & 255u) == 0u) { if (xb_ld(&bar[XB_TMO])) break; if (sp > XB_SPIN_CAP) { atomicAdd(&bar[XB_TMO], 1u); break; } }
    }
    nloc = mine > 0u ? mine : 1u; nx = cnt > 0u ? cnt : 1u;
}

__device__ __forceinline__ void xcd_barrier(const XcdBarrier& b) {
    asm volatile("s_waitcnt vmcnt(0)" ::: "memory");
    __syncthreads();
    if (threadIdx.x == 0) {
        unsigned* bar = b.bar;
        __builtin_amdgcn_s_waitcnt(0);
        unsigned nloc = b.st[0], nx = b.st[1];
        if (nloc == 0u) { xcd_barrier_complete(bar, b.x, nloc, nx); b.st[0] = nloc; b.st[1] = nx; }
        const unsigned old = xb_add(&bar[XB_XSUB(b.x)], 1u);
        const unsigned gen = old / nloc;
        if (old + 1u == (gen + 1u) * nloc) {
            __builtin_amdgcn_fence(__ATOMIC_RELEASE, "agent");
            asm volatile("s_waitcnt vmcnt(0)" ::: "memory");
            const unsigned og = xb_add(&bar[XB_TOP], 1u);
            const unsigned tg = og / nx;
            if (og + 1u == (tg + 1u) * nx) xb_add(&bar[XB_TOPGEN], 1u);
            else XB_SPIN(xb_ld(&bar[XB_TOPGEN]) == tg, bar);
            __builtin_amdgcn_fence(__ATOMIC_ACQUIRE, "agent");
            xb_add(&bar[XB_XGEN(b.x)], 1u);
            asm volatile("s_waitcnt vmcnt(0)" ::: "memory");
        } else {
            XB_SPIN(xb_ld(&bar[XB_XGEN(b.x)]) == gen, bar);
            __builtin_amdgcn_fence(__ATOMIC_ACQUIRE, "agent");
            asm volatile("s_waitcnt vmcnt(0)" ::: "memory");
        }
    }
    __syncthreads();
}


namespace pg8 {
constexpr int BM = 256, BK = 64, HALF = 128, HTB = HALF * BK * 2, STAGE_BYTES = 8 * HTB, NXCD = 8, WGM = 8;
__host__ __device__ __forceinline__ int lds_byte(int r, int c) { const int st = (r >> 4) * 2 + (c >> 5), rr = r & 15, cc = c & 31, ob = rr * 64 + cc * 2; return st * 1024 + (ob ^ (((ob >> 9) & 1) << 5)); }
__host__ __device__ __forceinline__ void stage_rc(int b, int& R, int& C) { const int st = b / 1024, sb = b % 1024, swz = sb ^ (((sb >> 9) & 1) << 5); R = (st >> 1) * 16 + swz / 64; C = (st & 1) * 32 + (swz % 64) / 2; }
__host__ __device__ __forceinline__ int perm32(int rho) { const int n = rho >> 4, i = rho & 15; return 8 * (i >> 2) + 4 * n + (i & 3); }
struct Unit { int pm, pn; };
struct Gemm { const bf16_t* A; const bf16_t* Bt; int M, N, K; };
struct StaticOrder {
    int nM, nN, nwg, G, c;
    __device__ void init(int M, int N, int G_, int c_) { nM = M / BM; nN = N / BM; nwg = nM * nN; G = G_; c = c_; }
    __device__ void init_tiles(int nM_, int nN_, int G_, int c_) { nM = nM_; nN = nN_; nwg = nM * nN; G = G_; c = c_; }
    __device__ bool next(int i, Unit& u) const {
        const long L = (long)i * G + c; if (L >= nwg) return false;
        int wgid = (int)L; { const int q = nwg / NXCD, r = nwg % NXCD, xcd = wgid % NXCD, off = wgid / NXCD; wgid = (xcd < r ? xcd * (q + 1) : r * (q + 1) + (xcd - r) * q) + off; }
        const int nig = WGM * nN, gid = wgid / nig, fm = gid * WGM, gsz = (nM - fm) < WGM ? (nM - fm) : WGM;
        u.pm = fm + ((wgid % nig) % gsz); u.pn = (wgid % nig) / gsz; return true;
    }
};
struct EpiBf16 {
    static constexpr bool PERM = true, CONV = false; static constexpr int GAPA = 0;
    bf16_t* O; int ldc;
    __device__ __forceinline__ void operator()(const f32x4 (&acc)[2][2][4][2], const Unit& u, int wr, int wc, int fr, int fq) const {
        const int row0 = u.pm * BM + wr * 64 + fr; const int col0 = u.pn * BM + wc * 32 + 8 * fq;
#pragma unroll
        for (int ai = 0; ai < 2; ++ai)
#pragma unroll
            for (int m = 0; m < 4; ++m) { bf16_t* rowp = O + (size_t)(row0 + ai * HALF + m * 16) * ldc + col0;
#pragma unroll
                for (int bj = 0; bj < 2; ++bj) { const f32x4 v0 = acc[ai][bj][m][0], v1 = acc[ai][bj][m][1];
                    u32x4 w; w.x = cvt_pk_bf16(v0[0], v0[1]); w.y = cvt_pk_bf16(v0[2], v0[3]); w.z = cvt_pk_bf16(v1[0], v1[1]); w.w = cvt_pk_bf16(v1[2], v1[3]);
                    *(u32x4*)(rowp + bj * HALF) = w; } }
    }
};
struct EpiBf16Gm {
    static constexpr bool PERM = true, CONV = false; static constexpr int GAPA = D_MODEL * 2;
    bf16_t* O; int ldc; float* stats;
    __device__ __forceinline__ void operator()(const f32x4 (&acc)[2][2][4][2], const Unit& u, int wr, int wc, int fr, int fq) const {
        const int row0 = u.pm * BM + wr * 64 + fr; const int col0 = u.pn * BM + wc * 32 + 8 * fq;
        const bool act = u.pn >= 11, st = u.pn >= 14;
#pragma unroll
        for (int ai = 0; ai < 2; ++ai)
#pragma unroll
            for (int m = 0; m < 4; ++m) { const int row = row0 + ai * HALF + m * 16; bf16_t* rowp = O + (size_t)row * ldc + col0; float s1 = 0.f, s2 = 0.f;
#pragma unroll
                for (int bj = 0; bj < 2; ++bj) { f32x4 v0 = acc[ai][bj][m][0], v1 = acc[ai][bj][m][1];
                    if (act) {
#pragma unroll
                        for (int j = 0; j < 4; ++j) { v0[j] = gelu_tanh(v0[j]); v1[j] = gelu_tanh(v1[j]); s1 += v0[j] + v1[j]; s2 += v0[j] * v0[j] + v1[j] * v1[j]; } }
                    u32x4 w; w.x = cvt_pk_bf16(v0[0], v0[1]); w.y = cvt_pk_bf16(v0[2], v0[3]); w.z = cvt_pk_bf16(v1[0], v1[1]); w.w = cvt_pk_bf16(v1[2], v1[3]);
                    *(u32x4*)(rowp + bj * HALF) = w; }
                if (st) { s1 += __shfl_xor(s1, 16, 64); s2 += __shfl_xor(s2, 16, 64); s1 += __shfl_xor(s1, 32, 64); s2 += __shfl_xor(s2, 32, 64);
                    if (fq == 0) *(float2*)(stats + ((size_t)row * 12 + (u.pn - 14) * 4 + wc) * 2) = make_float2(s1, s2); } }
    }
};
__device__ __forceinline__ float dpp_ror1(float v) { return __builtin_bit_cast(float, __builtin_amdgcn_mov_dpp(__builtin_bit_cast(int, v), 0x121, 0xf, 0xf, true)); }
__device__ __forceinline__ float dpp_rol1(float v) { return __builtin_bit_cast(float, __builtin_amdgcn_mov_dpp(__builtin_bit_cast(int, v), 0x12F, 0xf, 0xf, true)); }
struct EpiConvAct {
    static constexpr bool PERM = true, CONV = true; static constexpr int GAPA = 0;
    bf16_t* ACT; const float* cw; const float* cb;
    __device__ __forceinline__ void operator()(const f32x4 (&acc)[2][2][4][2], const Unit& u, int wr, int wc, int fr, int fq) const {
        const bool f0 = fr == 0, f15 = fr == 15;
#pragma unroll
        for (int n = 0; n < 2; ++n) {
            const int cg = 128 * u.pn + 32 * wc + 8 * fq + 4 * n;
            f32x4 wg[3], wv[3];
#pragma unroll
            for (int k = 0; k < 3; ++k) { wg[k] = *(const f32x4*)(cw + k * D_UP + cg); wv[k] = *(const f32x4*)(cw + k * D_UP + D_FF + cg); }
            const f32x4 bg = *(const f32x4*)(cb + cg), bv = *(const f32x4*)(cb + D_FF + cg);
#pragma unroll
            for (int ai = 0; ai < 2; ++ai) { const int pbase = 248 * u.pm + 62 * (2 * ai + wr);
                float rpg[4], rpv[4], lcg[4], lcv[4];
#pragma unroll
                for (int j = 0; j < 4; ++j) { rpg[j] = 0.f; rpv[j] = 0.f; lcg[j] = dpp_rol1(acc[ai][0][0][n][j]); lcv[j] = dpp_rol1(acc[ai][1][0][n][j]); }
#pragma unroll
                for (int m = 0; m < 4; ++m) { const int q = 16 * m + fr, pr = pbase + q; const int G = pr - 1 - (pr > 4097 ? 1 : 0);
                    const f32x4 gc = acc[ai][0][m][n], vc = acc[ai][1][m][n]; float o[4];
#pragma unroll
                    for (int j = 0; j < 4; ++j) {
                        const float rg = dpp_ror1(gc[j]), rv = dpp_ror1(vc[j]);
                        const float gp = (m > 0 && f0) ? rpg[j] : rg, vp = (m > 0 && f0) ? rpv[j] : rv;
                        float gn = lcg[j], vn = lcv[j];
                        if (m < 3) { const float a = dpp_rol1(acc[ai][0][m + 1][n][j]), b = dpp_rol1(acc[ai][1][m + 1][n][j]); gn = f15 ? a : gn; vn = f15 ? b : vn; lcg[j] = a; lcv[j] = b; }
                        rpg[j] = rg; rpv[j] = rv;
                        const float ga = __builtin_fmaf(wg[0][j], gp, __builtin_fmaf(wg[1][j], gc[j], __builtin_fmaf(wg[2][j], gn, bg[j])));
                        float va = __builtin_fmaf(wv[2][j], vn, bv[j]); asm volatile("" : "+v"(va));
                        va = __builtin_fmaf(wv[1][j], vc[j], va); asm volatile("" : "+v"(va));
                        va = __builtin_fmaf(wv[0][j], vp, va);
                        o[j] = silu(ga) * va; }
                    if (q >= 1 && q <= 62 && pr >= 1 && pr != 4097 && pr <= 8193) { u32x2 ow; ow.x = cvt_pk_bf16(o[0], o[1]); ow.y = cvt_pk_bf16(o[2], o[3]); *(u32x2*)(ACT + (size_t)G * D_FF + cg) = ow; } } }
        }
    }
};
template <bool RF32> struct EpiRes {
    static constexpr bool PERM = true, CONV = false; static constexpr int GAPA = 0;
    bf16_t* C; const void* R; int ldc;
    __device__ __forceinline__ void operator()(const f32x4 (&acc)[2][2][4][2], const Unit& u, int wr, int wc, int fr, int fq) const {
        const int row0 = u.pm * BM + wr * 64 + fr, col0 = u.pn * BM + wc * 32 + 8 * fq;
#pragma unroll
        for (int ai = 0; ai < 2; ++ai)
#pragma unroll
            for (int m = 0; m < 4; ++m) { const size_t ro = (size_t)(row0 + ai * HALF + m * 16) * ldc + col0;
#pragma unroll
                for (int bj = 0; bj < 2; ++bj) { f32x4 r0, r1;
                    if (RF32) { const float* rp = (const float*)R + ro + bj * HALF; r0 = *(const f32x4*)rp; r1 = *(const f32x4*)(rp + 4); }
                    else { const u32x4 rr = *(const u32x4*)((const bf16_t*)R + ro + bj * HALF);
                        r0 = (f32x4){lo_bf(rr.x), hi_bf(rr.x), lo_bf(rr.y), hi_bf(rr.y)}; r1 = (f32x4){lo_bf(rr.z), hi_bf(rr.z), lo_bf(rr.w), hi_bf(rr.w)}; }
                    const f32x4 o0 = acc[ai][bj][m][0] + r0, o1 = acc[ai][bj][m][1] + r1;
                    u32x4 w; w.x = cvt_pk_bf16(o0[0], o0[1]); w.y = cvt_pk_bf16(o0[2], o0[3]); w.z = cvt_pk_bf16(o1[0], o1[1]); w.w = cvt_pk_bf16(o1[2], o1[3]);
                    *(u32x4*)(C + ro + bj * HALF) = w; } }
    }
};

template <class Epi, class Sched, int KDIM>
__device__ __forceinline__ void gemm_phase(LAS unsigned char* lds, const Gemm g, const Sched& S, const Epi& E) {
    int tid_ = threadIdx.x; asm volatile("" : "+v"(tid_));
    const int tid = tid_, wid = __builtin_amdgcn_readfirstlane(tid >> 6), lane = tid & 63, wr = wid >> 2, wc = wid & 3, fr = lane & 15, fq = lane >> 4;
    constexpr int K = KDIM, nt = K / BK;
    unsigned voffA[2], voffB[2];
#pragma unroll
    for (int i = 0; i < 2; ++i) { int R, C; stage_rc(tid * 16 + i * 8192, R, C); const int Rb = Epi::PERM ? ((R & ~31) + perm32(R & 31)) : R;
        const int Ra = Epi::CONV ? (62 * (R >> 6) + (R & 63)) : R;
        voffA[i] = (unsigned)(Ra * K + C) * 2u; voffB[i] = (unsigned)(Rb * K + C) * 2u; }
    const size_t kstep = (size_t)(BK * 2);
    const size_t hstep = (size_t)HALF * K * 2;
    const size_t tstep = 2 * hstep;
    const size_t hstepA = Epi::CONV ? (size_t)124 * K * 2 : hstep, tstepA = 2 * hstepA;
    const unsigned ldsw = (unsigned)wid * 1024u;
    const int aoff = lds_byte(wr * 64 + fr, fq * 8), boff = lds_byte(wc * 32 + fr, fq * 8);
#define PG8_SA(b, h) (((b) * 2 + (h)) * HTB)
#define PG8_SB(b, h) ((4 + (b) * 2 + (h)) * HTB)
#define PG8_STAGE(bufoff, gbase, voff) do { _Pragma("unroll") for (int _i = 0; _i < 2; ++_i) \
        __builtin_amdgcn_global_load_lds((const unsigned*)((const char*)(gbase) + (voff)[_i]), (LAS unsigned*)(lds + (bufoff) + ldsw + _i * 8192), 16, 0, 0); } while (0)
#define PG8_LDA(dst, b, h) do { _Pragma("unroll") for (int m = 0; m < 4; ++m) _Pragma("unroll") for (int k = 0; k < 2; ++k) dst[m][k] = *(const LAS bf16x8*)(lds + PG8_SA(b, h) + aoff + m * 2048 + k * 1024); } while (0)
#define PG8_LDB(dst, b, h) do { _Pragma("unroll") for (int n = 0; n < 2; ++n) _Pragma("unroll") for (int k = 0; k < 2; ++k) dst[n][k] = *(const LAS bf16x8*)(lds + PG8_SB(b, h) + boff + n * 2048 + k * 1024); } while (0)
#define PG8_MMA(ai, bj, At, Bt) do { __builtin_amdgcn_s_setprio(1); _Pragma("unroll") for (int m = 0; m < 4; ++m) _Pragma("unroll") for (int n = 0; n < 2; ++n) _Pragma("unroll") for (int k = 0; k < 2; ++k) \
        acc[ai][bj][m][n] = __builtin_amdgcn_mfma_f32_16x16x32_bf16(Bt[n][k], At[m][k], acc[ai][bj][m][n], 0, 0, 0); __builtin_amdgcn_s_setprio(0); } while (0)
#define PG8_WAIT_V(n) asm volatile("s_waitcnt vmcnt(" #n ")" ::: "memory")
#define PG8_WAIT_L(n) asm volatile("s_waitcnt lgkmcnt(" #n ")" ::: "memory")
#define PG8_BAR __builtin_amdgcn_s_barrier()
#define PG8_SCHED __builtin_amdgcn_sched_barrier(0)
    Unit cur, nxt; int ui = 0;
    if (!S.next(0, cur)) return;
    f32x4 acc[2][2][4][2];
#pragma unroll
    for (int a = 0; a < 2; ++a)
#pragma unroll
        for (int b = 0; b < 2; ++b)
#pragma unroll
            for (int m = 0; m < 4; ++m)
#pragma unroll
                for (int n = 0; n < 2; ++n) acc[a][b][m][n] = (f32x4){0.f, 0.f, 0.f, 0.f};
    bf16x8 At[4][2], B0[2][2], B1[2][2];
    const char* cA = (const char*)g.A + (size_t)cur.pm * tstepA + (cur.pm >= 16 ? Epi::GAPA : 0); const char* cB = (const char*)g.Bt + (size_t)cur.pn * tstep;
    PG8_STAGE(PG8_SB(0, 0), cB, voffB); PG8_STAGE(PG8_SA(0, 0), cA, voffA); PG8_STAGE(PG8_SB(0, 1), cB + hstep, voffB); PG8_STAGE(PG8_SA(0, 1), cA + hstepA, voffA);
    if (wr == 1) PG8_BAR;
    PG8_WAIT_V(4); PG8_BAR;
    PG8_STAGE(PG8_SB(1, 0), cB + kstep, voffB); PG8_STAGE(PG8_SA(1, 0), cA + kstep, voffA); PG8_STAGE(PG8_SB(1, 1), cB + hstep + kstep, voffB);
    PG8_WAIT_V(6); PG8_BAR;
    for (;;) {
        const bool has_next = S.next(ui + 1, nxt);
        const char* nA = has_next ? (const char*)g.A + (size_t)nxt.pm * tstepA + (nxt.pm >= 16 ? Epi::GAPA : 0) : cA; const char* nB = has_next ? (const char*)g.Bt + (size_t)nxt.pn * tstep : cB;
        for (int t = 0; t < nt; t += 2) {
            const bool last = (t == nt - 2);
            const char* a1 = cA + (size_t)(t + 1) * kstep;
            const char* a2 = last ? nA : cA + (size_t)(t + 2) * kstep; const char* b2 = last ? nB : cB + (size_t)(t + 2) * kstep;
            const char* a3 = a2 + kstep; const char* b3 = b2 + kstep;
            PG8_LDB(B0, 0, 0); PG8_SCHED; PG8_LDA(At, 0, 0); PG8_STAGE(PG8_SA(1, 1), a1 + hstepA, voffA);
            PG8_WAIT_L(8); PG8_BAR; PG8_WAIT_L(0); PG8_MMA(0, 0, At, B0); PG8_BAR; PG8_SCHED;
            PG8_LDB(B1, 0, 1); PG8_STAGE(PG8_SB(0, 0), b2, voffB);
            PG8_BAR; PG8_WAIT_L(0); PG8_MMA(0, 1, At, B1); PG8_BAR;
            PG8_LDA(At, 0, 1); PG8_STAGE(PG8_SA(0, 0), a2, voffA);
            PG8_BAR; PG8_WAIT_L(0); PG8_MMA(1, 0, At, B0); PG8_BAR; PG8_SCHED;
            PG8_STAGE(PG8_SB(0, 1), b2 + hstep, voffB);
            PG8_WAIT_V(6); PG8_BAR; PG8_MMA(1, 1, At, B1); PG8_BAR;
            PG8_LDB(B0, 1, 0); PG8_SCHED; PG8_LDA(At, 1, 0); PG8_STAGE(PG8_SA(0, 1), a2 + hstepA, voffA);
            PG8_WAIT_L(8); PG8_BAR; PG8_WAIT_L(0); PG8_MMA(0, 0, At, B0); PG8_BAR; PG8_SCHED;
            PG8_LDB(B1, 1, 1); PG8_STAGE(PG8_SB(1, 0), b3, voffB);
            PG8_BAR; PG8_WAIT_L(0); PG8_MMA(0, 1, At, B1); PG8_BAR;
            PG8_LDA(At, 1, 1); PG8_STAGE(PG8_SA(1, 0), a3, voffA);
            PG8_BAR; PG8_WAIT_L(0); PG8_MMA(1, 0, At, B0); PG8_BAR; PG8_SCHED;
            PG8_STAGE(PG8_SB(1, 1), b3 + hstep, voffB);
            PG8_WAIT_V(6); PG8_BAR; PG8_MMA(1, 1, At, B1); PG8_BAR;
        }
        E(acc, cur, wr, wc, fr, fq);
        if (!has_next) break;
#pragma unroll
        for (int a = 0; a < 2; ++a)
#pragma unroll
            for (int b = 0; b < 2; ++b)
#pragma unroll
                for (int m = 0; m < 4; ++m)
#pragma unroll
                    for (int n = 0; n < 2; ++n) acc[a][b][m][n] = (f32x4){0.f, 0.f, 0.f, 0.f};
        cur = nxt; cA = nA; cB = nB; ++ui;
    }
    PG8_WAIT_V(0);
    if (wr == 0) PG8_BAR;
    PG8_BAR;
#undef PG8_SA
#undef PG8_SB
#undef PG8_STAGE
#undef PG8_LDA
#undef PG8_LDB
#undef PG8_MMA
#undef PG8_WAIT_V
#undef PG8_WAIT_L
#undef PG8_BAR
#undef PG8_SCHED
}
}

__device__ __forceinline__ void convert_tile(const float* __restrict__ W, int K, int N, bf16_t* __restrict__ Wt, int k0, int n0, int orow0, float* tile) {
    const int tid = tid_l();
    { const int r = tid >> 4, c4 = (tid & 15) * 4;
#pragma unroll
      for (int ps = 0; ps < 2; ++ps) { const int rr = r + ps * 32; const float4 v = *(const float4*)(W + (size_t)(k0 + rr) * N + n0 + c4);
          tile[rr * 65 + c4 + 0] = v.x; tile[rr * 65 + c4 + 1] = v.y; tile[rr * 65 + c4 + 2] = v.z; tile[rr * 65 + c4 + 3] = v.w; } }
    __syncthreads();
    { const int n = tid >> 3, k8 = (tid & 7) * 8; float v[8];
#pragma unroll
      for (int j = 0; j < 8; ++j) v[j] = tile[(k8 + j) * 65 + n];
      u32x4 w; w.x = cvt_pk_bf16(v[0], v[1]); w.y = cvt_pk_bf16(v[2], v[3]); w.z = cvt_pk_bf16(v[4], v[5]); w.w = cvt_pk_bf16(v[6], v[7]);
      *(u32x4*)(Wt + (size_t)(orow0 + n) * K + k0 + k8) = w; }
    __syncthreads();
}

constexpr int NI_IN = 32 * 68, NI_OUT = 32 * 32, NI_UP = 32 * 176, NI_DN = 88 * 32, NI_POOL = 16, NI_LAYER = NI_IN + NI_OUT + NI_UP + NI_DN + NI_POOL;
constexpr int NI_FILT = 256;
constexpr int NT3 = 1600;
constexpr int R_OUT = NI_IN, R_UP = NI_IN + NI_OUT, R_DN = NI_IN + NI_OUT + NI_UP, R_POOL = NI_IN + NI_OUT + NI_UP + NI_DN;
__device__ void convert_item(const Params& p, int l, int r, float* lds) {
    if (r < NI_IN) { const int tn = r / 32, tk = r % 32;
        convert_tile(inp(2) + (size_t)l * D_MODEL * D_INP, D_MODEL, D_INP, (bf16_t*)(p.ws + OFF_WT_IN + l * SZ_WT_IN), tk * 64, tn * 64, tn * 64, lds); return; }
    r -= NI_IN;
    if (r < NI_OUT) { const int tn = r / 32, tk = r % 32;
        convert_tile(inp(20) + (size_t)l * D_MODEL * D_MODEL, D_MODEL, D_MODEL, (bf16_t*)(p.ws + OFF_WT_OUT + l * SZ_WT_OUT), tk * 64, tn * 64, tn * 64, lds); return; }
    r -= NI_OUT;
    if (r < NI_UP) { const int tn = r / 32, tk = r % 32; const int n0 = tn * 64, s = n0 / D_FF, rem = n0 % D_FF, j = rem / 128, i = rem % 128;
        convert_tile(inp(22) + (size_t)l * D_MODEL * D_UP, D_MODEL, D_UP, (bf16_t*)(p.ws + OFF_WT_UP + l * SZ_WT_UP), tk * 64, n0, 256 * j + 128 * s + i, lds); return; }
    r -= NI_UP;
    if (r < NI_DN) { const int tn = r / 88, tk = r % 88;
        convert_tile(inp(25) + (size_t)l * D_FF * D_MODEL, D_FF, D_MODEL, (bf16_t*)(p.ws + OFF_WT_DN + l * SZ_WT_DN), tk * 64, tn * 64, tn * 64, lds); return; }
    r -= NI_DN;
    { const int g = r >> 2, tn = (r >> 1) & 1, tk = r & 1;
        convert_tile(inp(3) + (size_t)(l * 4 + g) * 128 * 128, 128, 128, (bf16_t*)(p.ws + OFF_POOLWT + l * SZ_POOLWT) + g * 128 * 128, tk * 64, tn * 64, tn * 64, lds); }
}

__device__ __forceinline__ float sin_rad(float x) { return __builtin_amdgcn_sinf(x * 0.15915494309f); }

struct CvDesc { const float* W; bf16_t* Wt; int K, N, k0, n0, orow0; };
__device__ __forceinline__ CvDesc cv_desc(const Params& p, int l, int r) {
    CvDesc d;
    if (r < R_OUT) { const int tn = r / 32, tk = r % 32; d.W = inp(2) + (size_t)l * D_MODEL * D_INP; d.Wt = (bf16_t*)(p.ws + OFF_WT_IN + l * SZ_WT_IN); d.K = D_MODEL; d.N = D_INP; d.k0 = tk * 64; d.n0 = tn * 64; d.orow0 = tn * 64; }
    else if (r < R_UP) { r -= R_OUT; const int tn = r / 32, tk = r % 32; d.W = inp(20) + (size_t)l * D_MODEL * D_MODEL; d.Wt = (bf16_t*)(p.ws + OFF_WT_OUT + l * SZ_WT_OUT); d.K = D_MODEL; d.N = D_MODEL; d.k0 = tk * 64; d.n0 = tn * 64; d.orow0 = tn * 64; }
    else if (r < R_DN) { r -= R_UP; const int tn = r / 32, tk = r % 32; const int n0 = tn * 64, sg = n0 / D_FF, rem = n0 % D_FF, j = rem / 128, i = rem % 128;
        d.W = inp(22) + (size_t)l * D_MODEL * D_UP; d.Wt = (bf16_t*)(p.ws + OFF_WT_UP + l * SZ_WT_UP); d.K = D_MODEL; d.N = D_UP; d.k0 = tk * 64; d.n0 = n0; d.orow0 = 256 * j + 128 * sg + i; }
    else if (r < R_POOL) { r -= R_DN; const int tn = r / 88, tk = r % 88; d.W = inp(25) + (size_t)l * D_FF * D_MODEL; d.Wt = (bf16_t*)(p.ws + OFF_WT_DN + l * SZ_WT_DN); d.K = D_FF; d.N = D_MODEL; d.k0 = tk * 64; d.n0 = tn * 64; d.orow0 = tn * 64; }
    else { r -= R_POOL; const int g = r >> 2, tn = (r >> 1) & 1, tk = r & 1; d.W = inp(3) + (size_t)(l * 4 + g) * 128 * 128; d.Wt = (bf16_t*)(p.ws + OFF_POOLWT + l * SZ_POOLWT) + g * 128 * 128; d.K = 128; d.N = 128; d.k0 = tk * 64; d.n0 = tn * 64; d.orow0 = tn * 64; }
    return d;
}
__device__ __forceinline__ CvDesc cv_pick(const Params& p, int mode, int l, int base, int i) {
    if (mode == 0) { if (i < R_DN) return cv_desc(p, 0, i); if (i < R_DN + NI_POOL) return cv_desc(p, 0, R_POOL + i - R_DN); return cv_desc(p, 1, R_POOL + i - R_DN - NI_POOL); }
    return cv_desc(p, l, base + i);
}
__device__ __forceinline__ void cv_load(const CvDesc& d, int tid, float4 (&v)[2]) {
    const int r = tid >> 4, c4 = (tid & 15) * 4;
#pragma unroll
    for (int ps = 0; ps < 2; ++ps) v[ps] = *(const float4*)(d.W + (size_t)(d.k0 + r + ps * 32) * d.N + d.n0 + c4);
}
__device__ void convert_range(const Params& p, int mode, int l, int base, int count, int start, int stride, float* tile) {
    int i = start; if (i >= count) return;
    const int tid = tid_l();
    CvDesc d = cv_pick(p, mode, l, base, i); float4 v[2]; cv_load(d, tid, v);
    for (;;) {
        { const int r = tid >> 4, c4 = (tid & 15) * 4;
#pragma unroll
          for (int ps = 0; ps < 2; ++ps) { float* tp = tile + (r + ps * 32) * 65 + c4; tp[0] = v[ps].x; tp[1] = v[ps].y; tp[2] = v[ps].z; tp[3] = v[ps].w; } }
        __syncthreads();
        const int ni = i + stride; const bool more = ni < count; CvDesc dn = d;
        if (more) { dn = cv_pick(p, mode, l, base, ni); cv_load(dn, tid, v); }
        { const int n = tid >> 3, k8 = (tid & 7) * 8; float u[8];
#pragma unroll
          for (int j = 0; j < 8; ++j) u[j] = tile[(k8 + j) * 65 + n];
          u32x4 w; w.x = cvt_pk_bf16(u[0], u[1]); w.y = cvt_pk_bf16(u[2], u[3]); w.z = cvt_pk_bf16(u[4], u[5]); w.w = cvt_pk_bf16(u[6], u[7]);
          *(u32x4*)(d.Wt + (size_t)(d.orow0 + n) * d.K + d.k0 + k8) = w; }
        __syncthreads();
        if (!more) break;
        d = dn; i = ni;
    }
}

__device__ __forceinline__ void cv_load4(const CvDesc& d, int tid, float4 (&v)[8]) {
    const int r = tid >> 4, c4 = (tid & 15) * 4;
#pragma unroll
    for (int ps = 0; ps < 8; ++ps) v[ps] = *(const float4*)(d.W + (size_t)(d.k0 + r + ps * 32) * d.N + d.n0 + c4);
}
__device__ void convert_range4(const Params& p, int l, int base, int count4, int start, int stride, float* tile) {
    int i = start; if (i >= count4) return;
    const int tid = tid_l();
    CvDesc d = cv_desc(p, l, base + 4 * i); float4 v[8]; cv_load4(d, tid, v);
    for (;;) {
        { const int r = tid >> 4, c4 = (tid & 15) * 4;
#pragma unroll
          for (int ps = 0; ps < 8; ++ps) { float* tp = tile + (r + ps * 32) * 65 + c4; tp[0] = v[ps].x; tp[1] = v[ps].y; tp[2] = v[ps].z; tp[3] = v[ps].w; } }
        __syncthreads();
        const int ni = i + stride; const bool more = ni < count4; CvDesc dn = d;
        if (more) { dn = cv_desc(p, l, base + 4 * ni); cv_load4(dn, tid, v); }
        { const int n = tid >> 3, kc = tid & 7;
#pragma unroll
          for (int j = 0; j < 4; ++j) { const int k8 = (kc + 8 * j) * 8; float u[8];
#pragma unroll
              for (int q = 0; q < 8; ++q) u[q] = tile[(k8 + q) * 65 + n];
              u32x4 w; w.x = cvt_pk_bf16(u[0], u[1]); w.y = cvt_pk_bf16(u[2], u[3]); w.z = cvt_pk_bf16(u[4], u[5]); w.w = cvt_pk_bf16(u[6], u[7]);
              *(u32x4*)(d.Wt + (size_t)(d.orow0 + n) * d.K + d.k0 + k8) = w; } }
        __syncthreads();
        if (!more) break;
        d = dn; i = ni;
    }
}

__device__ void filter_item(const Params& p, int item, float* lds) {
    const int l = item >> 7, rem = item & 127, ti = rem >> 1, half = rem & 1;
    const int tid = tid_l(), lane = tid & 63, w = __builtin_amdgcn_readfirstlane(tid >> 6);
    const int t = ti * 64 + lane;
    const float* w1 = inp(8) + l * 33 * 64; const float* b1 = inp(9) + l * 64; const float* fr1 = inp(10) + l * 64;
    const float* w2 = inp(11) + l * 64 * 64; const float* b2 = inp(12) + l * 64; const float* fr2 = inp(13) + l * 64;
    const float* w3 = inp(14) + (size_t)l * 64 * 1536;
    float* h1s = lds; float* h2s = lds + 64 * 65;
    const float tt = (float)t / 4095.0f;
    float a[8];
#pragma unroll
    for (int j = 0; j < 8; ++j) a[j] = b1[8 * w + j] + tt * w1[8 * w + j];
    for (int band = 0; band < 16; ++band) {
        const float f = 1e-4f + (float)band * ((15.0f - 1e-4f) / 15.0f);
        float r = f * (float)t * (1.0f / 4096.0f); r -= floorf(r);
        const float cs = __builtin_amdgcn_cosf(r), sn = -__builtin_amdgcn_sinf(r);
#pragma unroll
        for (int j = 0; j < 8; ++j) a[j] += cs * w1[(1 + band) * 64 + 8 * w + j] + sn * w1[(17 + band) * 64 + 8 * w + j];
    }
#pragma unroll
    for (int j = 0; j < 8; ++j) h1s[lane * 65 + 8 * w + j] = sin_rad(fr1[8 * w + j] * a[j]);
    __syncthreads();
#pragma unroll
    for (int j = 0; j < 8; ++j) a[j] = b2[8 * w + j];
    for (int i = 0; i < 64; ++i) { const float h = h1s[lane * 65 + i];
#pragma unroll
        for (int j = 0; j < 8; ++j) a[j] += h * w2[i * 64 + 8 * w + j]; }
#pragma unroll
    for (int j = 0; j < 8; ++j) h2s[lane * 65 + 8 * w + j] = sin_rad(fr2[8 * w + j] * a[j]);
    __syncthreads();
    float* KT = (float*)(p.ws + OFF_ACT) + (size_t)l * 768 * 8192;
    const float d0 = -3.0701134573f, d1 = -15.3505672865f;
    typedef const __attribute__((address_space(4))) f32x4 cf4;
    for (int ci = 0; ci < 24; ++ci) {
        const int c = w * 96 + ci * 4;
        cf4* wc = (cf4*)(unsigned long long)(w3 + half * 768 + c);
        float o0 = 0.f, o1 = 0.f, o2 = 0.f, o3 = 0.f;
#pragma unroll 8
        for (int i = 0; i < 64; ++i) { const float h = h2s[lane * 65 + i]; const f32x4 wv = wc[i * 384]; o0 += h * wv[0]; o1 += h * wv[1]; o2 += h * wv[2]; o3 += h * wv[3]; }
        float o[4] = {o0, o1, o2, o3};
#pragma unroll
        for (int j = 0; j < 4; ++j) {
            const float delta = d0 + (float)(c + j) * ((d1 - d0) / 767.0f);
            const float val = o[j] * __expf(-tt * fabsf(delta));
            float* kt = KT + (size_t)(c + j) * 8192;
            if (half == 0) kt[t] = val; else { if (t == 0) kt[4096] = 0.f; else kt[8192 - t] = val; }
        }
    }
    __syncthreads();
}

__device__ __forceinline__ int phys(int i) { return i + (i >> 5); }
__device__ __forceinline__ float launder_f(float v) { asm volatile("" : "+v"(v)); return v; }
constexpr int FFT_BUF = 8192 + 256;
__device__ __forceinline__ constexpr float c32(int i) { constexpr float T[16] = {1.0f, 0.98078528040f, 0.92387953251f, 0.83146961230f, 0.70710678119f, 0.55557023302f, 0.38268343237f, 0.19509032202f, 0.0f, -0.19509032202f, -0.38268343237f, -0.55557023302f, -0.70710678119f, -0.83146961230f, -0.92387953251f, -0.98078528040f}; return T[i]; }
__device__ __forceinline__ constexpr float s32(int i) { constexpr float T[16] = {0.0f, 0.19509032202f, 0.38268343237f, 0.55557023302f, 0.70710678119f, 0.83146961230f, 0.92387953251f, 0.98078528040f, 1.0f, 0.98078528040f, 0.92387953251f, 0.83146961230f, 0.70710678119f, 0.55557023302f, 0.38268343237f, 0.19509032202f}; return T[i]; }
template <bool INV> __device__ __forceinline__ void radix16(float2 (&x)[16], float rfrac) {
#pragma unroll
    for (int jj = 0; jj < 4; ++jj) { const int j = INV ? 3 - jj : jj; const int half = 8 >> j;
        const float ab = rfrac * (float)(8 / half); const float cb = __builtin_amdgcn_cosf(ab), sb = __builtin_amdgcn_sinf(ab);
#pragma unroll
        for (int kk = 0; kk < half; ++kk) {
            const int idx = kk * (16 / half);
            float cs, sp;
            if (idx == 0) { cs = cb; sp = sb; }
            else if (idx == 8) { cs = -sb; sp = cb; }
            else { cs = cb * c32(idx) - sb * s32(idx); sp = cb * s32(idx) + sb * c32(idx); }
            const float sn = INV ? sp : -sp;
#pragma unroll
            for (int g = 0; g < 16; g += 2 * half) { const int i0 = g + kk, i1 = i0 + half; const float2 a = x[i0], b = x[i1];
                if (!INV) { const float dx = a.x - b.x, dy = a.y - b.y; x[i0] = make_float2(a.x + b.x, a.y + b.y); x[i1] = make_float2(dx * cs - dy * sn, dx * sn + dy * cs); }
                else { const float bx = b.x * cs - b.y * sn, by = b.x * sn + b.y * cs; x[i0] = make_float2(a.x + bx, a.y + by); x[i1] = make_float2(a.x - bx, a.y - by); } }
        }
    }
}
template <bool INV> __device__ __forceinline__ void radix32(float2 (&y)[32]) {
#pragma unroll
    for (int jj = 0; jj < 5; ++jj) { const int j = INV ? 4 - jj : jj; const int half = 16 >> j;
#pragma unroll
        for (int kk = 0; kk < half; ++kk) { const int idx = kk * (16 / half); const float cs = c32(idx), sn = INV ? s32(idx) : -s32(idx);
#pragma unroll
            for (int g = 0; g < 32; g += 2 * half) { const int i0 = g + kk, i1 = i0 + half; const float2 a = y[i0], b = y[i1];
                if (!INV) { const float dx = a.x - b.x, dy = a.y - b.y; y[i0] = make_float2(a.x + b.x, a.y + b.y);
                    if (idx == 0) y[i1] = make_float2(dx, dy);
                    else if (idx == 8) y[i1] = make_float2(dy, -dx);
                    else y[i1] = make_float2(dx * cs - dy * sn, dx * sn + dy * cs); }
                else { float bx, by;
                    if (idx == 0) { bx = b.x; by = b.y; }
                    else if (idx == 8) { bx = -b.y; by = b.x; }
                    else { bx = b.x * cs - b.y * sn; by = b.x * sn + b.y * cs; }
                    y[i0] = make_float2(a.x + bx, a.y + by); y[i1] = make_float2(a.x - bx, a.y - by); } }
        }
    }
}
template <bool INV> __device__ __forceinline__ void fft_pass2(float2* B, int tid, float rfr) {
    const int blk = tid >> 5, r = tid & 31; float2 x[16]; float2* b = B + blk * 528 + r;
#pragma unroll
    for (int k = 0; k < 16; ++k) x[k] = b[33 * k];
    radix16<INV>(x, rfr);
#pragma unroll
    for (int k = 0; k < 16; ++k) b[33 * k] = x[k];
}

__device__ void kf_item(const Params& p, int item, unsigned char* smem) {
    const int l = item / 384, cp = item % 384, c0 = 2 * cp;
    const int tid = tid_l();
    float2* B0 = (float2*)smem; float2* B1 = B0 + FFT_BUF;
    const float* KT = (const float*)(p.ws + OFF_ACT) + ((size_t)l * 768 + c0) * 8192 + tid;
    float2 x0[16], x1[16];
#pragma unroll
    for (int k = 0; k < 16; ++k) { x0[k] = make_float2(KT[512 * k], 0.f); x1[k] = make_float2(KT[8192 + 512 * k], 0.f); }
    const float rf = (float)tid * (1.0f / 8192.0f);
    radix16<false>(x0, rf); radix16<false>(x1, rf);
#pragma unroll
    for (int k = 0; k < 16; ++k) { B0[phys(tid + 512 * k)] = x0[k]; B1[phys(tid + 512 * k)] = x1[k]; }
    __syncthreads();
    { const float r2 = launder_f((float)(tid & 31) * (1.0f / 512.0f)); fft_pass2<false>(B0, tid, r2); fft_pass2<false>(B1, tid, r2); }
    __syncthreads();
    { const int blk = tid & 255, ch = tid >> 8; float2* B = ch ? B1 : B0; float2 y[32];
#pragma unroll
      for (int k = 0; k < 32; ++k) y[k] = B[blk * 33 + k];
      radix32<false>(y);
      float2* KF = (float2*)(p.ws + OFF_KF) + ((size_t)l * 768 + c0 + ch) * 8192 + blk * 2; const float sc = 1.0f / 8192.0f;
#pragma unroll
      for (int k = 0; k < 32; k += 2) *(float4*)(KF + (k >> 1) * 512) = make_float4(y[k].x * sc, y[k].y * sc, y[k + 1].x * sc, y[k + 1].y * sc); }
    __syncthreads();
}

template <bool XF32> __device__ void norm_phase(const void* __restrict__ xin, const float* __restrict__ g, bf16_t* hb, float* hf) {
    const int tid = tid_l(); const int lane = tid & 63; const int gw = blockIdx.x * 8 + (tid >> 6), nw = gridDim.x * 8;
    for (int row = gw; row < NTOK; row += nw) {
        float4 v[8]; float ss = 0.f;
#pragma unroll
        for (int i = 0; i < 8; ++i) {
            if (XF32) v[i] = *(const float4*)((const float*)xin + (size_t)row * D_MODEL + i * 256 + lane * 4);
            else { const u32x2 u = *(const u32x2*)((const bf16_t*)xin + (size_t)row * D_MODEL + i * 256 + lane * 4); v[i] = make_float4(lo_bf(u.x), hi_bf(u.x), lo_bf(u.y), hi_bf(u.y)); }
            ss += v[i].x * v[i].x + v[i].y * v[i].y + v[i].z * v[i].z + v[i].w * v[i].w; }
        ss = wave_sum(ss);
        const float rs = rsqrtf(ss * (1.0f / D_MODEL) + 1e-6f);
#pragma unroll
        for (int i = 0; i < 8; ++i) { const float4 gg = *(const float4*)(g + i * 256 + lane * 4);
            const float y0 = v[i].x * rs * gg.x, y1 = v[i].y * rs * gg.y, y2 = v[i].z * rs * gg.z, y3 = v[i].w * rs * gg.w;
            if (hb) { u32x2 w; w.x = cvt_pk_bf16(y0, y1); w.y = cvt_pk_bf16(y2, y3); *(u32x2*)(hb + (size_t)(row + 1 + (row >> 12)) * D_MODEL + i * 256 + lane * 4) = w; }
            else { *(float4*)(hf + (size_t)row * D_MODEL + i * 256 + lane * 4) = make_float4(y0, y1, y2, y3); } }
    }
}

__device__ void pool_item(const Params& p, int l, int item, unsigned char* smem) {
    const int tt = item >> 2, g = item & 3;
    const int tid = tid_l(), lane = tid & 63, w = tid >> 6, fr = lane & 15, fq = lane >> 4;
    const bf16_t* P = (const bf16_t*)(p.ws + OFF_P); bf16_t* MIX = (bf16_t*)(p.ws + OFF_MIX);
    const int row0 = tt * 128, b0 = (row0 / SEQ) * SEQ;
    float* X = (float*)smem;
    bf16_t* A = (bf16_t*)(smem + 144 * 129 * 4);
    for (int idx = tid; idx < 144 * 16; idx += 512) { const int r = idx >> 4, c8 = (idx & 15) * 8; const int row = row0 - 8 + r;
        u32x4 v = (u32x4){0u, 0u, 0u, 0u};
        if (row >= b0 && row < b0 + SEQ) v = *(const u32x4*)(P + (size_t)row * D_INP + g * 128 + c8);
        float* xp = X + r * 129 + c8;
        xp[0] = lo_bf(v.x); xp[1] = hi_bf(v.x); xp[2] = lo_bf(v.y); xp[3] = hi_bf(v.y); xp[4] = lo_bf(v.z); xp[5] = hi_bf(v.z); xp[6] = lo_bf(v.w); xp[7] = hi_bf(v.w); }
    __syncthreads();
    { const int c = tid & 127, tq = tid >> 7; const int hw = 1 << g;
      const float* xc = X + (tq * 32 + 8) * 129 + c;
      float s = 0.f;
      for (int q = -hw; q < hw; ++q) s += xc[q * 129];
      const int tb = row0 + tq * 32 - b0;
#pragma unroll 8
      for (int i = 0; i < 32; ++i) { const int t = tb + i; const int lo = max(t - hw, 0), hi = min(t + hw - 1, SEQ - 1);
          const float d = s * __builtin_amdgcn_rcpf((float)(hi - lo + 1)) - xc[i * 129];
          A[(tq * 32 + i) * 136 + c] = (bf16_t)(cvt_pk_bf16(d, 0.f) & 0xffffu);
          s += xc[(i + hw) * 129] - xc[(i - hw) * 129]; } }
    __syncthreads();
    const bf16_t* Wt = (const bf16_t*)(p.ws + OFF_POOLWT + l * SZ_POOLWT) + g * 128 * 128;
    f32x4 acc[8];
#pragma unroll
    for (int nb = 0; nb < 8; ++nb) acc[nb] = (f32x4){0.f, 0.f, 0.f, 0.f};
#pragma unroll
    for (int ks = 0; ks < 4; ++ks) {
        const bf16x8 af = *(const bf16x8*)(A + (16 * w + fr) * 136 + ks * 32 + fq * 8);
#pragma unroll
        for (int nb = 0; nb < 8; ++nb) { const bf16x8 bfr = *(const bf16x8*)(Wt + (nb * 16 + fr) * 128 + ks * 32 + fq * 8);
            acc[nb] = __builtin_amdgcn_mfma_f32_16x16x32_bf16(bfr, af, acc[nb], 0, 0, 0); }
    }
    const float* pb = inp(4) + l * 512 + g * 128; const float* psc = inp(5) + l * 512 + g * 128;
    const int row = row0 + 16 * w + fr;
#pragma unroll
    for (int nb = 0; nb < 8; ++nb) { const int d = nb * 16 + 4 * fq; const float4 bb = *(const float4*)(pb + d), sc = *(const float4*)(psc + d);
        u32x2 o; o.x = cvt_pk_bf16((acc[nb][0] + bb.x) * sc.x, (acc[nb][1] + bb.y) * sc.y); o.y = cvt_pk_bf16((acc[nb][2] + bb.z) * sc.z, (acc[nb][3] + bb.w) * sc.w);
        *(u32x2*)(MIX + (size_t)row * D_MODEL + g * 128 + d) = o; }
    __syncthreads();
}

__device__ void hypre_item(const Params& p, int l, int item, unsigned char* smem) {
    const int tt = item / 6, ct = item % 6; const int tid = tid_l();
    const bf16_t* P = (const bf16_t*)(p.ws + OFF_P); float* ZT = (float*)(p.ws + OFF_ZT); float* X0T = (float*)(p.ws + OFF_X0T);
    const float* sw = inp(6) + (size_t)l * 3 * 2304; const float* sb = inp(7) + (size_t)l * 2304;
    float* zt = (float*)smem;
    float* xt = zt + 128 * 65;
    const int row0 = tt * 64;
    { const int cpq = tid & 63, tr = tid >> 6; const int ch = ct * 128 + 2 * cpq;
      float w[3][3][2], bb[3][2];
#pragma unroll
      for (int s3 = 0; s3 < 3; ++s3) {
#pragma unroll
          for (int k = 0; k < 3; ++k) { const float2 v = *(const float2*)(sw + k * 2304 + s3 * 768 + ch); w[s3][k][0] = v.x; w[s3][k][1] = v.y; }
          const float2 v = *(const float2*)(sb + s3 * 768 + ch); bb[s3][0] = v.x; bb[s3][1] = v.y; }
      const int r0 = row0 + tr * 8; const bf16_t* pr = P + (size_t)r0 * D_INP + COL_HY + ch;
      unsigned pm[3], pc[3], pn[3];
#pragma unroll
      for (int s3 = 0; s3 < 3; ++s3) { pm[s3] = ((r0 & (SEQ - 1)) != 0) ? *(const unsigned*)(pr - D_INP + s3 * 768) : 0u; pc[s3] = *(const unsigned*)(pr + s3 * 768); }
#pragma unroll
      for (int i = 0; i < 8; ++i) { const int row = r0 + i;
#pragma unroll
          for (int s3 = 0; s3 < 3; ++s3) pn[s3] = ((row & (SEQ - 1)) != SEQ - 1) ? *(const unsigned*)(pr + (size_t)(i + 1) * D_INP + s3 * 768) : 0u;
          float o[3][2];
#pragma unroll
          for (int s3 = 0; s3 < 3; ++s3) { o[s3][0] = w[s3][0][0] * lo_bf(pm[s3]) + w[s3][1][0] * lo_bf(pc[s3]) + w[s3][2][0] * lo_bf(pn[s3]) + bb[s3][0];
                                           o[s3][1] = w[s3][0][1] * hi_bf(pm[s3]) + w[s3][1][1] * hi_bf(pc[s3]) + w[s3][2][1] * hi_bf(pn[s3]) + bb[s3][1]; }
          const int tl = tr * 8 + i;
          zt[(2 * cpq) * 65 + tl] = o[1][0] * o[2][0]; zt[(2 * cpq + 1) * 65 + tl] = o[1][1] * o[2][1];
          xt[(2 * cpq) * 65 + tl] = o[0][0]; xt[(2 * cpq + 1) * 65 + tl] = o[0][1];
#pragma unroll
          for (int s3 = 0; s3 < 3; ++s3) { pm[s3] = pc[s3]; pc[s3] = pn[s3]; } } }
    __syncthreads();
    { const int tl = tid & 63, cr = tid >> 6; const int row = row0 + tl, b = row >> 12, t = row & (SEQ - 1);
#pragma unroll
      for (int i = 0; i < 16; ++i) { const int c = cr * 16 + i; const size_t o = (size_t)(ct * 128 + c) * 8192 + b * 4096 + t; ZT[o] = zt[c * 65 + tl]; X0T[o] = xt[c * 65 + tl]; } }
    __syncthreads();
}

constexpr int GM_NH = 3;
__device__ void gmlp_item(const Params& p, int l, int item, unsigned char* smem) {
    const int n = item / (6 / GM_NH), e0 = (item % (6 / GM_NH)) * GM_NH;
    const int tid = tid_l(), lane = tid & 63, w = tid >> 6, fr = lane & 15, fq = lane >> 4;
    const bf16_t* P = (const bf16_t*)(p.ws + OFF_P); bf16_t* MIX = (bf16_t*)(p.ws + OFF_MIX);
    const float* stats = (const float*)(p.ws + OFF_STATS) + (size_t)l * NTOK * 24;
    const float* lng = inp(16) + l * 768; const float* lnb = inp(17) + l * 768;
    bf16_t* VT = (bf16_t*)smem;
    const int t0 = n * 128;
    const int q = 16 * w + fr; const size_t qrow = (size_t)(t0 + q);
    float g0[GM_NH], g1[GM_NH], be0[GM_NH], be1[GM_NH], bq[GM_NH]; u32x2 uu[GM_NH][8]; bf16x8 wf[GM_NH][4];
#pragma unroll
    for (int h = 0; h < GM_NH; ++h) { const int e = e0 + h;
        g0[h] = lng[e * 128 + lane]; g1[h] = lng[e * 128 + 64 + lane]; be0[h] = lnb[e * 128 + lane]; be1[h] = lnb[e * 128 + 64 + lane];
        bq[h] = (inp(19) + (l * 6 + e) * 128)[q];
#pragma unroll
        for (int cb = 0; cb < 8; ++cb) uu[h][cb] = *(const u32x2*)(P + qrow * D_INP + COL_GM + e * 128 + cb * 16 + 4 * fq);
        const float* ws_ = inp(18) + (size_t)(l * 6 + e) * 128 * 128;
#pragma unroll
        for (int ks = 0; ks < 4; ++ks) { const float* wp = ws_ + (16 * w + fr) * 128 + ks * 32 + fq * 8; const float4 a = *(const float4*)wp, b = *(const float4*)(wp + 4);
            u32x4 t; t.x = cvt_pk_bf16(a.x, a.y); t.y = cvt_pk_bf16(a.z, a.w); t.z = cvt_pk_bf16(b.x, b.y); t.w = cvt_pk_bf16(b.z, b.w); wf[h][ks] = __builtin_bit_cast(bf16x8, t); } }
#pragma unroll
    for (int i = 0; i < 16; ++i) { const int pl = 16 * w + i; const size_t row = (size_t)(t0 + pl); const bf16_t* pr = P + row * D_INP + COL_GM + 768 + e0 * 128;
        float2 st; { const f32x4* sp = (const f32x4*)(stats + row * 24); f32x4 a = sp[0];
#pragma unroll
          for (int k = 1; k < 6; ++k) a += sp[k];
          st = make_float2(a[0] + a[2], a[1] + a[3]); }
        const float mean = st.x * (1.0f / 768.0f); const float rstd = rsqrtf(fmaxf(st.y * (1.0f / 768.0f) - mean * mean, 0.f) + 1e-5f);
#pragma unroll
        for (int h = 0; h < GM_NH; ++h) {
            const float y0 = (bf2f(pr[h * 128 + lane]) - mean) * rstd * g0[h] + be0[h], y1 = (bf2f(pr[h * 128 + 64 + lane]) - mean) * rstd * g1[h] + be1[h];
            const unsigned pk = cvt_pk_bf16(y0, y1);
            VT[(h * 128 + lane) * 132 + pl] = (bf16_t)(pk & 0xffffu); VT[(h * 128 + 64 + lane) * 132 + pl] = (bf16_t)(pk >> 16); } }
    __syncthreads();
#pragma unroll
    for (int h = 0; h < GM_NH; ++h) { const int e = e0 + h;
        f32x4 acc[8];
#pragma unroll
        for (int cb = 0; cb < 8; ++cb) acc[cb] = (f32x4){0.f, 0.f, 0.f, 0.f};
#pragma unroll
        for (int ks = 0; ks < 4; ++ks)
#pragma unroll
            for (int cb = 0; cb < 8; ++cb) { const bf16_t* vp = VT + (h * 128 + cb * 16 + fr) * 132 + ks * 32 + fq * 8; const u32x2 lo = *(const u32x2*)vp, hi = *(const u32x2*)(vp + 4);
                u32x4 t; t.x = lo.x; t.y = lo.y; t.z = hi.x; t.w = hi.y;
                acc[cb] = __builtin_amdgcn_mfma_f32_16x16x32_bf16(__builtin_bit_cast(bf16x8, t), wf[h][ks], acc[cb], 0, 0, 0); }
#pragma unroll
        for (int cb = 0; cb < 8; ++cb) { const int c = cb * 16 + 4 * fq;
            const float u0 = lo_bf(uu[h][cb].x), u1 = hi_bf(uu[h][cb].x), u2 = lo_bf(uu[h][cb].y), u3 = hi_bf(uu[h][cb].y);
            u32x2 o; o.x = cvt_pk_bf16(u0 * (acc[cb][0] + bq[h]), u1 * (acc[cb][1] + bq[h])); o.y = cvt_pk_bf16(u2 * (acc[cb][2] + bq[h]), u3 * (acc[cb][3] + bq[h]));
            *(u32x2*)(MIX + qrow * D_MODEL + MIX_GM + e * 128 + c) = o; } }
    __syncthreads();
}

__device__ void fft_item(const Params& p, int l, int cp, unsigned char* smem) {
    const int tid = tid_l(); const int c0 = 2 * cp;
    float2* B0 = (float2*)smem;
    const float* ZT = (const float*)(p.ws + OFF_ZT) + (size_t)c0 * 8192; const float* X0T = (const float*)(p.ws + OFF_X0T) + (size_t)c0 * 8192;
    const float rf = (float)tid * (1.0f / 8192.0f);
#pragma unroll
    for (int ch = 0; ch < 2; ++ch) { float2 x[16]; float2* B = B0 + ch * FFT_BUF; const float* z = ZT + ch * 8192 + tid;
#pragma unroll
        for (int k = 0; k < 8; ++k) { x[k] = make_float2(z[512 * k], z[4096 + 512 * k]); x[k + 8] = make_float2(0.f, 0.f); }
        radix16<false>(x, rf);
#pragma unroll
        for (int k = 0; k < 16; ++k) B[phys(tid + 512 * k)] = x[k]; }
    __syncthreads();
    { const float r2 = launder_f((float)(tid & 31) * (1.0f / 512.0f));
#pragma unroll
      for (int ch = 0; ch < 2; ++ch) fft_pass2<false>(B0 + ch * FFT_BUF, tid, r2); }
    __syncthreads();
    { const int blk = tid & 255, ch = tid >> 8; float2* B = B0 + ch * FFT_BUF + blk * 33; float2 y[32];
#pragma unroll
      for (int k = 0; k < 32; ++k) y[k] = B[k];
      radix32<false>(y);
      const float2* KF = (const float2*)(p.ws + OFF_KF) + ((size_t)l * 768 + c0 + ch) * 8192 + blk * 2;
#pragma unroll
      for (int k = 0; k < 32; k += 2) { const float4 kq = *(const float4*)(KF + (k >> 1) * 512);
          y[k] = make_float2(y[k].x * kq.x - y[k].y * kq.y, y[k].x * kq.y + y[k].y * kq.x); y[k + 1] = make_float2(y[k + 1].x * kq.z - y[k + 1].y * kq.w, y[k + 1].x * kq.w + y[k + 1].y * kq.z); }
      radix32<true>(y);
#pragma unroll
      for (int k = 0; k < 32; ++k) B[k] = y[k]; }
    __syncthreads();
    { const float r2 = launder_f((float)(tid & 31) * (1.0f / 512.0f));
#pragma unroll
      for (int ch = 0; ch < 2; ++ch) fft_pass2<true>(B0 + ch * FFT_BUF, tid, r2); }
    __syncthreads();
    bf16_t* MIX = (bf16_t*)(p.ws + OFF_MIX);
    const float2 dsk = *(const float2*)(inp(15) + l * 768 + c0);
    const float rfi = launder_f(rf);
    { unsigned long long zp = (unsigned long long)ZT; asm volatile("" : "+s"(zp)); ZT = (const float*)zp; }
#pragma unroll 1
    for (int ch = 0; ch < 2; ++ch) { float2 x[16]; float2* B = B0 + ch * FFT_BUF;
#pragma unroll
        for (int k = 0; k < 16; ++k) x[k] = B[phys(tid + 512 * k)];
        radix16<true>(x, rfi);
        const float d = ch ? dsk.y : dsk.x; const float* z = ZT + ch * 8192 + tid; const float* x0 = X0T + ch * 8192 + tid;
        if (ch == 0) {
#pragma unroll
            for (int k = 0; k < 8; ++k) B0[phys(tid + 512 * k)] = make_float2(x0[512 * k] * (x[k].x + d * z[512 * k]), x0[4096 + 512 * k] * (x[k].y + d * z[4096 + 512 * k]));
        } else {
#pragma unroll
            for (int k = 0; k < 8; ++k) { const int t = tid + 512 * k; const float2 r0 = B0[phys(t)];
                const float r1a = x0[512 * k] * (x[k].x + d * z[512 * k]), r1b = x0[4096 + 512 * k] * (x[k].y + d * z[4096 + 512 * k]);
                *(unsigned*)(MIX + (size_t)t * D_MODEL + MIX_HY + c0) = cvt_pk_bf16(r0.x, r1a);
                *(unsigned*)(MIX + (size_t)(4096 + t) * D_MODEL + MIX_HY + c0) = cvt_pk_bf16(r0.y, r1b); }
        } }
    __syncthreads();
}

__device__ void convact_phase(const Params& p, int l) {
    const bf16_t* UP = (const bf16_t*)(p.ws + OFF_UP); bf16_t* ACT = (bf16_t*)(p.ws + OFF_ACT);
    const float* cw = inp(23) + (size_t)l * 3 * D_UP; const float* cb = inp(24) + (size_t)l * D_UP;
    const int nthr = gridDim.x * 512;
    const int tid = tid_l();
    for (int idx = blockIdx.x * 512 + tid; idx < 704 * 512; idx += nthr) {
        const int cg8 = idx % 704, run = idx / 704; const int j = cg8 >> 4, i8 = (cg8 & 15) * 8;
        const int ncol = j * 128 + i8;
        float wg[3][8], wv[3][8], bg[8], bv[8];
#pragma unroll
        for (int k = 0; k < 3; ++k) { const float4 a = *(const float4*)(cw + k * D_UP + ncol), b = *(const float4*)(cw + k * D_UP + ncol + 4);
            wg[k][0] = a.x; wg[k][1] = a.y; wg[k][2] = a.z; wg[k][3] = a.w; wg[k][4] = b.x; wg[k][5] = b.y; wg[k][6] = b.z; wg[k][7] = b.w;
            const float4 c = *(const float4*)(cw + k * D_UP + D_FF + ncol), d = *(const float4*)(cw + k * D_UP + D_FF + ncol + 4);
            wv[k][0] = c.x; wv[k][1] = c.y; wv[k][2] = c.z; wv[k][3] = c.w; wv[k][4] = d.x; wv[k][5] = d.y; wv[k][6] = d.z; wv[k][7] = d.w; }
        { const float4 a = *(const float4*)(cb + ncol), b = *(const float4*)(cb + ncol + 4); bg[0] = a.x; bg[1] = a.y; bg[2] = a.z; bg[3] = a.w; bg[4] = b.x; bg[5] = b.y; bg[6] = b.z; bg[7] = b.w;
          const float4 c = *(const float4*)(cb + D_FF + ncol), d = *(const float4*)(cb + D_FF + ncol + 4); bv[0] = c.x; bv[1] = c.y; bv[2] = c.z; bv[3] = c.w; bv[4] = d.x; bv[5] = d.y; bv[6] = d.z; bv[7] = d.w; }
        const int r0 = run * 16; const size_t colg = (size_t)j * 256 + i8, colv = colg + 128;
        u32x4 gm = (u32x4){0u, 0u, 0u, 0u}, vm = gm, gc, vc, gn, vn;
        if ((r0 & (SEQ - 1)) != 0) { gm = *(const u32x4*)(UP + (size_t)(r0 - 1) * D_UP + colg); vm = *(const u32x4*)(UP + (size_t)(r0 - 1) * D_UP + colv); }
        gc = *(const u32x4*)(UP + (size_t)r0 * D_UP + colg); vc = *(const u32x4*)(UP + (size_t)r0 * D_UP + colv);
        for (int r = r0; r < r0 + 16; ++r) {
            if ((r & (SEQ - 1)) != SEQ - 1) { gn = *(const u32x4*)(UP + (size_t)(r + 1) * D_UP + colg); vn = *(const u32x4*)(UP + (size_t)(r + 1) * D_UP + colv); }
            else { gn = (u32x4){0u, 0u, 0u, 0u}; vn = gn; }
            float o[8];
#pragma unroll
            for (int q = 0; q < 4; ++q) {
                const float ga = wg[0][2 * q] * lo_bf(gm[q]) + wg[1][2 * q] * lo_bf(gc[q]) + wg[2][2 * q] * lo_bf(gn[q]) + bg[2 * q];
                const float gb = wg[0][2 * q + 1] * hi_bf(gm[q]) + wg[1][2 * q + 1] * hi_bf(gc[q]) + wg[2][2 * q + 1] * hi_bf(gn[q]) + bg[2 * q + 1];
                const float va = wv[0][2 * q] * lo_bf(vm[q]) + wv[1][2 * q] * lo_bf(vc[q]) + wv[2][2 * q] * lo_bf(vn[q]) + bv[2 * q];
                const float vb = wv[0][2 * q + 1] * hi_bf(vm[q]) + wv[1][2 * q + 1] * hi_bf(vc[q]) + wv[2][2 * q + 1] * hi_bf(vn[q]) + bv[2 * q + 1];
                o[2 * q] = silu(ga) * va; o[2 * q + 1] = silu(gb) * vb; }
            u32x4 ow; ow.x = cvt_pk_bf16(o[0], o[1]); ow.y = cvt_pk_bf16(o[2], o[3]); ow.z = cvt_pk_bf16(o[4], o[5]); ow.w = cvt_pk_bf16(o[6], o[7]);
            *(u32x4*)(ACT + (size_t)r * D_FF + ncol) = ow;
            gm = gc; vm = vc; gc = gn; vc = vn;
        }
    }
}

__global__ void __launch_bounds__(512, 2) fwd_megakernel(Params p) {
    extern __shared__ __attribute__((aligned(16))) unsigned char smem[];
    cg::grid_group grid = cg::this_grid();
    const int G = gridDim.x, bid = blockIdx.x;
    int step = 0;
    if (p.ph_hi < 0) grid.sync();
    volatile LAS unsigned* xst = (volatile LAS unsigned*)(LAS unsigned char*)(smem + LDS_BYTES - 16);
    if (threadIdx.x < 4) xst[threadIdx.x] = 0u;
    __syncthreads();
    XcdBarrier xb = xcd_barrier_post((unsigned*)(p.ws + OFF_BAR), xst);
#define STEP_BEGIN if (step >= p.ph_lo && step < p.ph_hi) {
#define STEP_END } ++step; if (step > p.ph_lo && step < p.ph_hi) xcd_barrier(xb);

    bf16_t* H = (bf16_t*)(p.ws + OFF_H);
    bf16_t* XA = (bf16_t*)(p.ws + OFF_XA);
#if PROBE == 6
    for (int i = 0; i < 20; ++i) xcd_barrier(xb);
#endif

    STEP_BEGIN
        for (int it = bid; it < NI_FILT; it += G) filter_item(p, it, (float*)smem);
        convert_range4(p, 0, 0, NI_IN / 4, bid, G, (float*)smem);
        convert_range(p, 1, 0, R_POOL, NI_POOL, bid, G, (float*)smem); convert_range(p, 1, 1, R_POOL, NI_POOL, bid, G, (float*)smem);
        if (bid < 3) { const int zr = bid == 0 ? 0 : (bid == 1 ? 4097 : 8194); for (int i = tid_l(); i < D_MODEL / 2; i += 512) ((unsigned*)(H + (size_t)zr * D_MODEL))[i] = 0u; }
        norm_phase<true>(inp(0), inp(1), H, nullptr);
    STEP_END

    for (int l = 0; l < 2; ++l) {
        STEP_BEGIN
            pg8::Gemm g{H + D_MODEL, (const bf16_t*)(p.ws + OFF_WT_IN + l * SZ_WT_IN), NTOK, D_INP, D_MODEL}; pg8::StaticOrder S; S.init(NTOK, D_INP, G, bid);
            pg8::EpiBf16Gm E{(bf16_t*)(p.ws + OFF_P), D_INP, (float*)(p.ws + OFF_STATS) + (size_t)l * NTOK * 24};
            pg8::gemm_phase<pg8::EpiBf16Gm, pg8::StaticOrder, D_MODEL>((LAS unsigned char*)smem, g, S, E);
            { const int rem = (NTOK / 256) * (D_INP / 256) % G;
              if (bid >= rem) for (int rep_ = 0; rep_ < (PROBE == 11 ? 2 : 1); ++rep_) {
                  if (l == 0) { for (int it = bid - rem; it < 768; it += G - rem) kf_item(p, it, smem); convert_range4(p, 1, 0, NI_IN / 4, bid - rem, G - rem, (float*)smem); convert_range4(p, 0, R_DN + NT3, (NI_DN - NT3) / 4, bid - rem, G - rem, (float*)smem); }
                  else { convert_range4(p, 1, R_OUT, (NI_OUT + NI_UP) / 4, bid - rem, G - rem, (float*)smem); convert_range4(p, 1, R_DN + NT3, (NI_DN - NT3) / 4, bid - rem, G - rem, (float*)smem); } } }
        STEP_END
        STEP_BEGIN
            for (int it = bid; it < 768; it += G) hypre_item(p, l, it, smem);
        STEP_END
        STEP_BEGIN
            for (int rep_ = 0; rep_ < (PROBE == 13 ? 2 : 1); ++rep_) {
            unsigned* wq = (unsigned*)(p.ws + OFF_BAR) + 3500 + l + 8 * rep_;
            for (;;) {
                __syncthreads();
                if (threadIdx.x == 0) xst[2] = atomicAdd(wq, 1u);
                __syncthreads();
                const int it = __builtin_amdgcn_readfirstlane((int)xst[2]);
                constexpr int NCH = (NI_OUT + NI_UP) / 8, NMIX = 384 + 128 + 256;
                int mi = it, ch = -1;
                if (l == 0) { if (it < 2 * NMIX) { if (it & 1) { ch = it >> 1; mi = -1; } else mi = it >> 1; } else { ch = NMIX + (it - 2 * NMIX); mi = -1; } }
                if (l == 0 ? it >= NMIX + NCH : it >= NMIX) break;
                if (ch >= 0) { if (ch < NCH) convert_range4(p, 0, R_OUT + ch * 8, 2, 0, 1, (float*)smem); }
                else if (mi < 384) fft_item(p, l, mi, smem); else if (mi < 512) gmlp_item(p, l, mi - 384, smem); else pool_item(p, l, mi - 512, smem);
            }
            }
#if PROBE == 21
            for (int it = bid; it < 256; it += G) pool_item(p, l, it, smem);
#elif PROBE == 22
            for (int it = bid; it < 128; it += G) gmlp_item(p, l, it, smem);
#elif PROBE == 3
            for (int it = bid; it < 384; it += G) fft_item(p, l, it, smem);
#endif
        STEP_END
        STEP_BEGIN
            pg8::Gemm g{(const bf16_t*)(p.ws + OFF_MIX), (const bf16_t*)(p.ws + OFF_WT_OUT + l * SZ_WT_OUT), NTOK, D_MODEL, D_MODEL}; pg8::StaticOrder S; S.init(NTOK, D_MODEL, G, bid);
            if (l == 0) { pg8::EpiRes<true> E{XA, inp(0), D_MODEL}; pg8::gemm_phase<pg8::EpiRes<true>, pg8::StaticOrder, D_MODEL>((LAS unsigned char*)smem, g, S, E); }
            else { pg8::EpiRes<false> E{XA, XA, D_MODEL}; pg8::gemm_phase<pg8::EpiRes<false>, pg8::StaticOrder, D_MODEL>((LAS unsigned char*)smem, g, S, E); }
        STEP_END
        STEP_BEGIN
            norm_phase<false>(XA, inp(21) + l * D_MODEL, H, nullptr);
        STEP_END
        STEP_BEGIN
            pg8::Gemm g{H, (const bf16_t*)(p.ws + OFF_WT_UP + l * SZ_WT_UP), NTOK, D_UP, D_MODEL}; pg8::StaticOrder S; S.init_tiles(34, D_UP / 256, G, bid);
            pg8::EpiConvAct E{(bf16_t*)(p.ws + OFF_ACT), inp(23) + (size_t)l * 3 * D_UP, inp(24) + (size_t)l * D_UP};
            pg8::gemm_phase<pg8::EpiConvAct, pg8::StaticOrder, D_MODEL>((LAS unsigned char*)smem, g, S, E);
#if PROBE == 7
            pg8::gemm_phase<pg8::EpiConvAct, pg8::StaticOrder, D_MODEL>((LAS unsigned char*)smem, g, S, E);
#endif
            { const int rem = (34 * (D_UP / 256)) % G; if (bid >= rem) convert_range4(p, l, R_DN, NT3 / 4, bid - rem, G - rem, (float*)smem); }
        STEP_END
        STEP_BEGIN
            pg8::Gemm g{(const bf16_t*)(p.ws + OFF_ACT), (const bf16_t*)(p.ws + OFF_WT_DN + l * SZ_WT_DN), NTOK, D_MODEL, D_FF}; pg8::StaticOrder S; S.init(NTOK, D_MODEL, G, bid);
            pg8::EpiRes<false> E{XA, XA, D_MODEL};
            pg8::gemm_phase<pg8::EpiRes<false>, pg8::StaticOrder, D_FF>((LAS unsigned char*)smem, g, S, E);
        STEP_END
        STEP_BEGIN
            if (l == 0) norm_phase<false>(XA, inp(1) + D_MODEL, H, nullptr); else norm_phase<false>(XA, inp(26), nullptr, p.out);
        STEP_END
    }
}

constexpr int N_STEPS = 17;
#ifndef MULTI_LAUNCH
#define MULTI_LAUNCH 0
#endif

extern "C" void kernel_launch(void* const* d_in, const int* in_sizes, int n_in, void* d_out, int out_size, void* d_ws, size_t ws_size, hipStream_t stream) {
    static int grid = 0;
    if (grid == 0) {
        if (n_in != 27 || ws_size < WS_END) { fprintf(stderr, "kernel_launch: need 27 inputs and %zu bytes of workspace (got %d, %zu)\n", (size_t)WS_END, n_in, ws_size); grid = -1; return; }
        int dev = 0, cus = 0, per_cu = 0;
        hipGetDevice(&dev); hipDeviceGetAttribute(&cus, hipDeviceAttributeMultiprocessorCount, dev);
        if (hipFuncSetAttribute((const void*)fwd_megakernel, hipFuncAttributeMaxDynamicSharedMemorySize, LDS_BYTES) != hipSuccess) { fprintf(stderr, "kernel_launch: hipFuncSetAttribute failed\n"); grid = -1; return; }
        if (hipOccupancyMaxActiveBlocksPerMultiprocessor(&per_cu, (const void*)fwd_megakernel, 512, LDS_BYTES) != hipSuccess || per_cu < 1) { fprintf(stderr, "kernel_launch: occupancy query gave %d\n", per_cu); per_cu = 1; }
        (void)hipGetLastError();
        grid = cus * 1;
    }
    if (grid < 0) return;
    if (hipMemsetAsync((char*)d_ws + OFF_BAR, 0, 16384, stream) != hipSuccess) { fprintf(stderr, "kernel_launch: memset failed\n"); return; }
    Params p{};
    for (int i = 0; i < 27; ++i) p.in[i] = (const float*)d_in[i];
    p.out = (float*)d_out; p.ws = (unsigned char*)d_ws;
#if MULTI_LAUNCH
    for (int s = 0; s < N_STEPS; ++s) { p.ph_lo = s; p.ph_hi = s + 1; hipLaunchKernelGGL(fwd_megakernel, dim3(grid), dim3(512), LDS_BYTES, stream, p); }
#else
    p.ph_lo = 0; p.ph_hi = N_STEPS;
    void* args[] = {&p};
    hipError_t e = hipLaunchCooperativeKernel((const void*)fwd_megakernel, dim3(grid), dim3(512), args, LDS_BYTES, stream);
    if (e != hipSuccess) fprintf(stderr, "cooperative launch failed: %s (grid %d)\n", hipGetErrorString(e), grid);
#endif
}
```

```cpp
#include <hip/hip_runtime.h>
#include <hip/hip_cooperative_groups.h>
#include <cstdio>
namespace cg = cooperative_groups;

#define LAS __attribute__((address_space(3)))
typedef unsigned short bf16_t;
typedef short bf16x8 __attribute__((ext_vector_type(8)));
typedef float f32x4 __attribute__((ext_vector_type(4)));
typedef unsigned u32x4 __attribute__((ext_vector_type(4)));
typedef unsigned u32x2 __attribute__((ext_vector_type(2)));

constexpr int D_MODEL = 2048, SEQ = 4096, NTOK = 8192, D_INP = 4352, D_FF = 5632, D_UP = 11264;
constexpr int D_HY = 768, D_GM = 768;
constexpr int COL_HY = 512, COL_GM = 2816;
constexpr int MIX_HY = 512, MIX_GM = 1280;

constexpr size_t SZ_WT_IN = (size_t)D_INP * D_MODEL * 2, SZ_WT_OUT = (size_t)D_MODEL * D_MODEL * 2, SZ_WT_UP = (size_t)D_UP * D_MODEL * 2, SZ_WT_DN = (size_t)D_MODEL * D_FF * 2;
constexpr size_t SZ_POOLWT = 4 * 128 * 128 * 2, SZ_KF = (size_t)768 * 8192 * 8, SZ_H2 = (size_t)4096 * 64 * 4, SZ_STATS = (size_t)NTOK * 12 * 2 * 4;
constexpr size_t OFF_WT_IN = 0;
constexpr size_t OFF_WT_OUT = OFF_WT_IN + 2 * SZ_WT_IN;
constexpr size_t OFF_WT_UP = OFF_WT_OUT + 2 * SZ_WT_OUT;
constexpr size_t OFF_WT_DN = OFF_WT_UP + 2 * SZ_WT_UP;
constexpr size_t OFF_POOLWT = OFF_WT_DN + 2 * SZ_WT_DN;
constexpr size_t OFF_KF = OFF_POOLWT + 2 * SZ_POOLWT;
constexpr size_t OFF_H2 = OFF_KF + 2 * SZ_KF;
constexpr size_t OFF_STATS = OFF_H2 + 2 * SZ_H2;
constexpr size_t OFF_XA = OFF_STATS + 2 * SZ_STATS;
constexpr size_t OFF_H = OFF_XA + (size_t)NTOK * D_MODEL * 4;
constexpr size_t OFF_R1 = OFF_H + (size_t)(NTOK + 512) * D_MODEL * 2;
constexpr size_t OFF_P = OFF_R1;
constexpr size_t OFF_MIX = OFF_P + (size_t)NTOK * D_INP * 2;
constexpr size_t OFF_ZT = OFF_MIX + (size_t)NTOK * D_MODEL * 2;
constexpr size_t OFF_X0T = OFF_ZT + (size_t)768 * 8192 * 4;
constexpr size_t OFF_UP = OFF_R1;
constexpr size_t OFF_ACT = OFF_R1 + (size_t)NTOK * D_UP * 2;
constexpr size_t OFF_BAR = OFF_ACT + (size_t)NTOK * D_FF * 2;
constexpr size_t OFF_SSP = OFF_BAR + 16384;
constexpr size_t WS_END = OFF_SSP + (size_t)4 * NTOK * 32 * 4;
static_assert(OFF_X0T + (size_t)768 * 8192 * 4 <= OFF_ACT, "alias region");

constexpr int LDS_BYTES = 139264;
#ifndef PROBE
#define PROBE 0
#endif
#define REP(k) for (int rep_ = 0; rep_ < ((PROBE == (k)) ? 2 : 1); ++rep_)

struct Params {
    const float* in[27];
    float* out;
    unsigned char* ws;
    int ph_lo, ph_hi;
};


__device__ __forceinline__ const float* inp(int i) {
    const __attribute__((address_space(4))) char* ka = (const __attribute__((address_space(4))) char*)__builtin_amdgcn_kernarg_segment_ptr();
    int off = i * 8; asm volatile("" : "+s"(off));
    return *(const float* const __attribute__((address_space(4)))*)(ka + off);
}

__device__ __forceinline__ int tid_l() { int t = threadIdx.x; asm volatile("" : "+v"(t)); return t; }
__device__ __forceinline__ float bf2f(bf16_t b) { return __uint_as_float(((unsigned)b) << 16); }
__device__ __forceinline__ unsigned cvt_pk_bf16(float lo, float hi) { unsigned r; asm volatile("v_cvt_pk_bf16_f32 %0, %1, %2" : "=v"(r) : "v"(lo), "v"(hi)); return r; }
__device__ __forceinline__ float lo_bf(unsigned u) { return __uint_as_float(u << 16); }
__device__ __forceinline__ float hi_bf(unsigned u) { return __uint_as_float(u & 0xffff0000u); }
__device__ __forceinline__ float gelu_tanh(float x) {
    const float y2 = 1.5957691216f * (x + 0.044715f * x * x * x);
    return x * __builtin_amdgcn_rcpf(1.0f + __expf(-y2));
}
__device__ __forceinline__ float silu(float x) { return x * __builtin_amdgcn_rcpf(1.0f + __expf(-x)); }
__device__ __forceinline__ float wave_sum(float v) {
#pragma unroll
    for (int o = 32; o > 0; o >>= 1) v += __shfl_xor(v, o, 64);
    return v;
}

#define XB_TMO      128
#define XB_XCNT(j)  (256  + 64 * (j))
#define XB_XSUB(j)  (1280 + 64 * (j))
#define XB_XGEN(j)  (2304 + 64 * (j))
#define XB_TOP      3328
#define XB_TOPGEN   3392
#define XCD_BAR_WORDS 3456
#define XB_SPIN_CAP (1u << 18)

__device__ __forceinline__ unsigned xb_ld(unsigned* p)              { return __hip_atomic_load(p, __ATOMIC_RELAXED, __HIP_MEMORY_SCOPE_AGENT); }
__device__ __forceinline__ unsigned xb_add(unsigned* p, unsigned v) { return __hip_atomic_fetch_add(p, v, __ATOMIC_RELAXED, __HIP_MEMORY_SCOPE_AGENT); }
__device__ __forceinline__ unsigned xb_xcc_id() { return (unsigned)__builtin_amdgcn_s_getreg((3 << 11) | 20) & 0xFu; }
#define XB_SPIN(cond, bar) do { unsigned _sp = 0; while (cond) { __builtin_amdgcn_s_sleep(1); \
    if ((++_sp & 255u) == 0u) { if (xb_ld(&(bar)[XB_TMO])) break; if (_sp > XB_SPIN_CAP) { atomicAdd(&(bar)[XB_TMO], 1u); break; } } } } while (0)

struct XcdBarrier {
    unsigned* bar; unsigned x;
    volatile LAS unsigned* st;
};

__device__ __forceinline__ XcdBarrier xcd_barrier_post(unsigned* bar, volatile LAS unsigned* st) {
    XcdBarrier b; b.bar = bar; b.x = xb_xcc_id(); b.st = st;
    if (threadIdx.x == 0) (void)xb_add(&bar[XB_XCNT(b.x)], 1u);
    return b;
}
__device__ __forceinline__ void xcd_barrier_complete(unsigned* bar, unsigned x, unsigned& nloc, unsigned& nx) {
    const unsigned G = gridDim.x * gridDim.y * gridDim.z;
    unsigned sum, cnt, mine, sp = 0u;
    for (;;) {
        sum = 0u; cnt = 0u; mine = 0u;
#pragma unroll
        for (unsigned j = 0; j < 16; ++j) { const unsigned c = xb_ld(&bar[XB_XCNT(j)]); sum += c; cnt += (c > 0u) ? 1u : 0u; mine = (j == x) ? c : mine; }
        if (sum == G) break;
        __builtin_amdgcn_s_sleep(1);
        if ((++sp & 255u) == 0u) { if (xb_ld(&bar[XB_TMO])) break; if (sp > XB_SPIN_CAP) { atomicAdd(&bar[XB_TMO], 1u); break; } }
    }
    nloc = mine > 0u ? mine : 1u; nx = cnt > 0u ? cnt : 1u;
}

__device__ __forceinline__ void xcd_barrier(const XcdBarrier& b) {
    asm volatile("s_waitcnt vmcnt(0)" ::: "memory");
    __syncthreads();
    if (threadIdx.x == 0) {
        unsigned* bar = b.bar;
        __builtin_amdgcn_s_waitcnt(0);
        unsigned nloc = b.st[0], nx = b.st[1];
        if (nloc == 0u) { xcd_barrier_complete(bar, b.x, nloc, nx); b.st[0] = nloc; b.st[1] = nx; }
        const unsigned old = xb_add(&bar[XB_XSUB(b.x)], 1u);
        const unsigned gen = old / nloc;
        if (old + 1u == (gen + 1u) * nloc) {
            __builtin_amdgcn_fence(__ATOMIC_RELEASE, "agent");
            asm volatile("s_waitcnt vmcnt(0)" ::: "memory");
            const unsigned og = xb_add(&bar[XB_TOP], 1u);
            const unsigned tg = og / nx;
            if (og + 1u == (tg + 1u) * nx) xb_add(&bar[XB_TOPGEN], 1u);
            else XB_SPIN(xb_ld(&bar[XB_TOPGEN]) == tg, bar);
            __builtin_amdgcn_fence(__ATOMIC_ACQUIRE, "agent");
            xb_add(&bar[XB_XGEN(b.x)], 1u);
            asm volatile("s_waitcnt vmcnt(0)" ::: "memory");
        } else {
            XB_SPIN(xb_ld(&bar[XB_XGEN(b.x)]) == gen, bar);
            __builtin_amdgcn_fence(__ATOMIC_ACQUIRE, "agent");
            asm volatile("s_waitcnt vmcnt(0)" ::: "memory");
        }
    }
    __syncthreads();
}


namespace pg8 {
constexpr int BM = 256, BK = 64, HALF = 128, HTB = HALF * BK * 2, STAGE_BYTES = 8 * HTB, NXCD = 8, WGM = 8;
__host__ __device__ __forceinline__ int lds_byte(int r, int c) { const int st = (r >> 4) * 2 + (c >> 5), rr = r & 15, cc = c & 31, ob = rr * 64 + cc * 2; return st * 1024 + (ob ^ (((ob >> 9) & 1) << 5)); }
__host__ __device__ __forceinline__ void stage_rc(int b, int& R, int& C) { const int st = b / 1024, sb = b % 1024, swz = sb ^ (((sb >> 9) & 1) << 5); R = (st >> 1) * 16 + swz / 64; C = (st & 1) * 32 + (swz % 64) / 2; }
__host__ __device__ __forceinline__ int perm32(int rho) { const int n = rho >> 4, i = rho & 15; return 8 * (i >> 2) + 4 * n + (i & 3); }
struct Unit { int pm, pn; };
struct Gemm { const bf16_t* A; const bf16_t* Bt; int M, N, K; };
struct StaticOrder {
    int nM, nN, nwg, G, c;
    __device__ void init(int M, int N, int G_, int c_) { nM = M / BM; nN = N / BM; nwg = nM * nN; G = G_; c = c_; }
    __device__ void init_tiles(int nM_, int nN_, int G_, int c_) { nM = nM_; nN = nN_; nwg = nM * nN; G = G_; c = c_; }
    __device__ bool next(int i, Unit& u) const {
        const long L = (long)i * G + c; if (L >= nwg) return false;
        int wgid = (int)L; { const int q = nwg / NXCD, r = nwg % NXCD, xcd = wgid % NXCD, off = wgid / NXCD; wgid = (xcd < r ? xcd * (q + 1) : r * (q + 1) + (xcd - r) * q) + off; }
        const int nig = WGM * nN, gid = wgid / nig, fm = gid * WGM, gsz = (nM - fm) < WGM ? (nM - fm) : WGM;
        u.pm = fm + ((wgid % nig) % gsz); u.pn = (wgid % nig) / gsz; return true;
    }
};
struct EpiBf16 {
    static constexpr bool PERM = true, CONV = false, AFTER_DRAIN = false; static constexpr int GAPA = 0;
    bf16_t* O; int ldc;
    __device__ __forceinline__ void operator()(const f32x4 (&acc)[2][2][4][2], const Unit& u, int wr, int wc, int fr, int fq) const {
        const int row0 = u.pm * BM + wr * 64 + fr; const int col0 = u.pn * BM + wc * 32 + 8 * fq;
#pragma unroll
        for (int ai = 0; ai < 2; ++ai)
#pragma unroll
            for (int m = 0; m < 4; ++m) { bf16_t* rowp = O + (size_t)(row0 + ai * HALF + m * 16) * ldc + col0;
#pragma unroll
                for (int bj = 0; bj < 2; ++bj) { const f32x4 v0 = acc[ai][bj][m][0], v1 = acc[ai][bj][m][1];
                    u32x4 w; w.x = cvt_pk_bf16(v0[0], v0[1]); w.y = cvt_pk_bf16(v0[2], v0[3]); w.z = cvt_pk_bf16(v1[0], v1[1]); w.w = cvt_pk_bf16(v1[2], v1[3]);
                    *(u32x4*)(rowp + bj * HALF) = w; } }
    }
};
struct EpiBf16Gm {
    static constexpr bool PERM = true, CONV = false, AFTER_DRAIN = false; static constexpr int GAPA = D_MODEL * 2;
    bf16_t* O; int ldc; float* stats;
    __device__ __forceinline__ void operator()(const f32x4 (&acc)[2][2][4][2], const Unit& u, int wr, int wc, int fr, int fq) const {
        const int row0 = u.pm * BM + wr * 64 + fr; const int col0 = u.pn * BM + wc * 32 + 8 * fq;
        const bool act = u.pn >= 11, st = u.pn >= 14;
#pragma unroll
        for (int ai = 0; ai < 2; ++ai)
#pragma unroll
            for (int m = 0; m < 4; ++m) { const int row = row0 + ai * HALF + m * 16; bf16_t* rowp = O + (size_t)row * ldc + col0; float s1 = 0.f, s2 = 0.f;
#pragma unroll
                for (int bj = 0; bj < 2; ++bj) { f32x4 v0 = acc[ai][bj][m][0], v1 = acc[ai][bj][m][1];
                    if (act) {
#pragma unroll
                        for (int j = 0; j < 4; ++j) { v0[j] = gelu_tanh(v0[j]); v1[j] = gelu_tanh(v1[j]); s1 += v0[j] + v1[j]; s2 += v0[j] * v0[j] + v1[j] * v1[j]; } }
                    u32x4 w; w.x = cvt_pk_bf16(v0[0], v0[1]); w.y = cvt_pk_bf16(v0[2], v0[3]); w.z = cvt_pk_bf16(v1[0], v1[1]); w.w = cvt_pk_bf16(v1[2], v1[3]);
                    *(u32x4*)(rowp + bj * HALF) = w; }
                if (st) { s1 += __shfl_xor(s1, 16, 64); s2 += __shfl_xor(s2, 16, 64); s1 += __shfl_xor(s1, 32, 64); s2 += __shfl_xor(s2, 32, 64);
                    if (fq == 0) *(float2*)(stats + ((size_t)row * 12 + (u.pn - 14) * 4 + wc) * 2) = make_float2(s1, s2); } }
    }
};
__device__ __forceinline__ float dpp_ror1(float v) { return __builtin_bit_cast(float, __builtin_amdgcn_mov_dpp(__builtin_bit_cast(int, v), 0x121, 0xf, 0xf, true)); }
__device__ __forceinline__ float dpp_rol1(float v) { return __builtin_bit_cast(float, __builtin_amdgcn_mov_dpp(__builtin_bit_cast(int, v), 0x12F, 0xf, 0xf, true)); }
struct EpiConvAct {
    static constexpr bool PERM = true, CONV = true, AFTER_DRAIN = false; static constexpr int GAPA = 0;
    bf16_t* ACT; const float* cw; const float* cb;
    __device__ __forceinline__ void operator()(const f32x4 (&acc)[2][2][4][2], const Unit& u, int wr, int wc, int fr, int fq) const {
        const bool f0 = fr == 0, f15 = fr == 15;
#pragma unroll
        for (int n = 0; n < 2; ++n) {
            const int cg = 128 * u.pn + 32 * wc + 8 * fq + 4 * n;
            f32x4 wg[3], wv[3];
#pragma unroll
            for (int k = 0; k < 3; ++k) { wg[k] = *(const f32x4*)(cw + k * D_UP + cg); wv[k] = *(const f32x4*)(cw + k * D_UP + D_FF + cg); }
            const f32x4 bg = *(const f32x4*)(cb + cg), bv = *(const f32x4*)(cb + D_FF + cg);
#pragma unroll
            for (int ai = 0; ai < 2; ++ai) { const int pbase = 248 * u.pm + 62 * (2 * ai + wr);
                float rpg[4], rpv[4], lcg[4], lcv[4];
#pragma unroll
                for (int j = 0; j < 4; ++j) { rpg[j] = 0.f; rpv[j] = 0.f; lcg[j] = dpp_rol1(acc[ai][0][0][n][j]); lcv[j] = dpp_rol1(acc[ai][1][0][n][j]); }
#pragma unroll
                for (int m = 0; m < 4; ++m) { const int q = 16 * m + fr, pr = pbase + q; const int G = pr - 1 - (pr > 4097 ? 1 : 0);
                    const f32x4 gc = acc[ai][0][m][n], vc = acc[ai][1][m][n]; float o[4];
#pragma unroll
                    for (int j = 0; j < 4; ++j) {
                        const float rg = dpp_ror1(gc[j]), rv = dpp_ror1(vc[j]);
                        const float gp = (m > 0 && f0) ? rpg[j] : rg, vp = (m > 0 && f0) ? rpv[j] : rv;
                        float gn = lcg[j], vn = lcv[j];
                        if (m < 3) { const float a = dpp_rol1(acc[ai][0][m + 1][n][j]), b = dpp_rol1(acc[ai][1][m + 1][n][j]); gn = f15 ? a : gn; vn = f15 ? b : vn; lcg[j] = a; lcv[j] = b; }
                        rpg[j] = rg; rpv[j] = rv;
                        const float ga = __builtin_fmaf(wg[0][j], gp, __builtin_fmaf(wg[1][j], gc[j], __builtin_fmaf(wg[2][j], gn, bg[j])));
                        float va = __builtin_fmaf(wv[2][j], vn, bv[j]); asm volatile("" : "+v"(va));
                        va = __builtin_fmaf(wv[1][j], vc[j], va); asm volatile("" : "+v"(va));
                        va = __builtin_fmaf(wv[0][j], vp, va);
                        o[j] = silu(ga) * va; }
                    if (q >= 1 && q <= 62 && pr >= 1 && pr != 4097 && pr <= 8193) { u32x2 ow; ow.x = cvt_pk_bf16(o[0], o[1]); ow.y = cvt_pk_bf16(o[2], o[3]); *(u32x2*)(ACT + (size_t)G * D_FF + cg) = ow; } } }
        }
    }
};
template <bool RF32, bool FINAL> struct EpiResNorm {
    static constexpr bool PERM = true, CONV = false, AFTER_DRAIN = true; static constexpr int GAPA = 0;
    bf16_t* C; const void* R; int ldc; const float* gain; bf16_t* Hout; float* Fout; float* ssp; unsigned* cnt;
    __device__ __forceinline__ void operator()(f32x4 (&acc)[2][2][4][2], const Unit& u, int wr, int wc, int fr, int fq) const {
        const int row0 = u.pm * BM + wr * 64 + fr, col0 = u.pn * BM + wc * 32 + 8 * fq;
#pragma unroll
        for (int ai = 0; ai < 2; ++ai)
#pragma unroll
            for (int m = 0; m < 4; ++m) { const int row = row0 + ai * HALF + m * 16; const size_t ro = (size_t)row * ldc + col0; float sq = 0.f;
#pragma unroll
                for (int bj = 0; bj < 2; ++bj) { f32x4 r0, r1;
                    if (RF32) { const float* rp = (const float*)R + ro + bj * HALF; r0 = *(const f32x4*)rp; r1 = *(const f32x4*)(rp + 4); }
                    else { const u32x4 rr = *(const u32x4*)((const bf16_t*)R + ro + bj * HALF);
                        r0 = (f32x4){lo_bf(rr.x), hi_bf(rr.x), lo_bf(rr.y), hi_bf(rr.y)}; r1 = (f32x4){lo_bf(rr.z), hi_bf(rr.z), lo_bf(rr.w), hi_bf(rr.w)}; }
                    const f32x4 o0 = acc[ai][bj][m][0] + r0, o1 = acc[ai][bj][m][1] + r1; acc[ai][bj][m][0] = o0; acc[ai][bj][m][1] = o1;
                    sq += o0[0] * o0[0] + o0[1] * o0[1] + o0[2] * o0[2] + o0[3] * o0[3] + o1[0] * o1[0] + o1[1] * o1[1] + o1[2] * o1[2] + o1[3] * o1[3]; }
                sq += __shfl_xor(sq, 16, 64); sq += __shfl_xor(sq, 32, 64);
                if (fq == 0) __hip_atomic_store(ssp + (size_t)row * 32 + u.pn * 4 + wc, sq, __ATOMIC_RELAXED, __HIP_MEMORY_SCOPE_AGENT); }
        asm volatile("s_waitcnt vmcnt(0)" ::: "memory");
        __syncthreads();
        if (threadIdx.x == 0) {
            __hip_atomic_fetch_add(cnt + u.pm, 1u, __ATOMIC_RELAXED, __HIP_MEMORY_SCOPE_AGENT);
            unsigned spins = 0;
            while (__hip_atomic_load(cnt + u.pm, __ATOMIC_RELAXED, __HIP_MEMORY_SCOPE_AGENT) < 8u) { __builtin_amdgcn_s_sleep(2); if (++spins > (1u << 22)) break; }
            __builtin_amdgcn_fence(__ATOMIC_ACQUIRE, "agent");
            asm volatile("s_waitcnt vmcnt(0)" ::: "memory");
        }
        __syncthreads();
        f32x4 g0[2], g1[2];
#pragma unroll
        for (int bj = 0; bj < 2; ++bj) { g0[bj] = *(const f32x4*)(gain + col0 + bj * HALF); g1[bj] = *(const f32x4*)(gain + col0 + bj * HALF + 4); }
#pragma unroll
        for (int ai = 0; ai < 2; ++ai)
#pragma unroll
            for (int m = 0; m < 4; ++m) { const int row = row0 + ai * HALF + m * 16; const size_t ro = (size_t)row * ldc + col0;
                const f32x4* q = (const f32x4*)(ssp + (size_t)row * 32 + 8 * fq); const f32x4 a = q[0] + q[1];
                float v = (a[0] + a[1]) + (a[2] + a[3]); v += __shfl_xor(v, 16, 64); v += __shfl_xor(v, 32, 64);
                const float rs = rsqrtf(v * (1.0f / D_MODEL) + 1e-6f);
#pragma unroll
                for (int bj = 0; bj < 2; ++bj) { const f32x4 o0 = acc[ai][bj][m][0], o1 = acc[ai][bj][m][1];
                    if (!FINAL) { u32x4 w; w.x = cvt_pk_bf16(o0[0], o0[1]); w.y = cvt_pk_bf16(o0[2], o0[3]); w.z = cvt_pk_bf16(o1[0], o1[1]); w.w = cvt_pk_bf16(o1[2], o1[3]);
                        *(u32x4*)(C + ro + bj * HALF) = w; }
                    const f32x4 y0 = o0 * rs * g0[bj], y1 = o1 * rs * g1[bj];
                    if (FINAL) { float* op = Fout + ro + bj * HALF; *(f32x4*)op = y0; *(f32x4*)(op + 4) = y1; }
                    else { u32x4 w; w.x = cvt_pk_bf16(y0[0], y0[1]); w.y = cvt_pk_bf16(y0[2], y0[3]); w.z = cvt_pk_bf16(y1[0], y1[1]); w.w = cvt_pk_bf16(y1[2], y1[3]);
                        *(u32x4*)(Hout + (size_t)(row + 1 + (row >> 12)) * ldc + col0 + bj * HALF) = w; } } }
    }
};

template <class Epi, class Sched, int KDIM>
__device__ __forceinline__ void gemm_phase(LAS unsigned char* lds, const Gemm g, const Sched& S, const Epi& E) {
    int tid_ = threadIdx.x; asm volatile("" : "+v"(tid_));
    const int tid = tid_, wid = __builtin_amdgcn_readfirstlane(tid >> 6), lane = tid & 63, wr = wid >> 2, wc = wid & 3, fr = lane & 15, fq = lane >> 4;
    constexpr int K = KDIM, nt = K / BK;
    unsigned voffA[2], voffB[2];
#pragma unroll
    for (int i = 0; i < 2; ++i) { int R, C; stage_rc(tid * 16 + i * 8192, R, C); const int Rb = Epi::PERM ? ((R & ~31) + perm32(R & 31)) : R;
        const int Ra = Epi::CONV ? (62 * (R >> 6) + (R & 63)) : R;
        voffA[i] = (unsigned)(Ra * K + C) * 2u; voffB[i] = (unsigned)(Rb * K + C) * 2u; }
    const size_t kstep = (size_t)(BK * 2);
    const size_t hstep = (size_t)HALF * K * 2;
    const size_t tstep = 2 * hstep;
    const size_t hstepA = Epi::CONV ? (size_t)124 * K * 2 : hstep, tstepA = 2 * hstepA;
    const unsigned ldsw = (unsigned)wid * 1024u;
    const int aoff = lds_byte(wr * 64 + fr, fq * 8), boff = lds_byte(wc * 32 + fr, fq * 8);
#define PG8_SA(b, h) (((b) * 2 + (h)) * HTB)
#define PG8_SB(b, h) ((4 + (b) * 2 + (h)) * HTB)
#define PG8_STAGE(bufoff, gbase, voff) do { _Pragma("unroll") for (int _i = 0; _i < 2; ++_i) \
        __builtin_amdgcn_global_load_lds((const unsigned*)((const char*)(gbase) + (voff)[_i]), (LAS unsigned*)(lds + (bufoff) + ldsw + _i * 8192), 16, 0, 0); } while (0)
#define PG8_LDA(dst, b, h) do { _Pragma("unroll") for (int m = 0; m < 4; ++m) _Pragma("unroll") for (int k = 0; k < 2; ++k) dst[m][k] = *(const LAS bf16x8*)(lds + PG8_SA(b, h) + aoff + m * 2048 + k * 1024); } while (0)
#define PG8_LDB(dst, b, h) do { _Pragma("unroll") for (int n = 0; n < 2; ++n) _Pragma("unroll") for (int k = 0; k < 2; ++k) dst[n][k] = *(const LAS bf16x8*)(lds + PG8_SB(b, h) + boff + n * 2048 + k * 1024); } while (0)
#define PG8_MMA(ai, bj, At, Bt) do { __builtin_amdgcn_s_setprio(1); _Pragma("unroll") for (int m = 0; m < 4; ++m) _Pragma("unroll") for (int n = 0; n < 2; ++n) _Pragma("unroll") for (int k = 0; k < 2; ++k) \
        acc[ai][bj][m][n] = __builtin_amdgcn_mfma_f32_16x16x32_bf16(Bt[n][k], At[m][k], acc[ai][bj][m][n], 0, 0, 0); __builtin_amdgcn_s_setprio(0); } while (0)
#define PG8_WAIT_V(n) asm volatile("s_waitcnt vmcnt(" #n ")" ::: "memory")
#define PG8_WAIT_L(n) asm volatile("s_waitcnt lgkmcnt(" #n ")" ::: "memory")
#define PG8_BAR __builtin_amdgcn_s_barrier()
#define PG8_SCHED __builtin_amdgcn_sched_barrier(0)
    Unit cur, nxt; int ui = 0;
    if (!S.next(0, cur)) return;
    f32x4 acc[2][2][4][2];
#pragma unroll
    for (int a = 0; a < 2; ++a)
#pragma unroll
        for (int b = 0; b < 2; ++b)
#pragma unroll
            for (int m = 0; m < 4; ++m)
#pragma unroll
                for (int n = 0; n < 2; ++n) acc[a][b][m][n] = (f32x4){0.f, 0.f, 0.f, 0.f};
    bf16x8 At[4][2], B0[2][2], B1[2][2];
    const char* cA = (const char*)g.A + (size_t)cur.pm * tstepA + (cur.pm >= 16 ? Epi::GAPA : 0); const char* cB = (const char*)g.Bt + (size_t)cur.pn * tstep;
    PG8_STAGE(PG8_SB(0, 0), cB, voffB); PG8_STAGE(PG8_SA(0, 0), cA, voffA); PG8_STAGE(PG8_SB(0, 1), cB + hstep, voffB); PG8_STAGE(PG8_SA(0, 1), cA + hstepA, voffA);
    if (wr == 1) PG8_BAR;
    PG8_WAIT_V(4); PG8_BAR;
    PG8_STAGE(PG8_SB(1, 0), cB + kstep, voffB); PG8_STAGE(PG8_SA(1, 0), cA + kstep, voffA); PG8_STAGE(PG8_SB(1, 1), cB + hstep + kstep, voffB);
    PG8_WAIT_V(6); PG8_BAR;
    for (;;) {
        const bool has_next = S.next(ui + 1, nxt);
        const char* nA = has_next ? (const char*)g.A + (size_t)nxt.pm * tstepA + (nxt.pm >= 16 ? Epi::GAPA : 0) : cA; const char* nB = has_next ? (const char*)g.Bt + (size_t)nxt.pn * tstep : cB;
        for (int t = 0; t < nt; t += 2) {
            const bool last = (t == nt - 2);
            const char* a1 = cA + (size_t)(t + 1) * kstep;
            const char* a2 = last ? nA : cA + (size_t)(t + 2) * kstep; const char* b2 = last ? nB : cB + (size_t)(t + 2) * kstep;
            const char* a3 = a2 + kstep; const char* b3 = b2 + kstep;
            PG8_LDB(B0, 0, 0); PG8_SCHED; PG8_LDA(At, 0, 0); PG8_STAGE(PG8_SA(1, 1), a1 + hstepA, voffA);
            PG8_WAIT_L(8); PG8_BAR; PG8_WAIT_L(0); PG8_MMA(0, 0, At, B0); PG8_BAR; PG8_SCHED;
            PG8_LDB(B1, 0, 1); PG8_STAGE(PG8_SB(0, 0), b2, voffB);
            PG8_BAR; PG8_WAIT_L(0); PG8_MMA(0, 1, At, B1); PG8_BAR;
            PG8_LDA(At, 0, 1); PG8_STAGE(PG8_SA(0, 0), a2, voffA);
            PG8_BAR; PG8_WAIT_L(0); PG8_MMA(1, 0, At, B0); PG8_BAR; PG8_SCHED;
            PG8_STAGE(PG8_SB(0, 1), b2 + hstep, voffB);
            PG8_WAIT_V(6); PG8_BAR; PG8_MMA(1, 1, At, B1); PG8_BAR;
            PG8_LDB(B0, 1, 0); PG8_SCHED; PG8_LDA(At, 1, 0); PG8_STAGE(PG8_SA(0, 1), a2 + hstepA, voffA);
            PG8_WAIT_L(8); PG8_BAR; PG8_WAIT_L(0); PG8_MMA(0, 0, At, B0); PG8_BAR; PG8_SCHED;
            PG8_LDB(B1, 1, 1); PG8_STAGE(PG8_SB(1, 0), b3, voffB);
            PG8_BAR; PG8_WAIT_L(0); PG8_MMA(0, 1, At, B1); PG8_BAR;
            PG8_LDA(At, 1, 1); PG8_STAGE(PG8_SA(1, 0), a3, voffA);
            PG8_BAR; PG8_WAIT_L(0); PG8_MMA(1, 0, At, B0); PG8_BAR; PG8_SCHED;
            PG8_STAGE(PG8_SB(1, 1), b3 + hstep, voffB);
            PG8_WAIT_V(6); PG8_BAR; PG8_MMA(1, 1, At, B1); PG8_BAR;
        }
        if constexpr (!Epi::AFTER_DRAIN) E(acc, cur, wr, wc, fr, fq);
        if (!has_next) break;
#pragma unroll
        for (int a = 0; a < 2; ++a)
#pragma unroll
            for (int b = 0; b < 2; ++b)
#pragma unroll
                for (int m = 0; m < 4; ++m)
#pragma unroll
                    for (int n = 0; n < 2; ++n) acc[a][b][m][n] = (f32x4){0.f, 0.f, 0.f, 0.f};
        cur = nxt; cA = nA; cB = nB; ++ui;
    }
    PG8_WAIT_V(0);
    if (wr == 0) PG8_BAR;
    PG8_BAR;
    if constexpr (Epi::AFTER_DRAIN) E(acc, cur, wr, wc, fr, fq);
#undef PG8_SA
#undef PG8_SB
#undef PG8_STAGE
#undef PG8_LDA
#undef PG8_LDB
#undef PG8_MMA
#undef PG8_WAIT_V
#undef PG8_WAIT_L
#undef PG8_BAR
#undef PG8_SCHED
}
}

__device__ __forceinline__ void convert_tile(const float* __restrict__ W, int K, int N, bf16_t* __restrict__ Wt, int k0, int n0, int orow0, float* tile) {
    const int tid = tid_l();
    { const int r = tid >> 4, c4 = (tid & 15) * 4;
#pragma unroll
      for (int ps = 0; ps < 2; ++ps) { const int rr = r + ps * 32; const float4 v = *(const float4*)(W + (size_t)(k0 + rr) * N + n0 + c4);
          tile[rr * 65 + c4 + 0] = v.x; tile[rr * 65 + c4 + 1] = v.y; tile[rr * 65 + c4 + 2] = v.z; tile[rr * 65 + c4 + 3] = v.w; } }
    __syncthreads();
    { const int n = tid >> 3, k8 = (tid & 7) * 8; float v[8];
#pragma unroll
      for (int j = 0; j < 8; ++j) v[j] = tile[(k8 + j) * 65 + n];
      u32x4 w; w.x = cvt_pk_bf16(v[0], v[1]); w.y = cvt_pk_bf16(v[2], v[3]); w.z = cvt_pk_bf16(v[4], v[5]); w.w = cvt_pk_bf16(v[6], v[7]);
      *(u32x4*)(Wt + (size_t)(orow0 + n) * K + k0 + k8) = w; }
    __syncthreads();
}

constexpr int NI_IN = 32 * 68, NI_OUT = 32 * 32, NI_UP = 32 * 176, NI_DN = 88 * 32, NI_POOL = 16, NI_LAYER = NI_IN + NI_OUT + NI_UP + NI_DN + NI_POOL;
constexpr int NI_FILT = 256;
constexpr int NT3 = 1600;
constexpr int R_OUT = NI_IN, R_UP = NI_IN + NI_OUT, R_DN = NI_IN + NI_OUT + NI_UP, R_POOL = NI_IN + NI_OUT + NI_UP + NI_DN;
__device__ void convert_item(const Params& p, int l, int r, float* lds) {
    if (r < NI_IN) { const int tn = r / 32, tk = r % 32;
        convert_tile(inp(2) + (size_t)l * D_MODEL * D_INP, D_MODEL, D_INP, (bf16_t*)(p.ws + OFF_WT_IN + l * SZ_WT_IN), tk * 64, tn * 64, tn * 64, lds); return; }
    r -= NI_IN;
    if (r < NI_OUT) { const int tn = r / 32, tk = r % 32;
        convert_tile(inp(20) + (size_t)l * D_MODEL * D_MODEL, D_MODEL, D_MODEL, (bf16_t*)(p.ws + OFF_WT_OUT + l * SZ_WT_OUT), tk * 64, tn * 64, tn * 64, lds); return; }
    r -= NI_OUT;
    if (r < NI_UP) { const int tn = r / 32, tk = r % 32; const int n0 = tn * 64, s = n0 / D_FF, rem = n0 % D_FF, j = rem / 128, i = rem % 128;
        convert_tile(inp(22) + (size_t)l * D_MODEL * D_UP, D_MODEL, D_UP, (bf16_t*)(p.ws + OFF_WT_UP + l * SZ_WT_UP), tk * 64, n0, 256 * j + 128 * s + i, lds); return; }
    r -= NI_UP;
    if (r < NI_DN) { const int tn = r / 88, tk = r % 88;
        convert_tile(inp(25) + (size_t)l * D_FF * D_MODEL, D_FF, D_MODEL, (bf16_t*)(p.ws + OFF_WT_DN + l * SZ_WT_DN), tk * 64, tn * 64, tn * 64, lds); return; }
    r -= NI_DN;
    { const int g = r >> 2, tn = (r >> 1) & 1, tk = r & 1;
        convert_tile(inp(3) + (size_t)(l * 4 + g) * 128 * 128, 128, 128, (bf16_t*)(p.ws + OFF_POOLWT + l * SZ_POOLWT) + g * 128 * 128, tk * 64, tn * 64, tn * 64, lds); }
}

__device__ __forceinline__ float sin_rad(float x) { return __builtin_amdgcn_sinf(x * 0.15915494309f); }

struct CvDesc { const float* W; bf16_t* Wt; int K, N, k0, n0, orow0; };
__device__ __forceinline__ CvDesc cv_desc(const Params& p, int l, int r) {
    CvDesc d;
    if (r < R_OUT) { const int tn = r / 32, tk = r % 32; d.W = inp(2) + (size_t)l * D_MODEL * D_INP; d.Wt = (bf16_t*)(p.ws + OFF_WT_IN + l * SZ_WT_IN); d.K = D_MODEL; d.N = D_INP; d.k0 = tk * 64; d.n0 = tn * 64; d.orow0 = tn * 64; }
    else if (r < R_UP) { r -= R_OUT; const int tn = r / 32, tk = r % 32; d.W = inp(20) + (size_t)l * D_MODEL * D_MODEL; d.Wt = (bf16_t*)(p.ws + OFF_WT_OUT + l * SZ_WT_OUT); d.K = D_MODEL; d.N = D_MODEL; d.k0 = tk * 64; d.n0 = tn * 64; d.orow0 = tn * 64; }
    else if (r < R_DN) { r -= R_UP; const int tn = r / 32, tk = r % 32; const int n0 = tn * 64, sg = n0 / D_FF, rem = n0 % D_FF, j = rem / 128, i = rem % 128;
        d.W = inp(22) + (size_t)l * D_MODEL * D_UP; d.Wt = (bf16_t*)(p.ws + OFF_WT_UP + l * SZ_WT_UP); d.K = D_MODEL; d.N = D_UP; d.k0 = tk * 64; d.n0 = n0; d.orow0 = 256 * j + 128 * sg + i; }
    else if (r < R_POOL) { r -= R_DN; const int tn = r / 88, tk = r % 88; d.W = inp(25) + (size_t)l * D_FF * D_MODEL; d.Wt = (bf16_t*)(p.ws + OFF_WT_DN + l * SZ_WT_DN); d.K = D_FF; d.N = D_MODEL; d.k0 = tk * 64; d.n0 = tn * 64; d.orow0 = tn * 64; }
    else { r -= R_POOL; const int g = r >> 2, tn = (r >> 1) & 1, tk = r & 1; d.W = inp(3) + (size_t)(l * 4 + g) * 128 * 128; d.Wt = (bf16_t*)(p.ws + OFF_POOLWT + l * SZ_POOLWT) + g * 128 * 128; d.K = 128; d.N = 128; d.k0 = tk * 64; d.n0 = tn * 64; d.orow0 = tn * 64; }
    return d;
}
__device__ __forceinline__ CvDesc cv_pick(const Params& p, int mode, int l, int base, int i) {
    if (mode == 0) { if (i < R_DN) return cv_desc(p, 0, i); if (i < R_DN + NI_POOL) return cv_desc(p, 0, R_POOL + i - R_DN); return cv_desc(p, 1, R_POOL + i - R_DN - NI_POOL); }
    return cv_desc(p, l, base + i);
}
__device__ __forceinline__ void cv_load(const CvDesc& d, int tid, float4 (&v)[2]) {
    const int r = tid >> 4, c4 = (tid & 15) * 4;
#pragma unroll
    for (int ps = 0; ps < 2; ++ps) v[ps] = *(const float4*)(d.W + (size_t)(d.k0 + r + ps * 32) * d.N + d.n0 + c4);
}
__device__ void convert_range(const Params& p, int mode, int l, int base, int count, int start, int stride, float* tile) {
    int i = start; if (i >= count) return;
    const int tid = tid_l();
    CvDesc d = cv_pick(p, mode, l, base, i); float4 v[2]; cv_load(d, tid, v);
    for (;;) {
        { const int r = tid >> 4, c4 = (tid & 15) * 4;
#pragma unroll
          for (int ps = 0; ps < 2; ++ps) { float* tp = tile + (r + ps * 32) * 65 + c4; tp[0] = v[ps].x; tp[1] = v[ps].y; tp[2] = v[ps].z; tp[3] = v[ps].w; } }
        __syncthreads();
        const int ni = i + stride; const bool more = ni < count; CvDesc dn = d;
        if (more) { dn = cv_pick(p, mode, l, base, ni); cv_load(dn, tid, v); }
        { const int n = tid >> 3, k8 = (tid & 7) * 8; float u[8];
#pragma unroll
          for (int j = 0; j < 8; ++j) u[j] = tile[(k8 + j) * 65 + n];
          u32x4 w; w.x = cvt_pk_bf16(u[0], u[1]); w.y = cvt_pk_bf16(u[2], u[3]); w.z = cvt_pk_bf16(u[4], u[5]); w.w = cvt_pk_bf16(u[6], u[7]);
          *(u32x4*)(d.Wt + (size_t)(d.orow0 + n) * d.K + d.k0 + k8) = w; }
        __syncthreads();
        if (!more) break;
        d = dn; i = ni;
    }
}

__device__ __forceinline__ void cv_load4(const CvDesc& d, int tid, float4 (&v)[8]) {
    const int r = tid >> 4, c4 = (tid & 15) * 4;
#pragma unroll
    for (int ps = 0; ps < 8; ++ps) v[ps] = *(const float4*)(d.W + (size_t)(d.k0 + r + ps * 32) * d.N + d.n0 + c4);
}
__device__ void convert_range4(const Params& p, int l, int base, int count4, int start, int stride, float* tile) {
    int i = start; if (i >= count4) return;
    const int tid = tid_l();
    CvDesc d = cv_desc(p, l, base + 4 * i); float4 v[8]; cv_load4(d, tid, v);
    for (;;) {
        { const int r = tid >> 4, c4 = (tid & 15) * 4;
#pragma unroll
          for (int ps = 0; ps < 8; ++ps) { float* tp = tile + (r + ps * 32) * 65 + c4; tp[0] = v[ps].x; tp[1] = v[ps].y; tp[2] = v[ps].z; tp[3] = v[ps].w; } }
        __syncthreads();
        const int ni = i + stride; const bool more = ni < count4; CvDesc dn = d;
        if (more) { dn = cv_desc(p, l, base + 4 * ni); cv_load4(dn, tid, v); }
        { const int n = tid >> 3, kc = tid & 7;
#pragma unroll
          for (int j = 0; j < 4; ++j) { const int k8 = (kc + 8 * j) * 8; float u[8];
#pragma unroll
              for (int q = 0; q < 8; ++q) u[q] = tile[(k8 + q) * 65 + n];
              u32x4 w; w.x = cvt_pk_bf16(u[0], u[1]); w.y = cvt_pk_bf16(u[2], u[3]); w.z = cvt_pk_bf16(u[4], u[5]); w.w = cvt_pk_bf16(u[6], u[7]);
              *(u32x4*)(d.Wt + (size_t)(d.orow0 + n) * d.K + d.k0 + k8) = w; } }
        __syncthreads();
        if (!more) break;
        d = dn; i = ni;
    }
}

__device__ void filter_item(const Params& p, int item, float* lds) {
    const int l = item >> 7, rem = item & 127, ti = rem >> 1, half = rem & 1;
    const int tid = tid_l(), lane = tid & 63, w = __builtin_amdgcn_readfirstlane(tid >> 6);
    const int t = ti * 64 + lane;
    const float* w1 = inp(8) + l * 33 * 64; const float* b1 = inp(9) + l * 64; const float* fr1 = inp(10) + l * 64;
    const float* w2 = inp(11) + l * 64 * 64; const float* b2 = inp(12) + l * 64; const float* fr2 = inp(13) + l * 64;
    const float* w3 = inp(14) + (size_t)l * 64 * 1536;
    float* h1s = lds; float* h2s = lds + 64 * 65;
    const float tt = (float)t / 4095.0f;
    float a[8];
#pragma unroll
    for (int j = 0; j < 8; ++j) a[j] = b1[8 * w + j] + tt * w1[8 * w + j];
    for (int band = 0; band < 16; ++band) {
        const float f = 1e-4f + (float)band * ((15.0f - 1e-4f) / 15.0f);
        float r = f * (float)t * (1.0f / 4096.0f); r -= floorf(r);
        const float cs = __builtin_amdgcn_cosf(r), sn = -__builtin_amdgcn_sinf(r);
#pragma unroll
        for (int j = 0; j < 8; ++j) a[j] += cs * w1[(1 + band) * 64 + 8 * w + j] + sn * w1[(17 + band) * 64 + 8 * w + j];
    }
#pragma unroll
    for (int j = 0; j < 8; ++j) h1s[lane * 65 + 8 * w + j] = sin_rad(fr1[8 * w + j] * a[j]);
    __syncthreads();
#pragma unroll
    for (int j = 0; j < 8; ++j) a[j] = b2[8 * w + j];
    for (int i = 0; i < 64; ++i) { const float h = h1s[lane * 65 + i];
#pragma unroll
        for (int j = 0; j < 8; ++j) a[j] += h * w2[i * 64 + 8 * w + j]; }
#pragma unroll
    for (int j = 0; j < 8; ++j) h2s[lane * 65 + 8 * w + j] = sin_rad(fr2[8 * w + j] * a[j]);
    __syncthreads();
    float* KT = (float*)(p.ws + OFF_ACT) + (size_t)l * 768 * 8192;
    const float d0 = -3.0701134573f, d1 = -15.3505672865f;
    typedef const __attribute__((address_space(4))) f32x4 cf4;
    for (int ci = 0; ci < 24; ++ci) {
        const int c = w * 96 + ci * 4;
        cf4* wc = (cf4*)(unsigned long long)(w3 + half * 768 + c);
        float o0 = 0.f, o1 = 0.f, o2 = 0.f, o3 = 0.f;
#pragma unroll 8
        for (int i = 0; i < 64; ++i) { const float h = h2s[lane * 65 + i]; const f32x4 wv = wc[i * 384]; o0 += h * wv[0]; o1 += h * wv[1]; o2 += h * wv[2]; o3 += h * wv[3]; }
        float o[4] = {o0, o1, o2, o3};
#pragma unroll
        for (int j = 0; j < 4; ++j) {
            const float delta = d0 + (float)(c + j) * ((d1 - d0) / 767.0f);
            const float val = o[j] * __expf(-tt * fabsf(delta));
            float* kt = KT + (size_t)(c + j) * 8192;
            if (half == 0) kt[t] = val; else { if (t == 0) kt[4096] = 0.f; else kt[8192 - t] = val; }
        }
    }
    __syncthreads();
}

__device__ __forceinline__ int phys(int i) { return i + (i >> 5); }
__device__ __forceinline__ float launder_f(float v) { asm volatile("" : "+v"(v)); return v; }
constexpr int FFT_BUF = 8192 + 256;
__device__ __forceinline__ constexpr float c32(int i) { constexpr float T[16] = {1.0f, 0.98078528040f, 0.92387953251f, 0.83146961230f, 0.70710678119f, 0.55557023302f, 0.38268343237f, 0.19509032202f, 0.0f, -0.19509032202f, -0.38268343237f, -0.55557023302f, -0.70710678119f, -0.83146961230f, -0.92387953251f, -0.98078528040f}; return T[i]; }
__device__ __forceinline__ constexpr float s32(int i) { constexpr float T[16] = {0.0f, 0.19509032202f, 0.38268343237f, 0.55557023302f, 0.70710678119f, 0.83146961230f, 0.92387953251f, 0.98078528040f, 1.0f, 0.98078528040f, 0.92387953251f, 0.83146961230f, 0.70710678119f, 0.55557023302f, 0.38268343237f, 0.19509032202f}; return T[i]; }
template <bool INV> __device__ __forceinline__ void radix16(float2 (&x)[16], float rfrac) {
#pragma unroll
    for (int jj = 0; jj < 4; ++jj) { const int j = INV ? 3 - jj : jj; const int half = 8 >> j;
        const float ab = rfrac * (float)(8 / half); const float cb = __builtin_amdgcn_cosf(ab), sb = __builtin_amdgcn_sinf(ab);
#pragma unroll
        for (int kk = 0; kk < half; ++kk) {
            const int idx = kk * (16 / half);
            float cs, sp;
            if (idx == 0) { cs = cb; sp = sb; }
            else if (idx == 8) { cs = -sb; sp = cb; }
            else { cs = cb * c32(idx) - sb * s32(idx); sp = cb * s32(idx) + sb * c32(idx); }
            const float sn = INV ? sp : -sp;
#pragma unroll
            for (int g = 0; g < 16; g += 2 * half) { const int i0 = g + kk, i1 = i0 + half; const float2 a = x[i0], b = x[i1];
                if (!INV) { const float dx = a.x - b.x, dy = a.y - b.y; x[i0] = make_float2(a.x + b.x, a.y + b.y); x[i1] = make_float2(dx * cs - dy * sn, dx * sn + dy * cs); }
                else { const float bx = b.x * cs - b.y * sn, by = b.x * sn + b.y * cs; x[i0] = make_float2(a.x + bx, a.y + by); x[i1] = make_float2(a.x - bx, a.y - by); } }
        }
    }
}
template <bool INV> __device__ __forceinline__ void radix32(float2 (&y)[32]) {
#pragma unroll
    for (int jj = 0; jj < 5; ++jj) { const int j = INV ? 4 - jj : jj; const int half = 16 >> j;
#pragma unroll
        for (int kk = 0; kk < half; ++kk) { const int idx = kk * (16 / half); const float cs = c32(idx), sn = INV ? s32(idx) : -s32(idx);
#pragma unroll
            for (int g = 0; g < 32; g += 2 * half) { const int i0 = g + kk, i1 = i0 + half; const float2 a = y[i0], b = y[i1];
                if (!INV) { const float dx = a.x - b.x, dy = a.y - b.y; y[i0] = make_float2(a.x + b.x, a.y + b.y);
                    if (idx == 0) y[i1] = make_float2(dx, dy);
                    else if (idx == 8) y[i1] = make_float2(dy, -dx);
                    else y[i1] = make_float2(dx * cs - dy * sn, dx * sn + dy * cs); }
                else { float bx, by;
                    if (idx == 0) { bx = b.x; by = b.y; }
                    else if (idx == 8) { bx = -b.y; by = b.x; }
                    else { bx = b.x * cs - b.y * sn; by = b.x * sn + b.y * cs; }
                    y[i0] = make_float2(a.x + bx, a.y + by); y[i1] = make_float2(a.x - bx, a.y - by); } }
        }
    }
}
template <bool INV> __device__ __forceinline__ void fft_pass2(float2* B, int tid, float rfr) {
    const int blk = tid >> 5, r = tid & 31; float2 x[16]; float2* b = B + blk * 528 + r;
#pragma unroll
    for (int k = 0; k < 16; ++k) x[k] = b[33 * k];
    radix16<INV>(x, rfr);
#pragma unroll
    for (int k = 0; k < 16; ++k) b[33 * k] = x[k];
}

__device__ void kf_item(const Params& p, int item, unsigned char* smem) {
    const int l = item / 384, cp = item % 384, c0 = 2 * cp;
    const int tid = tid_l();
    float2* B0 = (float2*)smem; float2* B1 = B0 + FFT_BUF;
    const float* KT = (const float*)(p.ws + OFF_ACT) + ((size_t)l * 768 + c0) * 8192 + tid;
    float2 x0[16], x1[16];
#pragma unroll
    for (int k = 0; k < 16; ++k) { x0[k] = make_float2(KT[512 * k], 0.f); x1[k] = make_float2(KT[8192 + 512 * k], 0.f); }
    const float rf = (float)tid * (1.0f / 8192.0f);
    radix16<false>(x0, rf); radix16<false>(x1, rf);
#pragma unroll
    for (int k = 0; k < 16; ++k) { B0[phys(tid + 512 * k)] = x0[k]; B1[phys(tid + 512 * k)] = x1[k]; }
    __syncthreads();
    { const float r2 = launder_f((float)(tid & 31) * (1.0f / 512.0f)); fft_pass2<false>(B0, tid, r2); fft_pass2<false>(B1, tid, r2); }
    __syncthreads();
    { const int blk = tid & 255, ch = tid >> 8; float2* B = ch ? B1 : B0; float2 y[32];
#pragma unroll
      for (int k = 0; k < 32; ++k) y[k] = B[blk * 33 + k];
      radix32<false>(y);
      float2* KF = (float2*)(p.ws + OFF_KF) + ((size_t)l * 768 + c0 + ch) * 8192 + blk * 2; const float sc = 1.0f / 8192.0f;
#pragma unroll
      for (int k = 0; k < 32; k += 2) *(float4*)(KF + (k >> 1) * 512) = make_float4(y[k].x * sc, y[k].y * sc, y[k + 1].x * sc, y[k + 1].y * sc); }
    __syncthreads();
}

template <bool XF32> __device__ void norm_phase(const void* __restrict__ xin, const float* __restrict__ g, bf16_t* hb, float* hf) {
    const int tid = tid_l(); const int lane = tid & 63; const int gw = blockIdx.x * 8 + (tid >> 6), nw = gridDim.x * 8;
    for (int row = gw; row < NTOK; row += nw) {
        float v[4][8]; float ss = 0.f;
#pragma unroll
        for (int i = 0; i < 4; ++i) { const size_t o = (size_t)row * D_MODEL + i * 512 + lane * 8;
            if (XF32) { const float4 a = *(const float4*)((const float*)xin + o), b = *(const float4*)((const float*)xin + o + 4);
                v[i][0] = a.x; v[i][1] = a.y; v[i][2] = a.z; v[i][3] = a.w; v[i][4] = b.x; v[i][5] = b.y; v[i][6] = b.z; v[i][7] = b.w; }
            else { const u32x4 u = *(const u32x4*)((const bf16_t*)xin + o);
                v[i][0] = lo_bf(u.x); v[i][1] = hi_bf(u.x); v[i][2] = lo_bf(u.y); v[i][3] = hi_bf(u.y); v[i][4] = lo_bf(u.z); v[i][5] = hi_bf(u.z); v[i][6] = lo_bf(u.w); v[i][7] = hi_bf(u.w); }
#pragma unroll
            for (int j = 0; j < 8; ++j) ss += v[i][j] * v[i][j]; }
        ss = wave_sum(ss);
        const float rs = rsqrtf(ss * (1.0f / D_MODEL) + 1e-6f);
#pragma unroll
        for (int i = 0; i < 4; ++i) { const int c = i * 512 + lane * 8; const float4 ga = *(const float4*)(g + c), gb = *(const float4*)(g + c + 4);
            const float y0 = v[i][0] * rs * ga.x, y1 = v[i][1] * rs * ga.y, y2 = v[i][2] * rs * ga.z, y3 = v[i][3] * rs * ga.w, y4 = v[i][4] * rs * gb.x, y5 = v[i][5] * rs * gb.y, y6 = v[i][6] * rs * gb.z, y7 = v[i][7] * rs * gb.w;
            if (hb) { u32x4 w; w.x = cvt_pk_bf16(y0, y1); w.y = cvt_pk_bf16(y2, y3); w.z = cvt_pk_bf16(y4, y5); w.w = cvt_pk_bf16(y6, y7); *(u32x4*)(hb + (size_t)(row + 1 + (row >> 12)) * D_MODEL + c) = w; }
            else { float* op = hf + (size_t)row * D_MODEL + c; *(float4*)op = make_float4(y0, y1, y2, y3); *(float4*)(op + 4) = make_float4(y4, y5, y6, y7); } }
    }
}

__device__ void pool_item(const Params& p, int l, int item, unsigned char* smem) {
    const int tt = item >> 2, g = item & 3;
    const int tid = tid_l(), lane = tid & 63, w = tid >> 6, fr = lane & 15, fq = lane >> 4;
    const bf16_t* P = (const bf16_t*)(p.ws + OFF_P); bf16_t* MIX = (bf16_t*)(p.ws + OFF_MIX);
    const int row0 = tt * 128, b0 = (row0 / SEQ) * SEQ;
    float* X = (float*)smem;
    bf16_t* A = (bf16_t*)(smem + 144 * 129 * 4);
    for (int idx = tid; idx < 144 * 16; idx += 512) { const int r = idx >> 4, c8 = (idx & 15) * 8; const int row = row0 - 8 + r;
        u32x4 v = (u32x4){0u, 0u, 0u, 0u};
        if (row >= b0 && row < b0 + SEQ) v = *(const u32x4*)(P + (size_t)row * D_INP + g * 128 + c8);
        float* xp = X + r * 129 + c8;
        xp[0] = lo_bf(v.x); xp[1] = hi_bf(v.x); xp[2] = lo_bf(v.y); xp[3] = hi_bf(v.y); xp[4] = lo_bf(v.z); xp[5] = hi_bf(v.z); xp[6] = lo_bf(v.w); xp[7] = hi_bf(v.w); }
    __syncthreads();
    { const int c = tid & 127, tq = tid >> 7; const int hw = 1 << g;
      const float* xc = X + (tq * 32 + 8) * 129 + c;
      float s = 0.f;
      for (int q = -hw; q < hw; ++q) s += xc[q * 129];
      const int tb = row0 + tq * 32 - b0;
#pragma unroll 8
      for (int i = 0; i < 32; ++i) { const int t = tb + i; const int lo = max(t - hw, 0), hi = min(t + hw - 1, SEQ - 1);
          const float d = s * __builtin_amdgcn_rcpf((float)(hi - lo + 1)) - xc[i * 129];
          A[(tq * 32 + i) * 136 + c] = (bf16_t)(cvt_pk_bf16(d, 0.f) & 0xffffu);
          s += xc[(i + hw) * 129] - xc[(i - hw) * 129]; } }
    __syncthreads();
    const bf16_t* Wt = (const bf16_t*)(p.ws + OFF_POOLWT + l * SZ_POOLWT) + g * 128 * 128;
    f32x4 acc[8];
#pragma unroll
    for (int nb = 0; nb < 8; ++nb) acc[nb] = (f32x4){0.f, 0.f, 0.f, 0.f};
#pragma unroll
    for (int ks = 0; ks < 4; ++ks) {
        const bf16x8 af = *(const bf16x8*)(A + (16 * w + fr) * 136 + ks * 32 + fq * 8);
#pragma unroll
        for (int nb = 0; nb < 8; ++nb) { const bf16x8 bfr = *(const bf16x8*)(Wt + (nb * 16 + fr) * 128 + ks * 32 + fq * 8);
            acc[nb] = __builtin_amdgcn_mfma_f32_16x16x32_bf16(bfr, af, acc[nb], 0, 0, 0); }
    }
    const float* pb = inp(4) + l * 512 + g * 128; const float* psc = inp(5) + l * 512 + g * 128;
    const int row = row0 + 16 * w + fr;
#pragma unroll
    for (int nb = 0; nb < 8; ++nb) { const int d = nb * 16 + 4 * fq; const float4 bb = *(const float4*)(pb + d), sc = *(const float4*)(psc + d);
        u32x2 o; o.x = cvt_pk_bf16((acc[nb][0] + bb.x) * sc.x, (acc[nb][1] + bb.y) * sc.y); o.y = cvt_pk_bf16((acc[nb][2] + bb.z) * sc.z, (acc[nb][3] + bb.w) * sc.w);
        *(u32x2*)(MIX + (size_t)row * D_MODEL + g * 128 + d) = o; }
    __syncthreads();
}

__device__ void hypre_item(const Params& p, int l, int item, unsigned char* smem) {
    const int tt = item / 6, ct = item % 6; const int tid = tid_l();
    const bf16_t* P = (const bf16_t*)(p.ws + OFF_P); float* ZT = (float*)(p.ws + OFF_ZT); float* X0T = (float*)(p.ws + OFF_X0T);
    const float* sw = inp(6) + (size_t)l * 3 * 2304; const float* sb = inp(7) + (size_t)l * 2304;
    float* zt = (float*)smem;
    float* xt = zt + 128 * 65;
    const int row0 = tt * 64;
    { const int cpq = tid & 63, tr = tid >> 6; const int ch = ct * 128 + 2 * cpq;
      float w[3][3][2], bb[3][2];
#pragma unroll
      for (int s3 = 0; s3 < 3; ++s3) {
#pragma unroll
          for (int k = 0; k < 3; ++k) { const float2 v = *(const float2*)(sw + k * 2304 + s3 * 768 + ch); w[s3][k][0] = v.x; w[s3][k][1] = v.y; }
          const float2 v = *(const float2*)(sb + s3 * 768 + ch); bb[s3][0] = v.x; bb[s3][1] = v.y; }
      const int r0 = row0 + tr * 8; const bf16_t* pr = P + (size_t)r0 * D_INP + COL_HY + ch;
      unsigned pm[3], pc[3], pn[3];
#pragma unroll
      for (int s3 = 0; s3 < 3; ++s3) { pm[s3] = ((r0 & (SEQ - 1)) != 0) ? *(const unsigned*)(pr - D_INP + s3 * 768) : 0u; pc[s3] = *(const unsigned*)(pr + s3 * 768); }
#pragma unroll
      for (int i = 0; i < 8; ++i) { const int row = r0 + i;
#pragma unroll
          for (int s3 = 0; s3 < 3; ++s3) pn[s3] = ((row & (SEQ - 1)) != SEQ - 1) ? *(const unsigned*)(pr + (size_t)(i + 1) * D_INP + s3 * 768) : 0u;
          float o[3][2];
#pragma unroll
          for (int s3 = 0; s3 < 3; ++s3) { o[s3][0] = w[s3][0][0] * lo_bf(pm[s3]) + w[s3][1][0] * lo_bf(pc[s3]) + w[s3][2][0] * lo_bf(pn[s3]) + bb[s3][0];
                                           o[s3][1] = w[s3][0][1] * hi_bf(pm[s3]) + w[s3][1][1] * hi_bf(pc[s3]) + w[s3][2][1] * hi_bf(pn[s3]) + bb[s3][1]; }
          const int tl = tr * 8 + i;
          zt[(2 * cpq) * 65 + tl] = o[1][0] * o[2][0]; zt[(2 * cpq + 1) * 65 + tl] = o[1][1] * o[2][1];
          xt[(2 * cpq) * 65 + tl] = o[0][0]; xt[(2 * cpq + 1) * 65 + tl] = o[0][1];
#pragma unroll
          for (int s3 = 0; s3 < 3; ++s3) { pm[s3] = pc[s3]; pc[s3] = pn[s3]; } } }
    __syncthreads();
    { const int tl = tid & 63, cr = tid >> 6; const int row = row0 + tl, b = row >> 12, t = row & (SEQ - 1);
#pragma unroll
      for (int i = 0; i < 16; ++i) { const int c = cr * 16 + i; const size_t o = (size_t)(ct * 128 + c) * 8192 + b * 4096 + t; ZT[o] = zt[c * 65 + tl]; X0T[o] = xt[c * 65 + tl]; } }
    __syncthreads();
}

constexpr int GM_NH = 3;
__device__ void gmlp_item(const Params& p, int l, int item, unsigned char* smem) {
    const int n = item / (6 / GM_NH), e0 = (item % (6 / GM_NH)) * GM_NH;
    const int tid = tid_l(), lane = tid & 63, w = tid >> 6, fr = lane & 15, fq = lane >> 4;
    const bf16_t* P = (const bf16_t*)(p.ws + OFF_P); bf16_t* MIX = (bf16_t*)(p.ws + OFF_MIX);
    const float* stats = (const float*)(p.ws + OFF_STATS) + (size_t)l * NTOK * 24;
    const float* lng = inp(16) + l * 768; const float* lnb = inp(17) + l * 768;
    bf16_t* VT = (bf16_t*)smem;
    const int t0 = n * 128;
    const int q = 16 * w + fr; const size_t qrow = (size_t)(t0 + q);
    float g0[GM_NH], g1[GM_NH], be0[GM_NH], be1[GM_NH], bq[GM_NH]; u32x2 uu[GM_NH][8]; bf16x8 wf[GM_NH][4];
#pragma unroll
    for (int h = 0; h < GM_NH; ++h) { const int e = e0 + h;
        g0[h] = lng[e * 128 + lane]; g1[h] = lng[e * 128 + 64 + lane]; be0[h] = lnb[e * 128 + lane]; be1[h] = lnb[e * 128 + 64 + lane];
        bq[h] = (inp(19) + (l * 6 + e) * 128)[q];
#pragma unroll
        for (int cb = 0; cb < 8; ++cb) uu[h][cb] = *(const u32x2*)(P + qrow * D_INP + COL_GM + e * 128 + cb * 16 + 4 * fq);
        const float* ws_ = inp(18) + (size_t)(l * 6 + e) * 128 * 128;
#pragma unroll
        for (int ks = 0; ks < 4; ++ks) { const float* wp = ws_ + (16 * w + fr) * 128 + ks * 32 + fq * 8; const float4 a = *(const float4*)wp, b = *(const float4*)(wp + 4);
            u32x4 t; t.x = cvt_pk_bf16(a.x, a.y); t.y = cvt_pk_bf16(a.z, a.w); t.z = cvt_pk_bf16(b.x, b.y); t.w = cvt_pk_bf16(b.z, b.w); wf[h][ks] = __builtin_bit_cast(bf16x8, t); } }
#pragma unroll
    for (int i = 0; i < 16; ++i) { const int pl = 16 * w + i; const size_t row = (size_t)(t0 + pl); const bf16_t* pr = P + row * D_INP + COL_GM + 768 + e0 * 128;
        float2 st; { const f32x4* sp = (const f32x4*)(stats + row * 24); f32x4 a = sp[0];
#pragma unroll
          for (int k = 1; k < 6; ++k) a += sp[k];
          st = make_float2(a[0] + a[2], a[1] + a[3]); }
        const float mean = st.x * (1.0f / 768.0f); const float rstd = rsqrtf(fmaxf(st.y * (1.0f / 768.0f) - mean * mean, 0.f) + 1e-5f);
#pragma unroll
        for (int h = 0; h < GM_NH; ++h) {
            const float y0 = (bf2f(pr[h * 128 + lane]) - mean) * rstd * g0[h] + be0[h], y1 = (bf2f(pr[h * 128 + 64 + lane]) - mean) * rstd * g1[h] + be1[h];
            const unsigned pk = cvt_pk_bf16(y0, y1);
            VT[(h * 128 + lane) * 132 + pl] = (bf16_t)(pk & 0xffffu); VT[(h * 128 + 64 + lane) * 132 + pl] = (bf16_t)(pk >> 16); } }
    __syncthreads();
#pragma unroll
    for (int h = 0; h < GM_NH; ++h) { const int e = e0 + h;
        f32x4 acc[8];
#pragma unroll
        for (int cb = 0; cb < 8; ++cb) acc[cb] = (f32x4){0.f, 0.f, 0.f, 0.f};
#pragma unroll
        for (int ks = 0; ks < 4; ++ks)
#pragma unroll
            for (int cb = 0; cb < 8; ++cb) { const bf16_t* vp = VT + (h * 128 + cb * 16 + fr) * 132 + ks * 32 + fq * 8; const u32x2 lo = *(const u32x2*)vp, hi = *(const u32x2*)(vp + 4);
                u32x4 t; t.x = lo.x; t.y = lo.y; t.z = hi.x; t.w = hi.y;
                acc[cb] = __builtin_amdgcn_mfma_f32_16x16x32_bf16(__builtin_bit_cast(bf16x8, t), wf[h][ks], acc[cb], 0, 0, 0); }
#pragma unroll
        for (int cb = 0; cb < 8; ++cb) { const int c = cb * 16 + 4 * fq;
            const float u0 = lo_bf(uu[h][cb].x), u1 = hi_bf(uu[h][cb].x), u2 = lo_bf(uu[h][cb].y), u3 = hi_bf(uu[h][cb].y);
            u32x2 o; o.x = cvt_pk_bf16(u0 * (acc[cb][0] + bq[h]), u1 * (acc[cb][1] + bq[h])); o.y = cvt_pk_bf16(u2 * (acc[cb][2] + bq[h]), u3 * (acc[cb][3] + bq[h]));
            *(u32x2*)(MIX + qrow * D_MODEL + MIX_GM + e * 128 + c) = o; } }
    __syncthreads();
}

__device__ void fft_item(const Params& p, int l, int cp, unsigned char* smem) {
    const int tid = tid_l(); const int c0 = 2 * cp;
    float2* B0 = (float2*)smem;
    const float* ZT = (const float*)(p.ws + OFF_ZT) + (size_t)c0 * 8192; const float* X0T = (const float*)(p.ws + OFF_X0T) + (size_t)c0 * 8192;
    const float rf = (float)tid * (1.0f / 8192.0f);
#pragma unroll
    for (int ch = 0; ch < 2; ++ch) { float2 x[16]; float2* B = B0 + ch * FFT_BUF; const float* z = ZT + ch * 8192 + tid;
#pragma unroll
        for (int k = 0; k < 8; ++k) { x[k] = make_float2(z[512 * k], z[4096 + 512 * k]); x[k + 8] = make_float2(0.f, 0.f); }
        radix16<false>(x, rf);
#pragma unroll
        for (int k = 0; k < 16; ++k) B[phys(tid + 512 * k)] = x[k]; }
    __syncthreads();
    { const float r2 = launder_f((float)(tid & 31) * (1.0f / 512.0f));
#pragma unroll
      for (int ch = 0; ch < 2; ++ch) fft_pass2<false>(B0 + ch * FFT_BUF, tid, r2); }
    __syncthreads();
    { const int blk = tid & 255, ch = tid >> 8; float2* B = B0 + ch * FFT_BUF + blk * 33; float2 y[32];
#pragma unroll
      for (int k = 0; k < 32; ++k) y[k] = B[k];
      radix32<false>(y);
      const float2* KF = (const float2*)(p.ws + OFF_KF) + ((size_t)l * 768 + c0 + ch) * 8192 + blk * 2;
#pragma unroll
      for (int k = 0; k < 32; k += 2) { const float4 kq = *(const float4*)(KF + (k >> 1) * 512);
          y[k] = make_float2(y[k].x * kq.x - y[k].y * kq.y, y[k].x * kq.y + y[k].y * kq.x); y[k + 1] = make_float2(y[k + 1].x * kq.z - y[k + 1].y * kq.w, y[k + 1].x * kq.w + y[k + 1].y * kq.z); }
      radix32<true>(y);
#pragma unroll
      for (int k = 0; k < 32; ++k) B[k] = y[k]; }
    __syncthreads();
    { const float r2 = launder_f((float)(tid & 31) * (1.0f / 512.0f));
#pragma unroll
      for (int ch = 0; ch < 2; ++ch) fft_pass2<true>(B0 + ch * FFT_BUF, tid, r2); }
    __syncthreads();
    bf16_t* MIX = (bf16_t*)(p.ws + OFF_MIX);
    const float2 dsk = *(const float2*)(inp(15) + l * 768 + c0);
    const float rfi = launder_f(rf);
    { unsigned long long zp = (unsigned long long)ZT; asm volatile("" : "+s"(zp)); ZT = (const float*)zp; }
#pragma unroll 1
    for (int ch = 0; ch < 2; ++ch) { float2 x[16]; float2* B = B0 + ch * FFT_BUF;
#pragma unroll
        for (int k = 0; k < 16; ++k) x[k] = B[phys(tid + 512 * k)];
        radix16<true>(x, rfi);
        const float d = ch ? dsk.y : dsk.x; const float* z = ZT + ch * 8192 + tid; const float* x0 = X0T + ch * 8192 + tid;
        if (ch == 0) {
#pragma unroll
            for (int k = 0; k < 8; ++k) B0[phys(tid + 512 * k)] = make_float2(x0[512 * k] * (x[k].x + d * z[512 * k]), x0[4096 + 512 * k] * (x[k].y + d * z[4096 + 512 * k]));
        } else {
#pragma unroll
            for (int k = 0; k < 8; ++k) { const int t = tid + 512 * k; const float2 r0 = B0[phys(t)];
                const float r1a = x0[512 * k] * (x[k].x + d * z[512 * k]), r1b = x0[4096 + 512 * k] * (x[k].y + d * z[4096 + 512 * k]);
                *(unsigned*)(MIX + (size_t)t * D_MODEL + MIX_HY + c0) = cvt_pk_bf16(r0.x, r1a);
                *(unsigned*)(MIX + (size_t)(4096 + t) * D_MODEL + MIX_HY + c0) = cvt_pk_bf16(r0.y, r1b); }
        } }
    __syncthreads();
}

__device__ void convact_phase(const Params& p, int l) {
    const bf16_t* UP = (const bf16_t*)(p.ws + OFF_UP); bf16_t* ACT = (bf16_t*)(p.ws + OFF_ACT);
    const float* cw = inp(23) + (size_t)l * 3 * D_UP; const float* cb = inp(24) + (size_t)l * D_UP;
    const int nthr = gridDim.x * 512;
    const int tid = tid_l();
    for (int idx = blockIdx.x * 512 + tid; idx < 704 * 512; idx += nthr) {
        const int cg8 = idx % 704, run = idx / 704; const int j = cg8 >> 4, i8 = (cg8 & 15) * 8;
        const int ncol = j * 128 + i8;
        float wg[3][8], wv[3][8], bg[8], bv[8];
#pragma unroll
        for (int k = 0; k < 3; ++k) { const float4 a = *(const float4*)(cw + k * D_UP + ncol), b = *(const float4*)(cw + k * D_UP + ncol + 4);
            wg[k][0] = a.x; wg[k][1] = a.y; wg[k][2] = a.z; wg[k][3] = a.w; wg[k][4] = b.x; wg[k][5] = b.y; wg[k][6] = b.z; wg[k][7] = b.w;
            const float4 c = *(const float4*)(cw + k * D_UP + D_FF + ncol), d = *(const float4*)(cw + k * D_UP + D_FF + ncol + 4);
            wv[k][0] = c.x; wv[k][1] = c.y; wv[k][2] = c.z; wv[k][3] = c.w; wv[k][4] = d.x; wv[k][5] = d.y; wv[k][6] = d.z; wv[k][7] = d.w; }
        { const float4 a = *(const float4*)(cb + ncol), b = *(const float4*)(cb + ncol + 4); bg[0] = a.x; bg[1] = a.y; bg[2] = a.z; bg[3] = a.w; bg[4] = b.x; bg[5] = b.y; bg[6] = b.z; bg[7] = b.w;
          const float4 c = *(const float4*)(cb + D_FF + ncol), d = *(const float4*)(cb + D_FF + ncol + 4); bv[0] = c.x; bv[1] = c.y; bv[2] = c.z; bv[3] = c.w; bv[4] = d.x; bv[5] = d.y; bv[6] = d.z; bv[7] = d.w; }
        const int r0 = run * 16; const size_t colg = (size_t)j * 256 + i8, colv = colg + 128;
        u32x4 gm = (u32x4){0u, 0u, 0u, 0u}, vm = gm, gc, vc, gn, vn;
        if ((r0 & (SEQ - 1)) != 0) { gm = *(const u32x4*)(UP + (size_t)(r0 - 1) * D_UP + colg); vm = *(const u32x4*)(UP + (size_t)(r0 - 1) * D_UP + colv); }
        gc = *(const u32x4*)(UP + (size_t)r0 * D_UP + colg); vc = *(const u32x4*)(UP + (size_t)r0 * D_UP + colv);
        for (int r = r0; r < r0 + 16; ++r) {
            if ((r & (SEQ - 1)) != SEQ - 1) { gn = *(const u32x4*)(UP + (size_t)(r + 1) * D_UP + colg); vn = *(const u32x4*)(UP + (size_t)(r + 1) * D_UP + colv); }
            else { gn = (u32x4){0u, 0u, 0u, 0u}; vn = gn; }
            float o[8];
#pragma unroll
            for (int q = 0; q < 4; ++q) {
                const float ga = wg[0][2 * q] * lo_bf(gm[q]) + wg[1][2 * q] * lo_bf(gc[q]) + wg[2][2 * q] * lo_bf(gn[q]) + bg[2 * q];
                const float gb = wg[0][2 * q + 1] * hi_bf(gm[q]) + wg[1][2 * q + 1] * hi_bf(gc[q]) + wg[2][2 * q + 1] * hi_bf(gn[q]) + bg[2 * q + 1];
                const float va = wv[0][2 * q] * lo_bf(vm[q]) + wv[1][2 * q] * lo_bf(vc[q]) + wv[2][2 * q] * lo_bf(vn[q]) + bv[2 * q];
                const float vb = wv[0][2 * q + 1] * hi_bf(vm[q]) + wv[1][2 * q + 1] * hi_bf(vc[q]) + wv[2][2 * q + 1] * hi_bf(vn[q]) + bv[2 * q + 1];
                o[2 * q] = silu(ga) * va; o[2 * q + 1] = silu(gb) * vb; }
            u32x4 ow; ow.x = cvt_pk_bf16(o[0], o[1]); ow.y = cvt_pk_bf16(o[2], o[3]); ow.z = cvt_pk_bf16(o[4], o[5]); ow.w = cvt_pk_bf16(o[6], o[7]);
            *(u32x4*)(ACT + (size_t)r * D_FF + ncol) = ow;
            gm = gc; vm = vc; gc = gn; vc = vn;
        }
    }
}

__global__ void __launch_bounds__(512, 2) fwd_megakernel(Params p) {
    extern __shared__ __attribute__((aligned(16))) unsigned char smem[];
    cg::grid_group grid = cg::this_grid();
    const int G = gridDim.x, bid = blockIdx.x;
    int step = 0;
    if (p.ph_hi < 0) grid.sync();
    volatile LAS unsigned* xst = (volatile LAS unsigned*)(LAS unsigned char*)(smem + LDS_BYTES - 16);
    if (threadIdx.x < 4) xst[threadIdx.x] = 0u;
    __syncthreads();
    XcdBarrier xb = xcd_barrier_post((unsigned*)(p.ws + OFF_BAR), xst);
#define STEP_BEGIN if (step >= p.ph_lo && step < p.ph_hi) {
#define STEP_END } ++step; if (step > p.ph_lo && step < p.ph_hi) xcd_barrier(xb);

    bf16_t* H = (bf16_t*)(p.ws + OFF_H);
    bf16_t* XA = (bf16_t*)(p.ws + OFF_XA);
#if PROBE == 6
    for (int i = 0; i < 20; ++i) xcd_barrier(xb);
#endif

    STEP_BEGIN
        for (int it = bid; it < NI_FILT; it += G) filter_item(p, it, (float*)smem);
        convert_range4(p, 0, 0, NI_IN / 4, bid, G, (float*)smem);
        convert_range(p, 1, 0, R_POOL, NI_POOL, bid, G, (float*)smem); convert_range(p, 1, 1, R_POOL, NI_POOL, bid, G, (float*)smem);
        if (bid < 3) { const int zr = bid == 0 ? 0 : (bid == 1 ? 4097 : 8194); for (int i = tid_l(); i < D_MODEL / 2; i += 512) ((unsigned*)(H + (size_t)zr * D_MODEL))[i] = 0u; }
        norm_phase<true>(inp(0), inp(1), H, nullptr);
    STEP_END

    for (int l = 0; l < 2; ++l) {
        STEP_BEGIN
            pg8::Gemm g{H + D_MODEL, (const bf16_t*)(p.ws + OFF_WT_IN + l * SZ_WT_IN), NTOK, D_INP, D_MODEL}; pg8::StaticOrder S; S.init(NTOK, D_INP, G, bid);
            pg8::EpiBf16Gm E{(bf16_t*)(p.ws + OFF_P), D_INP, (float*)(p.ws + OFF_STATS) + (size_t)l * NTOK * 24};
            pg8::gemm_phase<pg8::EpiBf16Gm, pg8::StaticOrder, D_MODEL>((LAS unsigned char*)smem, g, S, E);
            { const int rem = (NTOK / 256) * (D_INP / 256) % G;
              if (bid >= rem) for (int rep_ = 0; rep_ < (PROBE == 11 ? 2 : 1); ++rep_) {
                  if (l == 0) { for (int it = bid - rem; it < 768; it += G - rem) kf_item(p, it, smem); convert_range4(p, 1, 0, NI_IN / 4, bid - rem, G - rem, (float*)smem); convert_range4(p, 0, R_DN + NT3, (NI_DN - NT3) / 4, bid - rem, G - rem, (float*)smem); }
                  else { convert_range4(p, 1, R_OUT, (NI_OUT + NI_UP) / 4, bid - rem, G - rem, (float*)smem); convert_range4(p, 1, R_DN + NT3, (NI_DN - NT3) / 4, bid - rem, G - rem, (float*)smem); } } }
        STEP_END
        STEP_BEGIN
            for (int it = bid; it < 768; it += G) hypre_item(p, l, it, smem);
        STEP_END
        STEP_BEGIN
            for (int rep_ = 0; rep_ < (PROBE == 13 ? 2 : 1); ++rep_) {
            unsigned* wq = (unsigned*)(p.ws + OFF_BAR) + 3500 + l + 8 * rep_;
            for (;;) {
                __syncthreads();
                if (threadIdx.x == 0) xst[2] = atomicAdd(wq, 1u);
                __syncthreads();
                const int it = __builtin_amdgcn_readfirstlane((int)xst[2]);
                constexpr int NCH = (NI_OUT + NI_UP) / 8, NMIX = 384 + 128 + 256;
                int mi = it, ch = -1;
                if (l == 0) { if (it < 2 * NMIX) { if (it & 1) { ch = it >> 1; mi = -1; } else mi = it >> 1; } else { ch = NMIX + (it - 2 * NMIX); mi = -1; } }
                if (l == 0 ? it >= NMIX + NCH : it >= NMIX) break;
                if (ch >= 0) { if (ch < NCH) convert_range4(p, 0, R_OUT + ch * 8, 2, 0, 1, (float*)smem); }
                else if (mi < 384) fft_item(p, l, mi, smem); else if (mi < 512) gmlp_item(p, l, mi - 384, smem); else pool_item(p, l, mi - 512, smem);
            }
            }
#if PROBE == 21
            for (int it = bid; it < 256; it += G) pool_item(p, l, it, smem);
#elif PROBE == 22
            for (int it = bid; it < 128; it += G) gmlp_item(p, l, it, smem);
#elif PROBE == 3
            for (int it = bid; it < 384; it += G) fft_item(p, l, it, smem);
#endif
        STEP_END
        STEP_BEGIN
            pg8::Gemm g{(const bf16_t*)(p.ws + OFF_MIX), (const bf16_t*)(p.ws + OFF_WT_OUT + l * SZ_WT_OUT), NTOK, D_MODEL, D_MODEL}; pg8::StaticOrder S; S.init(NTOK, D_MODEL, G, bid);
            float* ssp = (float*)(p.ws + OFF_SSP) + (size_t)(2 * l) * NTOK * 32; unsigned* pc = (unsigned*)(p.ws + OFF_BAR) + 3600 + 64 * l;
            if (l == 0) { pg8::EpiResNorm<true, false> E{XA, inp(0), D_MODEL, inp(21) + l * D_MODEL, H, nullptr, ssp, pc}; pg8::gemm_phase<pg8::EpiResNorm<true, false>, pg8::StaticOrder, D_MODEL>((LAS unsigned char*)smem, g, S, E); }
            else { pg8::EpiResNorm<false, false> E{XA, XA, D_MODEL, inp(21) + l * D_MODEL, H, nullptr, ssp, pc}; pg8::gemm_phase<pg8::EpiResNorm<false, false>, pg8::StaticOrder, D_MODEL>((LAS unsigned char*)smem, g, S, E); }
        STEP_END
        STEP_BEGIN
            pg8::Gemm g{H, (const bf16_t*)(p.ws + OFF_WT_UP + l * SZ_WT_UP), NTOK, D_UP, D_MODEL}; pg8::StaticOrder S; S.init_tiles(34, D_UP / 256, G, bid);
            pg8::EpiConvAct E{(bf16_t*)(p.ws + OFF_ACT), inp(23) + (size_t)l * 3 * D_UP, inp(24) + (size_t)l * D_UP};
            pg8::gemm_phase<pg8::EpiConvAct, pg8::StaticOrder, D_MODEL>((LAS unsigned char*)smem, g, S, E);
#if PROBE == 7
            pg8::gemm_phase<pg8::EpiConvAct, pg8::StaticOrder, D_MODEL>((LAS unsigned char*)smem, g, S, E);
#endif
            { const int rem = (34 * (D_UP / 256)) % G; if (bid >= rem) convert_range4(p, l, R_DN, NT3 / 4, bid - rem, G - rem, (float*)smem); }
        STEP_END
        STEP_BEGIN
            pg8::Gemm g{(const bf16_t*)(p.ws + OFF_ACT), (const bf16_t*)(p.ws + OFF_WT_DN + l * SZ_WT_DN), NTOK, D_MODEL, D_FF}; pg8::StaticOrder S; S.init(NTOK, D_MODEL, G, bid);
            float* ssp = (float*)(p.ws + OFF_SSP) + (size_t)(2 * l + 1) * NTOK * 32; unsigned* pc = (unsigned*)(p.ws + OFF_BAR) + 3600 + 64 * l + 32;
            if (l == 0) { pg8::EpiResNorm<false, false> E{XA, XA, D_MODEL, inp(1) + D_MODEL, H, nullptr, ssp, pc}; pg8::gemm_phase<pg8::EpiResNorm<false, false>, pg8::StaticOrder, D_FF>((LAS unsigned char*)smem, g, S, E); }
            else { pg8::EpiResNorm<false, true> E{XA, XA, D_MODEL, inp(26), nullptr, p.out, ssp, pc}; pg8::gemm_phase<pg8::EpiResNorm<false, true>, pg8::StaticOrder, D_FF>((LAS unsigned char*)smem, g, S, E); }
        STEP_END
    }
}

constexpr int N_STEPS = 13;
#ifndef MULTI_LAUNCH
#define MULTI_LAUNCH 0
#endif

extern "C" void kernel_launch(void* const* d_in, const int* in_sizes, int n_in, void* d_out, int out_size, void* d_ws, size_t ws_size, hipStream_t stream) {
    static int grid = 0;
    if (grid == 0) {
        if (n_in != 27 || ws_size < WS_END) { fprintf(stderr, "kernel_launch: need 27 inputs and %zu bytes of workspace (got %d, %zu)\n", (size_t)WS_END, n_in, ws_size); grid = -1; return; }
        int dev = 0, cus = 0, per_cu = 0;
        hipGetDevice(&dev); hipDeviceGetAttribute(&cus, hipDeviceAttributeMultiprocessorCount, dev);
        if (hipFuncSetAttribute((const void*)fwd_megakernel, hipFuncAttributeMaxDynamicSharedMemorySize, LDS_BYTES) != hipSuccess) { fprintf(stderr, "kernel_launch: hipFuncSetAttribute failed\n"); grid = -1; return; }
        if (hipOccupancyMaxActiveBlocksPerMultiprocessor(&per_cu, (const void*)fwd_megakernel, 512, LDS_BYTES) != hipSuccess || per_cu < 1) { fprintf(stderr, "kernel_launch: occupancy query gave %d\n", per_cu); per_cu = 1; }
        (void)hipGetLastError();
        grid = cus * 1;
    }
    if (grid < 0) return;
    if (hipMemsetAsync((char*)d_ws + OFF_BAR, 0, 16384, stream) != hipSuccess) { fprintf(stderr, "kernel_launch: memset failed\n"); return; }
    Params p{};
    for (int i = 0; i < 27; ++i) p.in[i] = (const float*)d_in[i];
    p.out = (float*)d_out; p.ws = (unsigned char*)d_ws;
#if MULTI_LAUNCH
    for (int s = 0; s < N_STEPS; ++s) { p.ph_lo = s; p.ph_hi = s + 1; hipLaunchKernelGGL(fwd_megakernel, dim3(grid), dim3(512), LDS_BYTES, stream, p); }
#else
    p.ph_lo = 0; p.ph_hi = N_STEPS;
    void* args[] = {&p};
    hipError_t e = hipLaunchCooperativeKernel((const void*)fwd_megakernel, dim3(grid), dim3(512), args, LDS_BYTES, stream);
    if (e != hipSuccess) fprintf(stderr, "cooperative launch failed: %s (grid %d)\n", hipGetErrorString(e), grid);
#endif
}
```

```cpp
#include <hip/hip_runtime.h>
#include <hip/hip_cooperative_groups.h>
#include <cstdio>
namespace cg = cooperative_groups;

#define LAS __attribute__((address_space(3)))
typedef unsigned short bf16_t;
typedef short bf16x8 __attribute__((ext_vector_type(8)));
typedef float f32x4 __attribute__((ext_vector_type(4)));
typedef unsigned u32x4 __attribute__((ext_vector_type(4)));
typedef unsigned u32x2 __attribute__((ext_vector_type(2)));

constexpr int D_MODEL = 2048, SEQ = 4096, NTOK = 8192, D_INP = 4352, D_FF = 5632, D_UP = 11264;
constexpr int D_HY = 768, D_GM = 768;
constexpr int COL_HY = 512, COL_GM = 2816;
constexpr int MIX_HY = 512, MIX_GM = 1280;

constexpr size_t SZ_WT_IN = (size_t)D_INP * D_MODEL * 2, SZ_WT_OUT = (size_t)D_MODEL * D_MODEL * 2, SZ_WT_UP = (size_t)D_UP * D_MODEL * 2, SZ_WT_DN = (size_t)D_MODEL * D_FF * 2;
constexpr size_t SZ_POOLWT = 4 * 128 * 128 * 2, SZ_KF = (size_t)768 * 8192 * 8, SZ_H2 = (size_t)4096 * 64 * 4, SZ_STATS = (size_t)NTOK * 12 * 2 * 4;
constexpr size_t OFF_WT_IN = 0;
constexpr size_t OFF_WT_OUT = OFF_WT_IN + 2 * SZ_WT_IN;
constexpr size_t OFF_WT_UP = OFF_WT_OUT + 2 * SZ_WT_OUT;
constexpr size_t OFF_WT_DN = OFF_WT_UP + 2 * SZ_WT_UP;
constexpr size_t OFF_POOLWT = OFF_WT_DN + 2 * SZ_WT_DN;
constexpr size_t OFF_KF = OFF_POOLWT + 2 * SZ_POOLWT;
constexpr size_t OFF_H2 = OFF_KF + 2 * SZ_KF;
constexpr size_t OFF_STATS = OFF_H2 + 2 * SZ_H2;
constexpr size_t OFF_XA = OFF_STATS + 2 * SZ_STATS;
constexpr size_t OFF_H = OFF_XA + (size_t)NTOK * D_MODEL * 4;
constexpr size_t OFF_R1 = OFF_H + (size_t)(NTOK + 512) * D_MODEL * 2;
constexpr size_t OFF_P = OFF_R1;
constexpr size_t OFF_MIX = OFF_P + (size_t)NTOK * D_INP * 2;
constexpr size_t OFF_ZT = OFF_MIX + (size_t)NTOK * D_MODEL * 2;
constexpr size_t OFF_X0T = OFF_ZT + (size_t)768 * 8192 * 4;
constexpr size_t OFF_UP = OFF_R1;
constexpr size_t OFF_ACT = OFF_R1 + (size_t)NTOK * D_UP * 2;
constexpr size_t OFF_BAR = OFF_ACT + (size_t)NTOK * D_FF * 2;
constexpr size_t OFF_SSP = OFF_BAR + 16384;
constexpr size_t WS_END = OFF_SSP + (size_t)4 * NTOK * 32 * 4;
static_assert(OFF_X0T + (size_t)768 * 8192 * 4 <= OFF_ACT, "alias region");

constexpr int LDS_BYTES = 139264;
#ifndef PROBE
#define PROBE 0
#endif
#define REP(k) for (int rep_ = 0; rep_ < ((PROBE == (k)) ? 2 : 1); ++rep_)

struct Params {
    const float* in[27];
    float* out;
    unsigned char* ws;
    int ph_lo, ph_hi;
};


__device__ __forceinline__ const float* inp(int i) {
    const __attribute__((address_space(4))) char* ka = (const __attribute__((address_space(4))) char*)__builtin_amdgcn_kernarg_segment_ptr();
    int off = i * 8; asm volatile("" : "+s"(off));
    return *(const float* const __attribute__((address_space(4)))*)(ka + off);
}

__device__ __forceinline__ int tid_l() { int t = threadIdx.x; asm volatile("" : "+v"(t)); return t; }
__device__ __forceinline__ float bf2f(bf16_t b) { return __uint_as_float(((unsigned)b) << 16); }
__device__ __forceinline__ unsigned cvt_pk_bf16(float lo, float hi) { unsigned r; asm volatile("v_cvt_pk_bf16_f32 %0, %1, %2" : "=v"(r) : "v"(lo), "v"(hi)); return r; }
__device__ __forceinline__ float lo_bf(unsigned u) { return __uint_as_float(u << 16); }
__device__ __forceinline__ float hi_bf(unsigned u) { return __uint_as_float(u & 0xffff0000u); }
__device__ __forceinline__ float gelu_tanh(float x) {
    const float y2 = 1.5957691216f * (x + 0.044715f * x * x * x);
    return x * __builtin_amdgcn_rcpf(1.0f + __expf(-y2));
}
__device__ __forceinline__ float silu(float x) { return x * __builtin_amdgcn_rcpf(1.0f + __expf(-x)); }
__device__ __forceinline__ float wave_sum(float v) {
#pragma unroll
    for (int o = 32; o > 0; o >>= 1) v += __shfl_xor(v, o, 64);
    return v;
}

#define XB_TMO      128
#define XB_XCNT(j)  (256  + 64 * (j))
#define XB_XSUB(j)  (1280 + 64 * (j))
#define XB_XGEN(j)  (2304 + 64 * (j))
#define XB_TOP      3328
#define XB_TOPGEN   3392
#define XCD_BAR_WORDS 3456
#define XB_SPIN_CAP (1u << 18)

__device__ __forceinline__ unsigned xb_ld(unsigned* p)              { return __hip_atomic_load(p, __ATOMIC_RELAXED, __HIP_MEMORY_SCOPE_AGENT); }
__device__ __forceinline__ unsigned xb_add(unsigned* p, unsigned v) { return __hip_atomic_fetch_add(p, v, __ATOMIC_RELAXED, __HIP_MEMORY_SCOPE_AGENT); }
__device__ __forceinline__ unsigned xb_xcc_id() { return (unsigned)__builtin_amdgcn_s_getreg((3 << 11) | 20) & 0xFu; }
#define XB_SPIN(cond, bar) do { unsigned _sp = 0; while (cond) { __builtin_amdgcn_s_sleep(1); \
    if ((++_sp & 255u) == 0u) { if (xb_ld(&(bar)[XB_TMO])) break; if (_sp > XB_SPIN_CAP) { atomicAdd(&(bar)[XB_TMO], 1u); break; } } } } while (0)

struct XcdBarrier {
    unsigned* bar; unsigned x;
    volatile LAS unsigned* st;
};

__device__ __forceinline__ XcdBarrier xcd_barrier_post(unsigned* bar, volatile LAS unsigned* st) {
    XcdBarrier b; b.bar = bar; b.x = xb_xcc_id(); b.st = st;
    if (threadIdx.x == 0) (void)xb_add(&bar[XB_XCNT(b.x)], 1u);
    return b;
}
__device__ __forceinline__ void xcd_barrier_complete(unsigned* bar, unsigned x, unsigned& nloc, unsigned& nx) {
    const unsigned G = gridDim.x * gridDim.y * gridDim.z;
    unsigned sum, cnt, mine, sp = 0u;
    for (;;) {
        sum = 0u; cnt = 0u; mine = 0u;
#pragma unroll
        for (unsigned j = 0; j < 16; ++j) { const unsigned c = xb_ld(&bar[XB_XCNT(j)]); sum += c; cnt += (c > 0u) ? 1u : 0u; mine = (j == x) ? c : mine; }
        if (sum == G) break;
        __builtin_amdgcn_s_sleep(1);
        if ((++sp & 255u) == 0u) { if (xb_ld(&bar[XB_TMO])) break; if (sp > XB_SPIN_CAP) { atomicAdd(&bar[XB_TMO], 1u); break; } }
    }
    nloc = mine > 0u ? mine : 1u; nx = cnt > 0u ? cnt : 1u;
}

__device__ __forceinline__ void xcd_barrier(const XcdBarrier& b) {
    asm volatile("s_waitcnt vmcnt(0)" ::: "memory");
    __syncthreads();
    if (threadIdx.x == 0) {
        unsigned* bar = b.bar;
        __builtin_amdgcn_s_waitcnt(0);
        unsigned nloc = b.st[0], nx = b.st[1];
        if (nloc == 0u) { xcd_barrier_complete(bar, b.x, nloc, nx); b.st[0] = nloc; b.st[1] = nx; }
        const unsigned old = xb_add(&bar[XB_XSUB(b.x)], 1u);
        const unsigned gen = old / nloc;
        if (old + 1u == (gen + 1u) * nloc) {
            __builtin_amdgcn_fence(__ATOMIC_RELEASE, "agent");
            asm volatile("s_waitcnt vmcnt(0)" ::: "memory");
            const unsigned og = xb_add(&bar[XB_TOP], 1u);
            const unsigned tg = og / nx;
            if (og + 1u == (tg + 1u) * nx) xb_add(&bar[XB_TOPGEN], 1u);
            else XB_SPIN(xb_ld(&bar[XB_TOPGEN]) == tg, bar);
            __builtin_amdgcn_fence(__ATOMIC_ACQUIRE, "agent");
            xb_add(&bar[XB_XGEN(b.x)], 1u);
            asm volatile("s_waitcnt vmcnt(0)" ::: "memory");
        } else {
            XB_SPIN(xb_ld(&bar[XB_XGEN(b.x)]) == gen, bar);
            __builtin_amdgcn_fence(__ATOMIC_ACQUIRE, "agent");
            asm volatile("s_waitcnt vmcnt(0)" ::: "memory");
        }
    }
    __syncthreads();
}


namespace pg8 {
constexpr int BM = 256, BK = 64, HALF = 128, HTB = HALF * BK * 2, STAGE_BYTES = 8 * HTB, NXCD = 8, WGM = 8;
__host__ __device__ __forceinline__ int lds_byte(int r, int c) { const int st = (r >> 4) * 2 + (c >> 5), rr = r & 15, cc = c & 31, ob = rr * 64 + cc * 2; return st * 1024 + (ob ^ (((ob >> 9) & 1) << 5)); }
__host__ __device__ __forceinline__ void stage_rc(int b, int& R, int& C) { const int st = b / 1024, sb = b % 1024, swz = sb ^ (((sb >> 9) & 1) << 5); R = (st >> 1) * 16 + swz / 64; C = (st & 1) * 32 + (swz % 64) / 2; }
__host__ __device__ __forceinline__ int perm32(int rho) { const int n = rho >> 4, i = rho & 15; return 8 * (i >> 2) + 4 * n + (i & 3); }
struct Unit { int pm, pn; };
struct Gemm { const bf16_t* A; const bf16_t* Bt; int M, N, K; };
struct StaticOrder {
    int nM, nN, nwg, G, c;
    __device__ void init(int M, int N, int G_, int c_) { nM = M / BM; nN = N / BM; nwg = nM * nN; G = G_; c = c_; }
    __device__ void init_tiles(int nM_, int nN_, int G_, int c_) { nM = nM_; nN = nN_; nwg = nM * nN; G = G_; c = c_; }
    __device__ bool next(int i, Unit& u) const {
        const long L = (long)i * G + c; if (L >= nwg) return false;
        int wgid = (int)L; { const int q = nwg / NXCD, r = nwg % NXCD, xcd = wgid % NXCD, off = wgid / NXCD; wgid = (xcd < r ? xcd * (q + 1) : r * (q + 1) + (xcd - r) * q) + off; }
        const int nig = WGM * nN, gid = wgid / nig, fm = gid * WGM, gsz = (nM - fm) < WGM ? (nM - fm) : WGM;
        u.pm = fm + ((wgid % nig) % gsz); u.pn = (wgid % nig) / gsz; return true;
    }
};
struct EpiBf16 {
    static constexpr bool PERM = true, CONV = false, AFTER_DRAIN = false; static constexpr int GAPA = 0;
    bf16_t* O; int ldc;
    __device__ __forceinline__ void operator()(const f32x4 (&acc)[2][2][4][2], const Unit& u, int wr, int wc, int fr, int fq) const {
        const int row0 = u.pm * BM + wr * 64 + fr; const int col0 = u.pn * BM + wc * 32 + 8 * fq;
#pragma unroll
        for (int ai = 0; ai < 2; ++ai)
#pragma unroll
            for (int m = 0; m < 4; ++m) { bf16_t* rowp = O + (size_t)(row0 + ai * HALF + m * 16) * ldc + col0;
#pragma unroll
                for (int bj = 0; bj < 2; ++bj) { const f32x4 v0 = acc[ai][bj][m][0], v1 = acc[ai][bj][m][1];
                    u32x4 w; w.x = cvt_pk_bf16(v0[0], v0[1]); w.y = cvt_pk_bf16(v0[2], v0[3]); w.z = cvt_pk_bf16(v1[0], v1[1]); w.w = cvt_pk_bf16(v1[2], v1[3]);
                    *(u32x4*)(rowp + bj * HALF) = w; } }
    }
};
struct EpiBf16Gm {
    static constexpr bool PERM = true, CONV = false, AFTER_DRAIN = false; static constexpr int GAPA = D_MODEL * 2;
    bf16_t* O; int ldc; float* stats;
    __device__ __forceinline__ void operator()(const f32x4 (&acc)[2][2][4][2], const Unit& u, int wr, int wc, int fr, int fq) const {
        const int row0 = u.pm * BM + wr * 64 + fr; const int col0 = u.pn * BM + wc * 32 + 8 * fq;
        const bool act = u.pn >= 11, st = u.pn >= 14;
#pragma unroll
        for (int ai = 0; ai < 2; ++ai)
#pragma unroll
            for (int m = 0; m < 4; ++m) { const int row = row0 + ai * HALF + m * 16; bf16_t* rowp = O + (size_t)row * ldc + col0; float s1 = 0.f, s2 = 0.f;
#pragma unroll
                for (int bj = 0; bj < 2; ++bj) { f32x4 v0 = acc[ai][bj][m][0], v1 = acc[ai][bj][m][1];
                    if (act) {
#pragma unroll
                        for (int j = 0; j < 4; ++j) { v0[j] = gelu_tanh(v0[j]); v1[j] = gelu_tanh(v1[j]); s1 += v0[j] + v1[j]; s2 += v0[j] * v0[j] + v1[j] * v1[j]; } }
                    u32x4 w; w.x = cvt_pk_bf16(v0[0], v0[1]); w.y = cvt_pk_bf16(v0[2], v0[3]); w.z = cvt_pk_bf16(v1[0], v1[1]); w.w = cvt_pk_bf16(v1[2], v1[3]);
                    *(u32x4*)(rowp + bj * HALF) = w; }
                if (st) { s1 += __shfl_xor(s1, 16, 64); s2 += __shfl_xor(s2, 16, 64); s1 += __shfl_xor(s1, 32, 64); s2 += __shfl_xor(s2, 32, 64);
                    if (fq == 0) *(float2*)(stats + ((size_t)row * 12 + (u.pn - 14) * 4 + wc) * 2) = make_float2(s1, s2); } }
    }
};
__device__ __forceinline__ float dpp_ror1(float v) { return __builtin_bit_cast(float, __builtin_amdgcn_mov_dpp(__builtin_bit_cast(int, v), 0x121, 0xf, 0xf, true)); }
__device__ __forceinline__ float dpp_rol1(float v) { return __builtin_bit_cast(float, __builtin_amdgcn_mov_dpp(__builtin_bit_cast(int, v), 0x12F, 0xf, 0xf, true)); }
struct EpiConvAct {
    static constexpr bool PERM = true, CONV = true, AFTER_DRAIN = false; static constexpr int GAPA = 0;
    bf16_t* ACT; const float* cw; const float* cb;
    __device__ __forceinline__ void operator()(const f32x4 (&acc)[2][2][4][2], const Unit& u, int wr, int wc, int fr, int fq) const {
        const bool f0 = fr == 0, f15 = fr == 15;
#pragma unroll
        for (int n = 0; n < 2; ++n) {
            const int cg = 128 * u.pn + 32 * wc + 8 * fq + 4 * n;
            f32x4 wg[3], wv[3];
#pragma unroll
            for (int k = 0; k < 3; ++k) { wg[k] = *(const f32x4*)(cw + k * D_UP + cg); wv[k] = *(const f32x4*)(cw + k * D_UP + D_FF + cg); }
            const f32x4 bg = *(const f32x4*)(cb + cg), bv = *(const f32x4*)(cb + D_FF + cg);
#pragma unroll
            for (int ai = 0; ai < 2; ++ai) { const int pbase = 248 * u.pm + 62 * (2 * ai + wr);
                float rpg[4], rpv[4], lcg[4], lcv[4];
#pragma unroll
                for (int j = 0; j < 4; ++j) { rpg[j] = 0.f; rpv[j] = 0.f; lcg[j] = dpp_rol1(acc[ai][0][0][n][j]); lcv[j] = dpp_rol1(acc[ai][1][0][n][j]); }
#pragma unroll
                for (int m = 0; m < 4; ++m) { const int q = 16 * m + fr, pr = pbase + q; const int G = pr - 1 - (pr > 4097 ? 1 : 0);
                    const f32x4 gc = acc[ai][0][m][n], vc = acc[ai][1][m][n]; float o[4];
#pragma unroll
                    for (int j = 0; j < 4; ++j) {
                        const float rg = dpp_ror1(gc[j]), rv = dpp_ror1(vc[j]);
                        const float gp = (m > 0 && f0) ? rpg[j] : rg, vp = (m > 0 && f0) ? rpv[j] : rv;
                        float gn = lcg[j], vn = lcv[j];
                        if (m < 3) { const float a = dpp_rol1(acc[ai][0][m + 1][n][j]), b = dpp_rol1(acc[ai][1][m + 1][n][j]); gn = f15 ? a : gn; vn = f15 ? b : vn; lcg[j] = a; lcv[j] = b; }
                        rpg[j] = rg; rpv[j] = rv;
                        const float ga = __builtin_fmaf(wg[0][j], gp, __builtin_fmaf(wg[1][j], gc[j], __builtin_fmaf(wg[2][j], gn, bg[j])));
                        float va = __builtin_fmaf(wv[2][j], vn, bv[j]); asm volatile("" : "+v"(va));
                        va = __builtin_fmaf(wv[1][j], vc[j], va); asm volatile("" : "+v"(va));
                        va = __builtin_fmaf(wv[0][j], vp, va);
                        o[j] = silu(ga) * va; }
                    if (q >= 1 && q <= 62 && pr >= 1 && pr != 4097 && pr <= 8193) { u32x2 ow; ow.x = cvt_pk_bf16(o[0], o[1]); ow.y = cvt_pk_bf16(o[2], o[3]); *(u32x2*)(ACT + (size_t)G * D_FF + cg) = ow; } } }
        }
    }
};
template <bool RF32, bool FINAL> struct EpiResNorm {
    static constexpr bool PERM = true, CONV = false, AFTER_DRAIN = true; static constexpr int GAPA = 0;
    bf16_t* C; const void* R; int ldc; const float* gain; bf16_t* Hout; float* Fout; float* ssp; unsigned* cnt;
    __device__ __forceinline__ void operator()(f32x4 (&acc)[2][2][4][2], const Unit& u, int wr, int wc, int fr, int fq) const {
        const int row0 = u.pm * BM + wr * 64 + fr, col0 = u.pn * BM + wc * 32 + 8 * fq;
#pragma unroll
        for (int ai = 0; ai < 2; ++ai)
#pragma unroll
            for (int m = 0; m < 4; ++m) { const int row = row0 + ai * HALF + m * 16; const size_t ro = (size_t)row * ldc + col0; float sq = 0.f;
#pragma unroll
                for (int bj = 0; bj < 2; ++bj) { f32x4 r0, r1;
                    if (RF32) { const float* rp = (const float*)R + ro + bj * HALF; r0 = *(const f32x4*)rp; r1 = *(const f32x4*)(rp + 4); }
                    else { const u32x4 rr = *(const u32x4*)((const bf16_t*)R + ro + bj * HALF);
                        r0 = (f32x4){lo_bf(rr.x), hi_bf(rr.x), lo_bf(rr.y), hi_bf(rr.y)}; r1 = (f32x4){lo_bf(rr.z), hi_bf(rr.z), lo_bf(rr.w), hi_bf(rr.w)}; }
                    const f32x4 o0 = acc[ai][bj][m][0] + r0, o1 = acc[ai][bj][m][1] + r1; acc[ai][bj][m][0] = o0; acc[ai][bj][m][1] = o1;
                    sq += o0[0] * o0[0] + o0[1] * o0[1] + o0[2] * o0[2] + o0[3] * o0[3] + o1[0] * o1[0] + o1[1] * o1[1] + o1[2] * o1[2] + o1[3] * o1[3]; }
                sq += __shfl_xor(sq, 16, 64); sq += __shfl_xor(sq, 32, 64);
                if (fq == 0) __hip_atomic_store(ssp + (size_t)row * 32 + u.pn * 4 + wc, sq, __ATOMIC_RELAXED, __HIP_MEMORY_SCOPE_AGENT); }
        asm volatile("s_waitcnt vmcnt(0)" ::: "memory");
        __syncthreads();
        if (threadIdx.x == 0) __hip_atomic_fetch_add(cnt + u.pm, 1u, __ATOMIC_RELAXED, __HIP_MEMORY_SCOPE_AGENT);
        if (!FINAL) {
#pragma unroll
            for (int ai = 0; ai < 2; ++ai)
#pragma unroll
                for (int m = 0; m < 4; ++m) { const size_t ro = (size_t)(row0 + ai * HALF + m * 16) * ldc + col0;
#pragma unroll
                    for (int bj = 0; bj < 2; ++bj) { const f32x4 o0 = acc[ai][bj][m][0], o1 = acc[ai][bj][m][1];
                        u32x4 w; w.x = cvt_pk_bf16(o0[0], o0[1]); w.y = cvt_pk_bf16(o0[2], o0[3]); w.z = cvt_pk_bf16(o1[0], o1[1]); w.w = cvt_pk_bf16(o1[2], o1[3]);
                        *(u32x4*)(C + ro + bj * HALF) = w; } } }
        if (threadIdx.x == 0) {
            unsigned spins = 0;
            while (__hip_atomic_load(cnt + u.pm, __ATOMIC_RELAXED, __HIP_MEMORY_SCOPE_AGENT) < 8u) { __builtin_amdgcn_s_sleep(2); if (++spins > (1u << 22)) break; }
            __builtin_amdgcn_fence(__ATOMIC_ACQUIRE, "agent");
            asm volatile("s_waitcnt vmcnt(0)" ::: "memory");
        }
        __syncthreads();
        f32x4 g0[2], g1[2];
#pragma unroll
        for (int bj = 0; bj < 2; ++bj) { g0[bj] = *(const f32x4*)(gain + col0 + bj * HALF); g1[bj] = *(const f32x4*)(gain + col0 + bj * HALF + 4); }
#pragma unroll
        for (int ai = 0; ai < 2; ++ai)
#pragma unroll
            for (int m = 0; m < 4; ++m) { const int row = row0 + ai * HALF + m * 16; const size_t ro = (size_t)row * ldc + col0;
                const f32x4* q = (const f32x4*)(ssp + (size_t)row * 32 + 8 * fq); const f32x4 a = q[0] + q[1];
                float v = (a[0] + a[1]) + (a[2] + a[3]); v += __shfl_xor(v, 16, 64); v += __shfl_xor(v, 32, 64);
                const float rs = rsqrtf(v * (1.0f / D_MODEL) + 1e-6f);
#pragma unroll
                for (int bj = 0; bj < 2; ++bj) { const f32x4 o0 = acc[ai][bj][m][0], o1 = acc[ai][bj][m][1];
                    const f32x4 y0 = o0 * rs * g0[bj], y1 = o1 * rs * g1[bj];
                    if (FINAL) { float* op = Fout + ro + bj * HALF; *(f32x4*)op = y0; *(f32x4*)(op + 4) = y1; }
                    else { u32x4 w; w.x = cvt_pk_bf16(y0[0], y0[1]); w.y = cvt_pk_bf16(y0[2], y0[3]); w.z = cvt_pk_bf16(y1[0], y1[1]); w.w = cvt_pk_bf16(y1[2], y1[3]);
                        *(u32x4*)(Hout + (size_t)(row + 1 + (row >> 12)) * ldc + col0 + bj * HALF) = w; } } }
    }
};

template <class Epi, class Sched, int KDIM>
__device__ __forceinline__ void gemm_phase(LAS unsigned char* lds, const Gemm g, const Sched& S, const Epi& E) {
    int tid_ = threadIdx.x; asm volatile("" : "+v"(tid_));
    const int tid = tid_, wid = __builtin_amdgcn_readfirstlane(tid >> 6), lane = tid & 63, wr = wid >> 2, wc = wid & 3, fr = lane & 15, fq = lane >> 4;
    constexpr int K = KDIM, nt = K / BK;
    unsigned voffA[2], voffB[2];
#pragma unroll
    for (int i = 0; i < 2; ++i) { int R, C; stage_rc(tid * 16 + i * 8192, R, C); const int Rb = Epi::PERM ? ((R & ~31) + perm32(R & 31)) : R;
        const int Ra = Epi::CONV ? (62 * (R >> 6) + (R & 63)) : R;
        voffA[i] = (unsigned)(Ra * K + C) * 2u; voffB[i] = (unsigned)(Rb * K + C) * 2u; }
    const size_t kstep = (size_t)(BK * 2);
    const size_t hstep = (size_t)HALF * K * 2;
    const size_t tstep = 2 * hstep;
    const size_t hstepA = Epi::CONV ? (size_t)124 * K * 2 : hstep, tstepA = 2 * hstepA;
    const unsigned ldsw = (unsigned)wid * 1024u;
    const int aoff = lds_byte(wr * 64 + fr, fq * 8), boff = lds_byte(wc * 32 + fr, fq * 8);
#define PG8_SA(b, h) (((b) * 2 + (h)) * HTB)
#define PG8_SB(b, h) ((4 + (b) * 2 + (h)) * HTB)
#define PG8_STAGE(bufoff, gbase, voff) do { _Pragma("unroll") for (int _i = 0; _i < 2; ++_i) \
        __builtin_amdgcn_global_load_lds((const unsigned*)((const char*)(gbase) + (voff)[_i]), (LAS unsigned*)(lds + (bufoff) + ldsw + _i * 8192), 16, 0, 0); } while (0)
#define PG8_LDA(dst, b, h) do { _Pragma("unroll") for (int m = 0; m < 4; ++m) _Pragma("unroll") for (int k = 0; k < 2; ++k) dst[m][k] = *(const LAS bf16x8*)(lds + PG8_SA(b, h) + aoff + m * 2048 + k * 1024); } while (0)
#define PG8_LDB(dst, b, h) do { _Pragma("unroll") for (int n = 0; n < 2; ++n) _Pragma("unroll") for (int k = 0; k < 2; ++k) dst[n][k] = *(const LAS bf16x8*)(lds + PG8_SB(b, h) + boff + n * 2048 + k * 1024); } while (0)
#define PG8_MMA(ai, bj, At, Bt) do { __builtin_amdgcn_s_setprio(1); _Pragma("unroll") for (int m = 0; m < 4; ++m) _Pragma("unroll") for (int n = 0; n < 2; ++n) _Pragma("unroll") for (int k = 0; k < 2; ++k) \
        acc[ai][bj][m][n] = __builtin_amdgcn_mfma_f32_16x16x32_bf16(Bt[n][k], At[m][k], acc[ai][bj][m][n], 0, 0, 0); __builtin_amdgcn_s_setprio(0); } while (0)
#define PG8_WAIT_V(n) asm volatile("s_waitcnt vmcnt(" #n ")" ::: "memory")
#define PG8_WAIT_L(n) asm volatile("s_waitcnt lgkmcnt(" #n ")" ::: "memory")
#define PG8_BAR __builtin_amdgcn_s_barrier()
#define PG8_SCHED __builtin_amdgcn_sched_barrier(0)
    Unit cur, nxt; int ui = 0;
    if (!S.next(0, cur)) return;
    f32x4 acc[2][2][4][2];
#pragma unroll
    for (int a = 0; a < 2; ++a)
#pragma unroll
        for (int b = 0; b < 2; ++b)
#pragma unroll
            for (int m = 0; m < 4; ++m)
#pragma unroll
                for (int n = 0; n < 2; ++n) acc[a][b][m][n] = (f32x4){0.f, 0.f, 0.f, 0.f};
    bf16x8 At[4][2], B0[2][2], B1[2][2];
    const char* cA = (const char*)g.A + (size_t)cur.pm * tstepA + (cur.pm >= 16 ? Epi::GAPA : 0); const char* cB = (const char*)g.Bt + (size_t)cur.pn * tstep;
    PG8_STAGE(PG8_SB(0, 0), cB, voffB); PG8_STAGE(PG8_SA(0, 0), cA, voffA); PG8_STAGE(PG8_SB(0, 1), cB + hstep, voffB); PG8_STAGE(PG8_SA(0, 1), cA + hstepA, voffA);
    if (wr == 1) PG8_BAR;
    PG8_WAIT_V(4); PG8_BAR;
    PG8_STAGE(PG8_SB(1, 0), cB + kstep, voffB); PG8_STAGE(PG8_SA(1, 0), cA + kstep, voffA); PG8_STAGE(PG8_SB(1, 1), cB + hstep + kstep, voffB);
    PG8_WAIT_V(6); PG8_BAR;
    for (;;) {
        const bool has_next = S.next(ui + 1, nxt);
        const char* nA = has_next ? (const char*)g.A + (size_t)nxt.pm * tstepA + (nxt.pm >= 16 ? Epi::GAPA : 0) : cA; const char* nB = has_next ? (const char*)g.Bt + (size_t)nxt.pn * tstep : cB;
        for (int t = 0; t < nt; t += 2) {
            const bool last = (t == nt - 2);
            const char* a1 = cA + (size_t)(t + 1) * kstep;
            const char* a2 = last ? nA : cA + (size_t)(t + 2) * kstep; const char* b2 = last ? nB : cB + (size_t)(t + 2) * kstep;
            const char* a3 = a2 + kstep; const char* b3 = b2 + kstep;
            PG8_LDB(B0, 0, 0); PG8_SCHED; PG8_LDA(At, 0, 0); PG8_STAGE(PG8_SA(1, 1), a1 + hstepA, voffA);
            PG8_WAIT_L(8); PG8_BAR; PG8_WAIT_L(0); PG8_MMA(0, 0, At, B0); PG8_BAR; PG8_SCHED;
            PG8_LDB(B1, 0, 1); PG8_STAGE(PG8_SB(0, 0), b2, voffB);
            PG8_BAR; PG8_WAIT_L(0); PG8_MMA(0, 1, At, B1); PG8_BAR;
            PG8_LDA(At, 0, 1); PG8_STAGE(PG8_SA(0, 0), a2, voffA);
            PG8_BAR; PG8_WAIT_L(0); PG8_MMA(1, 0, At, B0); PG8_BAR; PG8_SCHED;
            PG8_STAGE(PG8_SB(0, 1), b2 + hstep, voffB);
            PG8_WAIT_V(6); PG8_BAR; PG8_MMA(1, 1, At, B1); PG8_BAR;
            PG8_LDB(B0, 1, 0); PG8_SCHED; PG8_LDA(At, 1, 0); PG8_STAGE(PG8_SA(0, 1), a2 + hstepA, voffA);
            PG8_WAIT_L(8); PG8_BAR; PG8_WAIT_L(0); PG8_MMA(0, 0, At, B0); PG8_BAR; PG8_SCHED;
            PG8_LDB(B1, 1, 1); PG8_STAGE(PG8_SB(1, 0), b3, voffB);
            PG8_BAR; PG8_WAIT_L(0); PG8_MMA(0, 1, At, B1); PG8_BAR;
            PG8_LDA(At, 1, 1); PG8_STAGE(PG8_SA(1, 0), a3, voffA);
            PG8_BAR; PG8_WAIT_L(0); PG8_MMA(1, 0, At, B0); PG8_BAR; PG8_SCHED;
            PG8_STAGE(PG8_SB(1, 1), b3 + hstep, voffB);
            PG8_WAIT_V(6); PG8_BAR; PG8_MMA(1, 1, At, B1); PG8_BAR;
        }
        if constexpr (!Epi::AFTER_DRAIN) E(acc, cur, wr, wc, fr, fq);
        if (!has_next) break;
#pragma unroll
        for (int a = 0; a < 2; ++a)
#pragma unroll
            for (int b = 0; b < 2; ++b)
#pragma unroll
                for (int m = 0; m < 4; ++m)
#pragma unroll
                    for (int n = 0; n < 2; ++n) acc[a][b][m][n] = (f32x4){0.f, 0.f, 0.f, 0.f};
        cur = nxt; cA = nA; cB = nB; ++ui;
    }
    PG8_WAIT_V(0);
    if (wr == 0) PG8_BAR;
    PG8_BAR;
    if constexpr (Epi::AFTER_DRAIN) E(acc, cur, wr, wc, fr, fq);
#undef PG8_SA
#undef PG8_SB
#undef PG8_STAGE
#undef PG8_LDA
#undef PG8_LDB
#undef PG8_MMA
#undef PG8_WAIT_V
#undef PG8_WAIT_L
#undef PG8_BAR
#undef PG8_SCHED
}
}

__device__ __forceinline__ void convert_tile(const float* __restrict__ W, int K, int N, bf16_t* __restrict__ Wt, int k0, int n0, int orow0, float* tile) {
    const int tid = tid_l();
    { const int r = tid >> 4, c4 = (tid & 15) * 4;
#pragma unroll
      for (int ps = 0; ps < 2; ++ps) { const int rr = r + ps * 32; const float4 v = *(const float4*)(W + (size_t)(k0 + rr) * N + n0 + c4);
          tile[rr * 65 + c4 + 0] = v.x; tile[rr * 65 + c4 + 1] = v.y; tile[rr * 65 + c4 + 2] = v.z; tile[rr * 65 + c4 + 3] = v.w; } }
    __syncthreads();
    { const int n = tid >> 3, k8 = (tid & 7) * 8; float v[8];
#pragma unroll
      for (int j = 0; j < 8; ++j) v[j] = tile[(k8 + j) * 65 + n];
      u32x4 w; w.x = cvt_pk_bf16(v[0], v[1]); w.y = cvt_pk_bf16(v[2], v[3]); w.z = cvt_pk_bf16(v[4], v[5]); w.w = cvt_pk_bf16(v[6], v[7]);
      *(u32x4*)(Wt + (size_t)(orow0 + n) * K + k0 + k8) = w; }
    __syncthreads();
}

constexpr int NI_IN = 32 * 68, NI_OUT = 32 * 32, NI_UP = 32 * 176, NI_DN = 88 * 32, NI_POOL = 16, NI_LAYER = NI_IN + NI_OUT + NI_UP + NI_DN + NI_POOL;
constexpr int NI_FILT = 256;
constexpr int NT3 = 1600;
constexpr int R_OUT = NI_IN, R_UP = NI_IN + NI_OUT, R_DN = NI_IN + NI_OUT + NI_UP, R_POOL = NI_IN + NI_OUT + NI_UP + NI_DN;
__device__ void convert_item(const Params& p, int l, int r, float* lds) {
    if (r < NI_IN) { const int tn = r / 32, tk = r % 32;
        convert_tile(inp(2) + (size_t)l * D_MODEL * D_INP, D_MODEL, D_INP, (bf16_t*)(p.ws + OFF_WT_IN + l * SZ_WT_IN), tk * 64, tn * 64, tn * 64, lds); return; }
    r -= NI_IN;
    if (r < NI_OUT) { const int tn = r / 32, tk = r % 32;
        convert_tile(inp(20) + (size_t)l * D_MODEL * D_MODEL, D_MODEL, D_MODEL, (bf16_t*)(p.ws + OFF_WT_OUT + l * SZ_WT_OUT), tk * 64, tn * 64, tn * 64, lds); return; }
    r -= NI_OUT;
    if (r < NI_UP) { const int tn = r / 32, tk = r % 32; const int n0 = tn * 64, s = n0 / D_FF, rem = n0 % D_FF, j = rem / 128, i = rem % 128;
        convert_tile(inp(22) + (size_t)l * D_MODEL * D_UP, D_MODEL, D_UP, (bf16_t*)(p.ws + OFF_WT_UP + l * SZ_WT_UP), tk * 64, n0, 256 * j + 128 * s + i, lds); return; }
    r -= NI_UP;
    if (r < NI_DN) { const int tn = r / 88, tk = r % 88;
        convert_tile(inp(25) + (size_t)l * D_FF * D_MODEL, D_FF, D_MODEL, (bf16_t*)(p.ws + OFF_WT_DN + l * SZ_WT_DN), tk * 64, tn * 64, tn * 64, lds); return; }
    r -= NI_DN;
    { const int g = r >> 2, tn = (r >> 1) & 1, tk = r & 1;
        convert_tile(inp(3) + (size_t)(l * 4 + g) * 128 * 128, 128, 128, (bf16_t*)(p.ws + OFF_POOLWT + l * SZ_POOLWT) + g * 128 * 128, tk * 64, tn * 64, tn * 64, lds); }
}

__device__ __forceinline__ float sin_rad(float x) { return __builtin_amdgcn_sinf(x * 0.15915494309f); }

struct CvDesc { const float* W; bf16_t* Wt; int K, N, k0, n0, orow0; };
__device__ __forceinline__ CvDesc cv_desc(const Params& p, int l, int r) {
    CvDesc d;
    if (r < R_OUT) { const int tn = r / 32, tk = r % 32; d.W = inp(2) + (size_t)l * D_MODEL * D_INP; d.Wt = (bf16_t*)(p.ws + OFF_WT_IN + l * SZ_WT_IN); d.K = D_MODEL; d.N = D_INP; d.k0 = tk * 64; d.n0 = tn * 64; d.orow0 = tn * 64; }
    else if (r < R_UP) { r -= R_OUT; const int tn = r / 32, tk = r % 32; d.W = inp(20) + (size_t)l * D_MODEL * D_MODEL; d.Wt = (bf16_t*)(p.ws + OFF_WT_OUT + l * SZ_WT_OUT); d.K = D_MODEL; d.N = D_MODEL; d.k0 = tk * 64; d.n0 = tn * 64; d.orow0 = tn * 64; }
    else if (r < R_DN) { r -= R_UP; const int tn = r / 32, tk = r % 32; const int n0 = tn * 64, sg = n0 / D_FF, rem = n0 % D_FF, j = rem / 128, i = rem % 128;
        d.W = inp(22) + (size_t)l * D_MODEL * D_UP; d.Wt = (bf16_t*)(p.ws + OFF_WT_UP + l * SZ_WT_UP); d.K = D_MODEL; d.N = D_UP; d.k0 = tk * 64; d.n0 = n0; d.orow0 = 256 * j + 128 * sg + i; }
    else if (r < R_POOL) { r -= R_DN; const int tn = r / 88, tk = r % 88; d.W = inp(25) + (size_t)l * D_FF * D_MODEL; d.Wt = (bf16_t*)(p.ws + OFF_WT_DN + l * SZ_WT_DN); d.K = D_FF; d.N = D_MODEL; d.k0 = tk * 64; d.n0 = tn * 64; d.orow0 = tn * 64; }
    else { r -= R_POOL; const int g = r >> 2, tn = (r >> 1) & 1, tk = r & 1; d.W = inp(3) + (size_t)(l * 4 + g) * 128 * 128; d.Wt = (bf16_t*)(p.ws + OFF_POOLWT + l * SZ_POOLWT) + g * 128 * 128; d.K = 128; d.N = 128; d.k0 = tk * 64; d.n0 = tn * 64; d.orow0 = tn * 64; }
    return d;
}
__device__ __forceinline__ CvDesc cv_pick(const Params& p, int mode, int l, int base, int i) {
    if (mode == 0) { if (i < R_DN) return cv_desc(p, 0, i); if (i < R_DN + NI_POOL) return cv_desc(p, 0, R_POOL + i - R_DN); return cv_desc(p, 1, R_POOL + i - R_DN - NI_POOL); }
    return cv_desc(p, l, base + i);
}
__device__ __forceinline__ void cv_load(const CvDesc& d, int tid, float4 (&v)[2]) {
    const int r = tid >> 4, c4 = (tid & 15) * 4;
#pragma unroll
    for (int ps = 0; ps < 2; ++ps) v[ps] = *(const float4*)(d.W + (size_t)(d.k0 + r + ps * 32) * d.N + d.n0 + c4);
}
__device__ void convert_range(const Params& p, int mode, int l, int base, int count, int start, int stride, float* tile) {
    int i = start; if (i >= count) return;
    const int tid = tid_l();
    CvDesc d = cv_pick(p, mode, l, base, i); float4 v[2]; cv_load(d, tid, v);
    for (;;) {
        { const int r = tid >> 4, c4 = (tid & 15) * 4;
#pragma unroll
          for (int ps = 0; ps < 2; ++ps) { float* tp = tile + (r + ps * 32) * 65 + c4; tp[0] = v[ps].x; tp[1] = v[ps].y; tp[2] = v[ps].z; tp[3] = v[ps].w; } }
        __syncthreads();
        const int ni = i + stride; const bool more = ni < count; CvDesc dn = d;
        if (more) { dn = cv_pick(p, mode, l, base, ni); cv_load(dn, tid, v); }
        { const int n = tid >> 3, k8 = (tid & 7) * 8; float u[8];
#pragma unroll
          for (int j = 0; j < 8; ++j) u[j] = tile[(k8 + j) * 65 + n];
          u32x4 w; w.x = cvt_pk_bf16(u[0], u[1]); w.y = cvt_pk_bf16(u[2], u[3]); w.z = cvt_pk_bf16(u[4], u[5]); w.w = cvt_pk_bf16(u[6], u[7]);
          *(u32x4*)(d.Wt + (size_t)(d.orow0 + n) * d.K + d.k0 + k8) = w; }
        __syncthreads();
        if (!more) break;
        d = dn; i = ni;
    }
}

__device__ __forceinline__ void cv_load4(const CvDesc& d, int tid, float4 (&v)[8]) {
    const int r = tid >> 4, c4 = (tid & 15) * 4;
#pragma unroll
    for (int ps = 0; ps < 8; ++ps) v[ps] = *(const float4*)(d.W + (size_t)(d.k0 + r + ps * 32) * d.N + d.n0 + c4);
}
__device__ void convert_range4(const Params& p, int l, int base, int count4, int start, int stride, float* tile) {
    int i = start; if (i >= count4) return;
    const int tid = tid_l();
    CvDesc d = cv_desc(p, l, base + 4 * i); float4 v[8]; cv_load4(d, tid, v);
    for (;;) {
        { const int r = tid >> 4, c4 = (tid & 15) * 4;
#pragma unroll
          for (int ps = 0; ps < 8; ++ps) { float* tp = tile + (r + ps * 32) * 65 + c4; tp[0] = v[ps].x; tp[1] = v[ps].y; tp[2] = v[ps].z; tp[3] = v[ps].w; } }
        __syncthreads();
        const int ni = i + stride; const bool more = ni < count4; CvDesc dn = d;
        if (more) { dn = cv_desc(p, l, base + 4 * ni); cv_load4(dn, tid, v); }
        { const int n = tid >> 3, kc = tid & 7;
#pragma unroll
          for (int j = 0; j < 4; ++j) { const int k8 = (kc + 8 * j) * 8; float u[8];
#pragma unroll
              for (int q = 0; q < 8; ++q) u[q] = tile[(k8 + q) * 65 + n];
              u32x4 w; w.x = cvt_pk_bf16(u[0], u[1]); w.y = cvt_pk_bf16(u[2], u[3]); w.z = cvt_pk_bf16(u[4], u[5]); w.w = cvt_pk_bf16(u[6], u[7]);
              *(u32x4*)(d.Wt + (size_t)(d.orow0 + n) * d.K + d.k0 + k8) = w; } }
        __syncthreads();
        if (!more) break;
        d = dn; i = ni;
    }
}

__device__ void filter_item(const Params& p, int item, float* lds) {
    const int l = item >> 7, rem = item & 127, ti = rem >> 1, half = rem & 1;
    const int tid = tid_l(), lane = tid & 63, w = __builtin_amdgcn_readfirstlane(tid >> 6);
    const int t = ti * 64 + lane;
    const float* w1 = inp(8) + l * 33 * 64; const float* b1 = inp(9) + l * 64; const float* fr1 = inp(10) + l * 64;
    const float* w2 = inp(11) + l * 64 * 64; const float* b2 = inp(12) + l * 64; const float* fr2 = inp(13) + l * 64;
    const float* w3 = inp(14) + (size_t)l * 64 * 1536;
    float* h1s = lds; float* h2s = lds + 64 * 65;
    const float tt = (float)t / 4095.0f;
    float a[8];
#pragma unroll
    for (int j = 0; j < 8; ++j) a[j] = b1[8 * w + j] + tt * w1[8 * w + j];
    for (int band = 0; band < 16; ++band) {
        const float f = 1e-4f + (float)band * ((15.0f - 1e-4f) / 15.0f);
        float r = f * (float)t * (1.0f / 4096.0f); r -= floorf(r);
        const float cs = __builtin_amdgcn_cosf(r), sn = -__builtin_amdgcn_sinf(r);
#pragma unroll
        for (int j = 0; j < 8; ++j) a[j] += cs * w1[(1 + band) * 64 + 8 * w + j] + sn * w1[(17 + band) * 64 + 8 * w + j];
    }
#pragma unroll
    for (int j = 0; j < 8; ++j) h1s[lane * 65 + 8 * w + j] = sin_rad(fr1[8 * w + j] * a[j]);
    __syncthreads();
#pragma unroll
    for (int j = 0; j < 8; ++j) a[j] = b2[8 * w + j];
    for (int i = 0; i < 64; ++i) { const float h = h1s[lane * 65 + i];
#pragma unroll
        for (int j = 0; j < 8; ++j) a[j] += h * w2[i * 64 + 8 * w + j]; }
#pragma unroll
    for (int j = 0; j < 8; ++j) h2s[lane * 65 + 8 * w + j] = sin_rad(fr2[8 * w + j] * a[j]);
    __syncthreads();
    float* KT = (float*)(p.ws + OFF_ACT) + (size_t)l * 768 * 8192;
    const float d0 = -3.0701134573f, d1 = -15.3505672865f;
    typedef const __attribute__((address_space(4))) f32x4 cf4;
    for (int ci = 0; ci < 24; ++ci) {
        const int c = w * 96 + ci * 4;
        cf4* wc = (cf4*)(unsigned long long)(w3 + half * 768 + c);
        float o0 = 0.f, o1 = 0.f, o2 = 0.f, o3 = 0.f;
#pragma unroll 8
        for (int i = 0; i < 64; ++i) { const float h = h2s[lane * 65 + i]; const f32x4 wv = wc[i * 384]; o0 += h * wv[0]; o1 += h * wv[1]; o2 += h * wv[2]; o3 += h * wv[3]; }
        float o[4] = {o0, o1, o2, o3};
#pragma unroll
        for (int j = 0; j < 4; ++j) {
            const float delta = d0 + (float)(c + j) * ((d1 - d0) / 767.0f);
            const float val = o[j] * __expf(-tt * fabsf(delta));
            float* kt = KT + (size_t)(c + j) * 8192;
            if (half == 0) kt[t] = val; else { if (t == 0) kt[4096] = 0.f; else kt[8192 - t] = val; }
        }
    }
    __syncthreads();
}

__device__ __forceinline__ int phys(int i) { return i + (i >> 5); }
__device__ __forceinline__ float launder_f(float v) { asm volatile("" : "+v"(v)); return v; }
constexpr int FFT_BUF = 8192 + 256;
__device__ __forceinline__ constexpr float c32(int i) { constexpr float T[16] = {1.0f, 0.98078528040f, 0.92387953251f, 0.83146961230f, 0.70710678119f, 0.55557023302f, 0.38268343237f, 0.19509032202f, 0.0f, -0.19509032202f, -0.38268343237f, -0.55557023302f, -0.70710678119f, -0.83146961230f, -0.92387953251f, -0.98078528040f}; return T[i]; }
__device__ __forceinline__ constexpr float s32(int i) { constexpr float T[16] = {0.0f, 0.19509032202f, 0.38268343237f, 0.55557023302f, 0.70710678119f, 0.83146961230f, 0.92387953251f, 0.98078528040f, 1.0f, 0.98078528040f, 0.92387953251f, 0.83146961230f, 0.70710678119f, 0.55557023302f, 0.38268343237f, 0.19509032202f}; return T[i]; }
template <bool INV> __device__ __forceinline__ void radix16(float2 (&x)[16], float rfrac) {
#pragma unroll
    for (int jj = 0; jj < 4; ++jj) { const int j = INV ? 3 - jj : jj; const int half = 8 >> j;
        const float ab = rfrac * (float)(8 / half); const float cb = __builtin_amdgcn_cosf(ab), sb = __builtin_amdgcn_sinf(ab);
#pragma unroll
        for (int kk = 0; kk < half; ++kk) {
            const int idx = kk * (16 / half);
            float cs, sp;
            if (idx == 0) { cs = cb; sp = sb; }
            else if (idx == 8) { cs = -sb; sp = cb; }
            else { cs = cb * c32(idx) - sb * s32(idx); sp = cb * s32(idx) + sb * c32(idx); }
            const float sn = INV ? sp : -sp;
#pragma unroll
            for (int g = 0; g < 16; g += 2 * half) { const int i0 = g + kk, i1 = i0 + half; const float2 a = x[i0], b = x[i1];
                if (!INV) { const float dx = a.x - b.x, dy = a.y - b.y; x[i0] = make_float2(a.x + b.x, a.y + b.y); x[i1] = make_float2(dx * cs - dy * sn, dx * sn + dy * cs); }
                else { const float bx = b.x * cs - b.y * sn, by = b.x * sn + b.y * cs; x[i0] = make_float2(a.x + bx, a.y + by); x[i1] = make_float2(a.x - bx, a.y - by); } }
        }
    }
}
template <bool INV> __device__ __forceinline__ void radix32(float2 (&y)[32]) {
#pragma unroll
    for (int jj = 0; jj < 5; ++jj) { const int j = INV ? 4 - jj : jj; const int half = 16 >> j;
#pragma unroll
        for (int kk = 0; kk < half; ++kk) { const int idx = kk * (16 / half); const float cs = c32(idx), sn = INV ? s32(idx) : -s32(idx);
#pragma unroll
            for (int g = 0; g < 32; g += 2 * half) { const int i0 = g + kk, i1 = i0 + half; const float2 a = y[i0], b = y[i1];
                if (!INV) { const float dx = a.x - b.x, dy = a.y - b.y; y[i0] = make_float2(a.x + b.x, a.y + b.y);
                    if (idx == 0) y[i1] = make_float2(dx, dy);
                    else if (idx == 8) y[i1] = make_float2(dy, -dx);
                    else y[i1] = make_float2(dx * cs - dy * sn, dx * sn + dy * cs); }
                else { float bx, by;
                    if (idx == 0) { bx = b.x; by = b.y; }
                    else if (idx == 8) { bx = -b.y; by = b.x; }
                    else { bx = b.x * cs - b.y * sn; by = b.x * sn + b.y * cs; }
                    y[i0] = make_float2(a.x + bx, a.y + by); y[i1] = make_float2(a.x - bx, a.y - by); } }
        }
    }
}
template <bool INV> __device__ __forceinline__ void fft_pass2(float2* B, int tid, float rfr) {
    const int blk = tid >> 5, r = tid & 31; float2 x[16]; float2* b = B + blk * 528 + r;
#pragma unroll
    for (int k = 0; k < 16; ++k) x[k] = b[33 * k];
    radix16<INV>(x, rfr);
#pragma unroll
    for (int k = 0; k < 16; ++k) b[33 * k] = x[k];
}

__device__ void kf_item(const Params& p, int item, unsigned char* smem) {
    const int l = item / 384, cp = item % 384, c0 = 2 * cp;
    const int tid = tid_l();
    float2* B0 = (float2*)smem; float2* B1 = B0 + FFT_BUF;
    const float* KT = (const float*)(p.ws + OFF_ACT) + ((size_t)l * 768 + c0) * 8192 + tid;
    float2 x0[16], x1[16];
#pragma unroll
    for (int k = 0; k < 16; ++k) { x0[k] = make_float2(KT[512 * k], 0.f); x1[k] = make_float2(KT[8192 + 512 * k], 0.f); }
    const float rf = (float)tid * (1.0f / 8192.0f);
    radix16<false>(x0, rf); radix16<false>(x1, rf);
#pragma unroll
    for (int k = 0; k < 16; ++k) { B0[phys(tid + 512 * k)] = x0[k]; B1[phys(tid + 512 * k)] = x1[k]; }
    __syncthreads();
    { const float r2 = launder_f((float)(tid & 31) * (1.0f / 512.0f)); fft_pass2<false>(B0, tid, r2); fft_pass2<false>(B1, tid, r2); }
    __syncthreads();
    { const int blk = tid & 255, ch = tid >> 8; float2* B = ch ? B1 : B0; float2 y[32];
#pragma unroll
      for (int k = 0; k < 32; ++k) y[k] = B[blk * 33 + k];
      radix32<false>(y);
      float2* KF = (float2*)(p.ws + OFF_KF) + ((size_t)l * 768 + c0 + ch) * 8192 + blk * 2; const float sc = 1.0f / 8192.0f;
#pragma unroll
      for (int k = 0; k < 32; k += 2) *(float4*)(KF + (k >> 1) * 512) = make_float4(y[k].x * sc, y[k].y * sc, y[k + 1].x * sc, y[k + 1].y * sc); }
    __syncthreads();
}

template <bool XF32> __device__ void norm_phase(const void* __restrict__ xin, const float* __restrict__ g, bf16_t* hb, float* hf) {
    const int tid = tid_l(); const int lane = tid & 63; const int gw = blockIdx.x * 8 + (tid >> 6), nw = gridDim.x * 8;
    for (int row = gw; row < NTOK; row += nw) {
        float v[4][8]; float ss = 0.f;
#pragma unroll
        for (int i = 0; i < 4; ++i) { const size_t o = (size_t)row * D_MODEL + i * 512 + lane * 8;
            if (XF32) { const float4 a = *(const float4*)((const float*)xin + o), b = *(const float4*)((const float*)xin + o + 4);
                v[i][0] = a.x; v[i][1] = a.y; v[i][2] = a.z; v[i][3] = a.w; v[i][4] = b.x; v[i][5] = b.y; v[i][6] = b.z; v[i][7] = b.w; }
            else { const u32x4 u = *(const u32x4*)((const bf16_t*)xin + o);
                v[i][0] = lo_bf(u.x); v[i][1] = hi_bf(u.x); v[i][2] = lo_bf(u.y); v[i][3] = hi_bf(u.y); v[i][4] = lo_bf(u.z); v[i][5] = hi_bf(u.z); v[i][6] = lo_bf(u.w); v[i][7] = hi_bf(u.w); }
#pragma unroll
            for (int j = 0; j < 8; ++j) ss += v[i][j] * v[i][j]; }
        ss = wave_sum(ss);
        const float rs = rsqrtf(ss * (1.0f / D_MODEL) + 1e-6f);
#pragma unroll
        for (int i = 0; i < 4; ++i) { const int c = i * 512 + lane * 8; const float4 ga = *(const float4*)(g + c), gb = *(const float4*)(g + c + 4);
            const float y0 = v[i][0] * rs * ga.x, y1 = v[i][1] * rs * ga.y, y2 = v[i][2] * rs * ga.z, y3 = v[i][3] * rs * ga.w, y4 = v[i][4] * rs * gb.x, y5 = v[i][5] * rs * gb.y, y6 = v[i][6] * rs * gb.z, y7 = v[i][7] * rs * gb.w;
            if (hb) { u32x4 w; w.x = cvt_pk_bf16(y0, y1); w.y = cvt_pk_bf16(y2, y3); w.z = cvt_pk_bf16(y4, y5); w.w = cvt_pk_bf16(y6, y7); *(u32x4*)(hb + (size_t)(row + 1 + (row >> 12)) * D_MODEL + c) = w; }
            else { float* op = hf + (size_t)row * D_MODEL + c; *(float4*)op = make_float4(y0, y1, y2, y3); *(float4*)(op + 4) = make_float4(y4, y5, y6, y7); } }
    }
}

__device__ void pool_item(const Params& p, int l, int item, unsigned char* smem) {
    const int tt = item >> 2, g = item & 3;
    const int tid = tid_l(), lane = tid & 63, w = tid >> 6, fr = lane & 15, fq = lane >> 4;
    const bf16_t* P = (const bf16_t*)(p.ws + OFF_P); bf16_t* MIX = (bf16_t*)(p.ws + OFF_MIX);
    const int row0 = tt * 128, b0 = (row0 / SEQ) * SEQ;
    float* X = (float*)smem;
    bf16_t* A = (bf16_t*)(smem + 144 * 129 * 4);
    for (int idx = tid; idx < 144 * 16; idx += 512) { const int r = idx >> 4, c8 = (idx & 15) * 8; const int row = row0 - 8 + r;
        u32x4 v = (u32x4){0u, 0u, 0u, 0u};
        if (row >= b0 && row < b0 + SEQ) v = *(const u32x4*)(P + (size_t)row * D_INP + g * 128 + c8);
        float* xp = X + r * 129 + c8;
        xp[0] = lo_bf(v.x); xp[1] = hi_bf(v.x); xp[2] = lo_bf(v.y); xp[3] = hi_bf(v.y); xp[4] = lo_bf(v.z); xp[5] = hi_bf(v.z); xp[6] = lo_bf(v.w); xp[7] = hi_bf(v.w); }
    __syncthreads();
    { const int c = tid & 127, tq = tid >> 7; const int hw = 1 << g;
      const float* xc = X + (tq * 32 + 8) * 129 + c;
      float s = 0.f;
      for (int q = -hw; q < hw; ++q) s += xc[q * 129];
      const int tb = row0 + tq * 32 - b0;
#pragma unroll 8
      for (int i = 0; i < 32; ++i) { const int t = tb + i; const int lo = max(t - hw, 0), hi = min(t + hw - 1, SEQ - 1);
          const float d = s * __builtin_amdgcn_rcpf((float)(hi - lo + 1)) - xc[i * 129];
          A[(tq * 32 + i) * 136 + c] = (bf16_t)(cvt_pk_bf16(d, 0.f) & 0xffffu);
          s += xc[(i + hw) * 129] - xc[(i - hw) * 129]; } }
    __syncthreads();
    const bf16_t* Wt = (const bf16_t*)(p.ws + OFF_POOLWT + l * SZ_POOLWT) + g * 128 * 128;
    f32x4 acc[8];
#pragma unroll
    for (int nb = 0; nb < 8; ++nb) acc[nb] = (f32x4){0.f, 0.f, 0.f, 0.f};
#pragma unroll
    for (int ks = 0; ks < 4; ++ks) {
        const bf16x8 af = *(const bf16x8*)(A + (16 * w + fr) * 136 + ks * 32 + fq * 8);
#pragma unroll
        for (int nb = 0; nb < 8; ++nb) { const bf16x8 bfr = *(const bf16x8*)(Wt + (nb * 16 + fr) * 128 + ks * 32 + fq * 8);
            acc[nb] = __builtin_amdgcn_mfma_f32_16x16x32_bf16(bfr, af, acc[nb], 0, 0, 0); }
    }
    const float* pb = inp(4) + l * 512 + g * 128; const float* psc = inp(5) + l * 512 + g * 128;
    const int row = row0 + 16 * w + fr;
#pragma unroll
    for (int nb = 0; nb < 8; ++nb) { const int d = nb * 16 + 4 * fq; const float4 bb = *(const float4*)(pb + d), sc = *(const float4*)(psc + d);
        u32x2 o; o.x = cvt_pk_bf16((acc[nb][0] + bb.x) * sc.x, (acc[nb][1] + bb.y) * sc.y); o.y = cvt_pk_bf16((acc[nb][2] + bb.z) * sc.z, (acc[nb][3] + bb.w) * sc.w);
        *(u32x2*)(MIX + (size_t)row * D_MODEL + g * 128 + d) = o; }
    __syncthreads();
}

__device__ void hypre_item(const Params& p, int l, int item, unsigned char* smem) {
    const int tt = item / 6, ct = item % 6; const int tid = tid_l();
    const bf16_t* P = (const bf16_t*)(p.ws + OFF_P); float* ZT = (float*)(p.ws + OFF_ZT); float* X0T = (float*)(p.ws + OFF_X0T);
    const float* sw = inp(6) + (size_t)l * 3 * 2304; const float* sb = inp(7) + (size_t)l * 2304;
    float* zt = (float*)smem;
    float* xt = zt + 128 * 65;
    const int row0 = tt * 64;
    { const int cpq = tid & 63, tr = tid >> 6; const int ch = ct * 128 + 2 * cpq;
      float w[3][3][2], bb[3][2];
#pragma unroll
      for (int s3 = 0; s3 < 3; ++s3) {
#pragma unroll
          for (int k = 0; k < 3; ++k) { const float2 v = *(const float2*)(sw + k * 2304 + s3 * 768 + ch); w[s3][k][0] = v.x; w[s3][k][1] = v.y; }
          const float2 v = *(const float2*)(sb + s3 * 768 + ch); bb[s3][0] = v.x; bb[s3][1] = v.y; }
      const int r0 = row0 + tr * 8; const bf16_t* pr = P + (size_t)r0 * D_INP + COL_HY + ch;
      unsigned pm[3], pc[3], pn[3];
#pragma unroll
      for (int s3 = 0; s3 < 3; ++s3) { pm[s3] = ((r0 & (SEQ - 1)) != 0) ? *(const unsigned*)(pr - D_INP + s3 * 768) : 0u; pc[s3] = *(const unsigned*)(pr + s3 * 768); }
#pragma unroll
      for (int i = 0; i < 8; ++i) { const int row = r0 + i;
#pragma unroll
          for (int s3 = 0; s3 < 3; ++s3) pn[s3] = ((row & (SEQ - 1)) != SEQ - 1) ? *(const unsigned*)(pr + (size_t)(i + 1) * D_INP + s3 * 768) : 0u;
          float o[3][2];
#pragma unroll
          for (int s3 = 0; s3 < 3; ++s3) { o[s3][0] = w[s3][0][0] * lo_bf(pm[s3]) + w[s3][1][0] * lo_bf(pc[s3]) + w[s3][2][0] * lo_bf(pn[s3]) + bb[s3][0];
                                           o[s3][1] = w[s3][0][1] * hi_bf(pm[s3]) + w[s3][1][1] * hi_bf(pc[s3]) + w[s3][2][1] * hi_bf(pn[s3]) + bb[s3][1]; }
          const int tl = tr * 8 + i;
          zt[(2 * cpq) * 65 + tl] = o[1][0] * o[2][0]; zt[(2 * cpq + 1) * 65 + tl] = o[1][1] * o[2][1];
          xt[(2 * cpq) * 65 + tl] = o[0][0]; xt[(2 * cpq + 1) * 65 + tl] = o[0][1];
#pragma unroll
          for (int s3 = 0; s3 < 3; ++s3) { pm[s3] = pc[s3]; pc[s3] = pn[s3]; } } }
    __syncthreads();
    { const int tl = tid & 63, cr = tid >> 6; const int row = row0 + tl, b = row >> 12, t = row & (SEQ - 1);
#pragma unroll
      for (int i = 0; i < 16; ++i) { const int c = cr * 16 + i; const size_t o = (size_t)(ct * 128 + c) * 8192 + b * 4096 + t; ZT[o] = zt[c * 65 + tl]; X0T[o] = xt[c * 65 + tl]; } }
    __syncthreads();
}

constexpr int GM_NH = 3;
__device__ void gmlp_item(const Params& p, int l, int item, unsigned char* smem) {
    const int n = item / (6 / GM_NH), e0 = (item % (6 / GM_NH)) * GM_NH;
    const int tid = tid_l(), lane = tid & 63, w = tid >> 6, fr = lane & 15, fq = lane >> 4;
    const bf16_t* P = (const bf16_t*)(p.ws + OFF_P); bf16_t* MIX = (bf16_t*)(p.ws + OFF_MIX);
    const float* stats = (const float*)(p.ws + OFF_STATS) + (size_t)l * NTOK * 24;
    const float* lng = inp(16) + l * 768; const float* lnb = inp(17) + l * 768;
    bf16_t* VT = (bf16_t*)smem;
    const int t0 = n * 128;
    const int q = 16 * w + fr; const size_t qrow = (size_t)(t0 + q);
    float g0[GM_NH], g1[GM_NH], be0[GM_NH], be1[GM_NH], bq[GM_NH]; u32x2 uu[GM_NH][8]; bf16x8 wf[GM_NH][4];
#pragma unroll
    for (int h = 0; h < GM_NH; ++h) { const int e = e0 + h;
        g0[h] = lng[e * 128 + lane]; g1[h] = lng[e * 128 + 64 + lane]; be0[h] = lnb[e * 128 + lane]; be1[h] = lnb[e * 128 + 64 + lane];
        bq[h] = (inp(19) + (l * 6 + e) * 128)[q];
#pragma unroll
        for (int cb = 0; cb < 8; ++cb) uu[h][cb] = *(const u32x2*)(P + qrow * D_INP + COL_GM + e * 128 + cb * 16 + 4 * fq);
        const float* ws_ = inp(18) + (size_t)(l * 6 + e) * 128 * 128;
#pragma unroll
        for (int ks = 0; ks < 4; ++ks) { const float* wp = ws_ + (16 * w + fr) * 128 + ks * 32 + fq * 8; const float4 a = *(const float4*)wp, b = *(const float4*)(wp + 4);
            u32x4 t; t.x = cvt_pk_bf16(a.x, a.y); t.y = cvt_pk_bf16(a.z, a.w); t.z = cvt_pk_bf16(b.x, b.y); t.w = cvt_pk_bf16(b.z, b.w); wf[h][ks] = __builtin_bit_cast(bf16x8, t); } }
#pragma unroll
    for (int i = 0; i < 16; ++i) { const int pl = 16 * w + i; const size_t row = (size_t)(t0 + pl); const bf16_t* pr = P + row * D_INP + COL_GM + 768 + e0 * 128;
        float2 st; { const f32x4* sp = (const f32x4*)(stats + row * 24); f32x4 a = sp[0];
#pragma unroll
          for (int k = 1; k < 6; ++k) a += sp[k];
          st = make_float2(a[0] + a[2], a[1] + a[3]); }
        const float mean = st.x * (1.0f / 768.0f); const float rstd = rsqrtf(fmaxf(st.y * (1.0f / 768.0f) - mean * mean, 0.f) + 1e-5f);
#pragma unroll
        for (int h = 0; h < GM_NH; ++h) {
            const float y0 = (bf2f(pr[h * 128 + lane]) - mean) * rstd * g0[h] + be0[h], y1 = (bf2f(pr[h * 128 + 64 + lane]) - mean) * rstd * g1[h] + be1[h];
            const unsigned pk = cvt_pk_bf16(y0, y1);
            VT[(h * 128 + lane) * 132 + pl] = (bf16_t)(pk & 0xffffu); VT[(h * 128 + 64 + lane) * 132 + pl] = (bf16_t)(pk >> 16); } }
    __syncthreads();
#pragma unroll
    for (int h = 0; h < GM_NH; ++h) { const int e = e0 + h;
        f32x4 acc[8];
#pragma unroll
        for (int cb = 0; cb < 8; ++cb) acc[cb] = (f32x4){0.f, 0.f, 0.f, 0.f};
#pragma unroll
        for (int ks = 0; ks < 4; ++ks)
#pragma unroll
            for (int cb = 0; cb < 8; ++cb) { const bf16_t* vp = VT + (h * 128 + cb * 16 + fr) * 132 + ks * 32 + fq * 8; const u32x2 lo = *(const u32x2*)vp, hi = *(const u32x2*)(vp + 4);
                u32x4 t; t.x = lo.x; t.y = lo.y; t.z = hi.x; t.w = hi.y;
                acc[cb] = __builtin_amdgcn_mfma_f32_16x16x32_bf16(__builtin_bit_cast(bf16x8, t), wf[h][ks], acc[cb], 0, 0, 0); }
#pragma unroll
        for (int cb = 0; cb < 8; ++cb) { const int c = cb * 16 + 4 * fq;
            const float u0 = lo_bf(uu[h][cb].x), u1 = hi_bf(uu[h][cb].x), u2 = lo_bf(uu[h][cb].y), u3 = hi_bf(uu[h][cb].y);
            u32x2 o; o.x = cvt_pk_bf16(u0 * (acc[cb][0] + bq[h]), u1 * (acc[cb][1] + bq[h])); o.y = cvt_pk_bf16(u2 * (acc[cb][2] + bq[h]), u3 * (acc[cb][3] + bq[h]));
            *(u32x2*)(MIX + qrow * D_MODEL + MIX_GM + e * 128 + c) = o; } }
    __syncthreads();
}

__device__ void fft_item(const Params& p, int l, int cp, unsigned char* smem) {
    const int tid = tid_l(); const int c0 = 2 * cp;
    float2* B0 = (float2*)smem;
    const float* ZT = (const float*)(p.ws + OFF_ZT) + (size_t)c0 * 8192; const float* X0T = (const float*)(p.ws + OFF_X0T) + (size_t)c0 * 8192;
    const float rf = (float)tid * (1.0f / 8192.0f);
#pragma unroll
    for (int ch = 0; ch < 2; ++ch) { float2 x[16]; float2* B = B0 + ch * FFT_BUF; const float* z = ZT + ch * 8192 + tid;
#pragma unroll
        for (int k = 0; k < 8; ++k) { x[k] = make_float2(z[512 * k], z[4096 + 512 * k]); x[k + 8] = make_float2(0.f, 0.f); }
        radix16<false>(x, rf);
#pragma unroll
        for (int k = 0; k < 16; ++k) B[phys(tid + 512 * k)] = x[k]; }
    __syncthreads();
    { const float r2 = launder_f((float)(tid & 31) * (1.0f / 512.0f));
#pragma unroll
      for (int ch = 0; ch < 2; ++ch) fft_pass2<false>(B0 + ch * FFT_BUF, tid, r2); }
    __syncthreads();
    { const int blk = tid & 255, ch = tid >> 8; float2* B = B0 + ch * FFT_BUF + blk * 33; float2 y[32];
#pragma unroll
      for (int k = 0; k < 32; ++k) y[k] = B[k];
      radix32<false>(y);
      const float2* KF = (const float2*)(p.ws + OFF_KF) + ((size_t)l * 768 + c0 + ch) * 8192 + blk * 2;
#pragma unroll
      for (int k = 0; k < 32; k += 2) { const float4 kq = *(const float4*)(KF + (k >> 1) * 512);
          y[k] = make_float2(y[k].x * kq.x - y[k].y * kq.y, y[k].x * kq.y + y[k].y * kq.x); y[k + 1] = make_float2(y[k + 1].x * kq.z - y[k + 1].y * kq.w, y[k + 1].x * kq.w + y[k + 1].y * kq.z); }
      radix32<true>(y);
#pragma unroll
      for (int k = 0; k < 32; ++k) B[k] = y[k]; }
    __syncthreads();
    { const float r2 = launder_f((float)(tid & 31) * (1.0f / 512.0f));
#pragma unroll
      for (int ch = 0; ch < 2; ++ch) fft_pass2<true>(B0 + ch * FFT_BUF, tid, r2); }
    __syncthreads();
    bf16_t* MIX = (bf16_t*)(p.ws + OFF_MIX);
    const float2 dsk = *(const float2*)(inp(15) + l * 768 + c0);
    const float rfi = launder_f(rf);
    { unsigned long long zp = (unsigned long long)ZT; asm volatile("" : "+s"(zp)); ZT = (const float*)zp; }
#pragma unroll 1
    for (int ch = 0; ch < 2; ++ch) { float2 x[16]; float2* B = B0 + ch * FFT_BUF;
#pragma unroll
        for (int k = 0; k < 16; ++k) x[k] = B[phys(tid + 512 * k)];
        radix16<true>(x, rfi);
        const float d = ch ? dsk.y : dsk.x; const float* z = ZT + ch * 8192 + tid; const float* x0 = X0T + ch * 8192 + tid;
        if (ch == 0) {
#pragma unroll
            for (int k = 0; k < 8; ++k) B0[phys(tid + 512 * k)] = make_float2(x0[512 * k] * (x[k].x + d * z[512 * k]), x0[4096 + 512 * k] * (x[k].y + d * z[4096 + 512 * k]));
        } else {
#pragma unroll
            for (int k = 0; k < 8; ++k) { const int t = tid + 512 * k; const float2 r0 = B0[phys(t)];
                const float r1a = x0[512 * k] * (x[k].x + d * z[512 * k]), r1b = x0[4096 + 512 * k] * (x[k].y + d * z[4096 + 512 * k]);
                *(unsigned*)(MIX + (size_t)t * D_MODEL + MIX_HY + c0) = cvt_pk_bf16(r0.x, r1a);
                *(unsigned*)(MIX + (size_t)(4096 + t) * D_MODEL + MIX_HY + c0) = cvt_pk_bf16(r0.y, r1b); }
        } }
    __syncthreads();
}

__device__ void convact_phase(const Params& p, int l) {
    const bf16_t* UP = (const bf16_t*)(p.ws + OFF_UP); bf16_t* ACT = (bf16_t*)(p.ws + OFF_ACT);
    const float* cw = inp(23) + (size_t)l * 3 * D_UP; const float* cb = inp(24) + (size_t)l * D_UP;
    const int nthr = gridDim.x * 512;
    const int tid = tid_l();
    for (int idx = blockIdx.x * 512 + tid; idx < 704 * 512; idx += nthr) {
        const int cg8 = idx % 704, run = idx / 704; const int j = cg8 >> 4, i8 = (cg8 & 15) * 8;
        const int ncol = j * 128 + i8;
        float wg[3][8], wv[3][8], bg[8], bv[8];
#pragma unroll
        for (int k = 0; k < 3; ++k) { const float4 a = *(const float4*)(cw + k * D_UP + ncol), b = *(const float4*)(cw + k * D_UP + ncol + 4);
            wg[k][0] = a.x; wg[k][1] = a.y; wg[k][2] = a.z; wg[k][3] = a.w; wg[k][4] = b.x; wg[k][5] = b.y; wg[k][6] = b.z; wg[k][7] = b.w;
            const float4 c = *(const float4*)(cw + k * D_UP + D_FF + ncol), d = *(const float4*)(cw + k * D_UP + D_FF + ncol + 4);
            wv[k][0] = c.x; wv[k][1] = c.y; wv[k][2] = c.z; wv[k][3] = c.w; wv[k][4] = d.x; wv[k][5] = d.y; wv[k][6] = d.z; wv[k][7] = d.w; }
        { const float4 a = *(const float4*)(cb + ncol), b = *(const float4*)(cb + ncol + 4); bg[0] = a.x; bg[1] = a.y; bg[2] = a.z; bg[3] = a.w; bg[4] = b.x; bg[5] = b.y; bg[6] = b.z; bg[7] = b.w;
          const float4 c = *(const float4*)(cb + D_FF + ncol), d = *(const float4*)(cb + D_FF + ncol + 4); bv[0] = c.x; bv[1] = c.y; bv[2] = c.z; bv[3] = c.w; bv[4] = d.x; bv[5] = d.y; bv[6] = d.z; bv[7] = d.w; }
        const int r0 = run * 16; const size_t colg = (size_t)j * 256 + i8, colv = colg + 128;
        u32x4 gm = (u32x4){0u, 0u, 0u, 0u}, vm = gm, gc, vc, gn, vn;
        if ((r0 & (SEQ - 1)) != 0) { gm = *(const u32x4*)(UP + (size_t)(r0 - 1) * D_UP + colg); vm = *(const u32x4*)(UP + (size_t)(r0 - 1) * D_UP + colv); }
        gc = *(const u32x4*)(UP + (size_t)r0 * D_UP + colg); vc = *(const u32x4*)(UP + (size_t)r0 * D_UP + colv);
        for (int r = r0; r < r0 + 16; ++r) {
            if ((r & (SEQ - 1)) != SEQ - 1) { gn = *(const u32x4*)(UP + (size_t)(r + 1) * D_UP + colg); vn = *(const u32x4*)(UP + (size_t)(r + 1) * D_UP + colv); }
            else { gn = (u32x4){0u, 0u, 0u, 0u}; vn = gn; }
            float o[8];
#pragma unroll
            for (int q = 0; q < 4; ++q) {
                const float ga = wg[0][2 * q] * lo_bf(gm[q]) + wg[1][2 * q] * lo_bf(gc[q]) + wg[2][2 * q] * lo_bf(gn[q]) + bg[2 * q];
                const float gb = wg[0][2 * q + 1] * hi_bf(gm[q]) + wg[1][2 * q + 1] * hi_bf(gc[q]) + wg[2][2 * q + 1] * hi_bf(gn[q]) + bg[2 * q + 1];
                const float va = wv[0][2 * q] * lo_bf(vm[q]) + wv[1][2 * q] * lo_bf(vc[q]) + wv[2][2 * q] * lo_bf(vn[q]) + bv[2 * q];
                const float vb = wv[0][2 * q + 1] * hi_bf(vm[q]) + wv[1][2 * q + 1] * hi_bf(vc[q]) + wv[2][2 * q + 1] * hi_bf(vn[q]) + bv[2 * q + 1];
                o[2 * q] = silu(ga) * va; o[2 * q + 1] = silu(gb) * vb; }
            u32x4 ow; ow.x = cvt_pk_bf16(o[0], o[1]); ow.y = cvt_pk_bf16(o[2], o[3]); ow.z = cvt_pk_bf16(o[4], o[5]); ow.w = cvt_pk_bf16(o[6], o[7]);
            *(u32x4*)(ACT + (size_t)r * D_FF + ncol) = ow;
            gm = gc; vm = vc; gc = gn; vc = vn;
        }
    }
}

__global__ void __launch_bounds__(512, 2) fwd_megakernel(Params p) {
    extern __shared__ __attribute__((aligned(16))) unsigned char smem[];
    cg::grid_group grid = cg::this_grid();
    const int G = gridDim.x, bid = blockIdx.x;
    int step = 0;
    if (p.ph_hi < 0) grid.sync();
    volatile LAS unsigned* xst = (volatile LAS unsigned*)(LAS unsigned char*)(smem + LDS_BYTES - 16);
    if (threadIdx.x < 4) xst[threadIdx.x] = 0u;
    __syncthreads();
    XcdBarrier xb = xcd_barrier_post((unsigned*)(p.ws + OFF_BAR), xst);
#define STEP_BEGIN if (step >= p.ph_lo && step < p.ph_hi) {
#define STEP_END } ++step; if (step > p.ph_lo && step < p.ph_hi) xcd_barrier(xb);

    bf16_t* H = (bf16_t*)(p.ws + OFF_H);
    bf16_t* XA = (bf16_t*)(p.ws + OFF_XA);
#if PROBE == 6
    for (int i = 0; i < 20; ++i) xcd_barrier(xb);
#endif

    STEP_BEGIN
        for (int it = bid; it < NI_FILT; it += G) filter_item(p, it, (float*)smem);
        convert_range4(p, 0, 0, NI_IN / 4, bid, G, (float*)smem);
        convert_range(p, 1, 0, R_POOL, NI_POOL, bid, G, (float*)smem); convert_range(p, 1, 1, R_POOL, NI_POOL, bid, G, (float*)smem);
        if (bid < 3) { const int zr = bid == 0 ? 0 : (bid == 1 ? 4097 : 8194); for (int i = tid_l(); i < D_MODEL / 2; i += 512) ((unsigned*)(H + (size_t)zr * D_MODEL))[i] = 0u; }
        norm_phase<true>(inp(0), inp(1), H, nullptr);
    STEP_END

    for (int l = 0; l < 2; ++l) {
        STEP_BEGIN
            pg8::Gemm g{H + D_MODEL, (const bf16_t*)(p.ws + OFF_WT_IN + l * SZ_WT_IN), NTOK, D_INP, D_MODEL}; pg8::StaticOrder S; S.init(NTOK, D_INP, G, bid);
            pg8::EpiBf16Gm E{(bf16_t*)(p.ws + OFF_P), D_INP, (float*)(p.ws + OFF_STATS) + (size_t)l * NTOK * 24};
            pg8::gemm_phase<pg8::EpiBf16Gm, pg8::StaticOrder, D_MODEL>((LAS unsigned char*)smem, g, S, E);
            { const int rem = (NTOK / 256) * (D_INP / 256) % G;
              if (bid >= rem) for (int rep_ = 0; rep_ < (PROBE == 11 ? 2 : 1); ++rep_) {
                  if (l == 0) { for (int it = bid - rem; it < 768; it += G - rem) kf_item(p, it, smem); convert_range4(p, 1, 0, NI_IN / 4, bid - rem, G - rem, (float*)smem); convert_range4(p, 0, R_DN + NT3, (NI_DN - NT3) / 4, bid - rem, G - rem, (float*)smem); }
                  else { convert_range4(p, 1, R_OUT, (NI_OUT + NI_UP) / 4, bid - rem, G - rem, (float*)smem); convert_range4(p, 1, R_DN + NT3, (NI_DN - NT3) / 4, bid - rem, G - rem, (float*)smem); } } }
        STEP_END
        STEP_BEGIN
            for (int it = bid; it < 768; it += G) hypre_item(p, l, it, smem);
        STEP_END
        STEP_BEGIN
            for (int rep_ = 0; rep_ < (PROBE == 13 ? 2 : 1); ++rep_) {
            unsigned* wq = (unsigned*)(p.ws + OFF_BAR) + 3500 + l + 8 * rep_;
            for (;;) {
                __syncthreads();
                if (threadIdx.x == 0) xst[2] = atomicAdd(wq, 1u);
                __syncthreads();
                const int it = __builtin_amdgcn_readfirstlane((int)xst[2]);
                constexpr int NCH = (NI_OUT + NI_UP) / 8, NMIX = 384 + 128 + 256;
                int mi = it, ch = -1;
                if (l == 0) { if (it < 2 * NMIX) { if (it & 1) { ch = it >> 1; mi = -1; } else mi = it >> 1; } else { ch = NMIX + (it - 2 * NMIX); mi = -1; } }
                if (l == 0 ? it >= NMIX + NCH : it >= NMIX) break;
                if (ch >= 0) { if (ch < NCH) convert_range4(p, 0, R_OUT + ch * 8, 2, 0, 1, (float*)smem); }
                else if (mi < 384) fft_item(p, l, mi, smem); else if (mi < 512) gmlp_item(p, l, mi - 384, smem); else pool_item(p, l, mi - 512, smem);
            }
            }
#if PROBE == 21
            for (int it = bid; it < 256; it += G) pool_item(p, l, it, smem);
#elif PROBE == 22
            for (int it = bid; it < 128; it += G) gmlp_item(p, l, it, smem);
#elif PROBE == 3
            for (int it = bid; it < 384; it += G) fft_item(p, l, it, smem);
#endif
        STEP_END
        STEP_BEGIN
            pg8::Gemm g{(const bf16_t*)(p.ws + OFF_MIX), (const bf16_t*)(p.ws + OFF_WT_OUT + l * SZ_WT_OUT), NTOK, D_MODEL, D_MODEL}; pg8::StaticOrder S; S.init(NTOK, D_MODEL, G, bid);
            float* ssp = (float*)(p.ws + OFF_SSP) + (size_t)(2 * l) * NTOK * 32; unsigned* pc = (unsigned*)(p.ws + OFF_BAR) + 3600 + 64 * l;
            if (l == 0) { pg8::EpiResNorm<true, false> E{XA, inp(0), D_MODEL, inp(21) + l * D_MODEL, H, nullptr, ssp, pc}; pg8::gemm_phase<pg8::EpiResNorm<true, false>, pg8::StaticOrder, D_MODEL>((LAS unsigned char*)smem, g, S, E); }
            else { pg8::EpiResNorm<false, false> E{XA, XA, D_MODEL, inp(21) + l * D_MODEL, H, nullptr, ssp, pc}; pg8::gemm_phase<pg8::EpiResNorm<false, false>, pg8::StaticOrder, D_MODEL>((LAS unsigned char*)smem, g, S, E); }
        STEP_END
        STEP_BEGIN
            pg8::Gemm g{H, (const bf16_t*)(p.ws + OFF_WT_UP + l * SZ_WT_UP), NTOK, D_UP, D_MODEL}; pg8::StaticOrder S; S.init_tiles(34, D_UP / 256, G, bid);
            pg8::EpiConvAct E{(bf16_t*)(p.ws + OFF_ACT), inp(23) + (size_t)l * 3 * D_UP, inp(24) + (size_t)l * D_UP};
            pg8::gemm_phase<pg8::EpiConvAct, pg8::StaticOrder, D_MODEL>((LAS unsigned char*)smem, g, S, E);
#if PROBE == 7
            pg8::gemm_phase<pg8::EpiConvAct, pg8::StaticOrder, D_MODEL>((LAS unsigned char*)smem, g, S, E);
#endif
            { const int rem = (34 * (D_UP / 256)) % G; if (bid >= rem) convert_range4(p, l, R_DN, NT3 / 4, bid - rem, G - rem, (float*)smem); }
        STEP_END
        STEP_BEGIN
            pg8::Gemm g{(const bf16_t*)(p.ws + OFF_ACT), (const bf16_t*)(p.ws + OFF_WT_DN + l * SZ_WT_DN), NTOK, D_MODEL, D_FF}; pg8::StaticOrder S; S.init(NTOK, D_MODEL, G, bid);
            float* ssp = (float*)(p.ws + OFF_SSP) + (size_t)(2 * l + 1) * NTOK * 32; unsigned* pc = (unsigned*)(p.ws + OFF_BAR) + 3600 + 64 * l + 32;
            if (l == 0) { pg8::EpiResNorm<false, false> E{XA, XA, D_MODEL, inp(1) + D_MODEL, H, nullptr, ssp, pc}; pg8::gemm_phase<pg8::EpiResNorm<false, false>, pg8::StaticOrder, D_FF>((LAS unsigned char*)smem, g, S, E); }
            else { pg8::EpiResNorm<false, true> E{XA, XA, D_MODEL, inp(26), nullptr, p.out, ssp, pc}; pg8::gemm_phase<pg8::EpiResNorm<false, true>, pg8::StaticOrder, D_FF>((LAS unsigned char*)smem, g, S, E); }
        STEP_END
    }
}

constexpr int N_STEPS = 13;
#ifndef MULTI_LAUNCH
#define MULTI_LAUNCH 0
#endif

extern "C" void kernel_launch(void* const* d_in, const int* in_sizes, int n_in, void* d_out, int out_size, void* d_ws, size_t ws_size, hipStream_t stream) {
    static int grid = 0;
    if (grid == 0) {
        if (n_in != 27 || ws_size < WS_END) { fprintf(stderr, "kernel_launch: need 27 inputs and %zu bytes of workspace (got %d, %zu)\n", (size_t)WS_END, n_in, ws_size); grid = -1; return; }
        int dev = 0, cus = 0, per_cu = 0;
        hipGetDevice(&dev); hipDeviceGetAttribute(&cus, hipDeviceAttributeMultiprocessorCount, dev);
        if (hipFuncSetAttribute((const void*)fwd_megakernel, hipFuncAttributeMaxDynamicSharedMemorySize, LDS_BYTES) != hipSuccess) { fprintf(stderr, "kernel_launch: hipFuncSetAttribute failed\n"); grid = -1; return; }
        if (hipOccupancyMaxActiveBlocksPerMultiprocessor(&per_cu, (const void*)fwd_megakernel, 512, LDS_BYTES) != hipSuccess || per_cu < 1) { fprintf(stderr, "kernel_launch: occupancy query gave %d\n", per_cu); per_cu = 1; }
        (void)hipGetLastError();
        grid = cus * 1;
    }
    if (grid < 0) return;
    if (hipMemsetAsync((char*)d_ws + OFF_BAR, 0, 16384, stream) != hipSuccess) { fprintf(stderr, "kernel_launch: memset failed\n"); return; }
    Params p{};
    for (int i = 0; i < 27; ++i) p.in[i] = (const float*)d_in[i];
    p.out = (float*)d_out; p.ws = (unsigned char*)d_ws;
#if MULTI_LAUNCH
    for (int s = 0; s < N_STEPS; ++s) { p.ph_lo = s; p.ph_hi = s + 1; hipLaunchKernelGGL(fwd_megakernel, dim3(grid), dim3(512), LDS_BYTES, stream, p); }
#else
    p.ph_lo = 0; p.ph_hi = N_STEPS;
    void* args[] = {&p};
    hipError_t e = hipLaunchCooperativeKernel((const void*)fwd_megakernel, dim3(grid), dim3(512), args, LDS_BYTES, stream);
    if (e != hipSuccess) fprintf(stderr, "cooperative launch failed: %s (grid %d)\n", hipGetErrorString(e), grid);
#endif
}
```

```cpp
#include <hip/hip_runtime.h>
#include <hip/hip_cooperative_groups.h>
#include <cstdio>
namespace cg = cooperative_groups;

#define LAS __attribute__((address_space(3)))
typedef unsigned short bf16_t;
typedef short bf16x8 __attribute__((ext_vector_type(8)));
typedef float f32x4 __attribute__((ext_vector_type(4)));
typedef unsigned u32x4 __attribute__((ext_vector_type(4)));
typedef unsigned u32x2 __attribute__((ext_vector_type(2)));

constexpr int D_MODEL = 2048, SEQ = 4096, NTOK = 8192, D_INP = 4352, D_FF = 5632, D_UP = 11264;
constexpr int D_HY = 768, D_GM = 768;
constexpr int COL_HY = 512, COL_GM = 2816;
constexpr int MIX_HY = 512, MIX_GM = 1280;

constexpr size_t SZ_WT_IN = (size_t)D_INP * D_MODEL * 2, SZ_WT_OUT = (size_t)D_MODEL * D_MODEL * 2, SZ_WT_UP = (size_t)D_UP * D_MODEL * 2, SZ_WT_DN = (size_t)D_MODEL * D_FF * 2;
constexpr size_t SZ_POOLWT = 4 * 128 * 128 * 2, SZ_KF = (size_t)768 * 8192 * 8, SZ_H2 = (size_t)4096 * 64 * 4, SZ_STATS = (size_t)NTOK * 12 * 2 * 4;
constexpr size_t OFF_WT_IN = 0;
constexpr size_t OFF_WT_OUT = OFF_WT_IN + 2 * SZ_WT_IN;
constexpr size_t OFF_WT_UP = OFF_WT_OUT + 2 * SZ_WT_OUT;
constexpr size_t OFF_WT_DN = OFF_WT_UP + 2 * SZ_WT_UP;
constexpr size_t OFF_POOLWT = OFF_WT_DN + 2 * SZ_WT_DN;
constexpr size_t OFF_KF = OFF_POOLWT + 2 * SZ_POOLWT;
constexpr size_t OFF_H2 = OFF_KF + 2 * SZ_KF;
constexpr size_t OFF_STATS = OFF_H2 + 2 * SZ_H2;
constexpr size_t OFF_XA = OFF_STATS + 2 * SZ_STATS;
constexpr size_t OFF_H = OFF_XA + (size_t)NTOK * D_MODEL * 4;
constexpr size_t OFF_R1 = OFF_H + (size_t)(NTOK + 512) * D_MODEL * 2;
constexpr size_t OFF_P = OFF_R1;
constexpr size_t OFF_MIX = OFF_P + (size_t)NTOK * D_INP * 2;
constexpr size_t OFF_ZT = OFF_MIX + (size_t)NTOK * D_MODEL * 2;
constexpr size_t OFF_X0T = OFF_ZT + (size_t)768 * 8192 * 4;
constexpr size_t OFF_UP = OFF_R1;
constexpr size_t OFF_ACT = OFF_R1 + (size_t)NTOK * D_UP * 2;
constexpr size_t OFF_BAR = OFF_ACT + (size_t)NTOK * D_FF * 2;
constexpr size_t OFF_SSP = OFF_BAR + 16384;
constexpr size_t WS_END = OFF_SSP + (size_t)4 * NTOK * 32 * 4;
static_assert(OFF_X0T + (size_t)768 * 8192 * 4 <= OFF_ACT, "alias region");

constexpr int LDS_BYTES = 139264;
#ifndef PROBE
#define PROBE 0
#endif
#define REP(k) for (int rep_ = 0; rep_ < ((PROBE == (k)) ? 2 : 1); ++rep_)

struct Params {
    const float* in[27];
    float* out;
    unsigned char* ws;
    int ph_lo, ph_hi;
};


__device__ __forceinline__ const float* inp(int i) {
    const __attribute__((address_space(4))) char* ka = (const __attribute__((address_space(4))) char*)__builtin_amdgcn_kernarg_segment_ptr();
    int off = i * 8; asm volatile("" : "+s"(off));
    return *(const float* const __attribute__((address_space(4)))*)(ka + off);
}

__device__ __forceinline__ int tid_l() { int t = threadIdx.x; asm volatile("" : "+v"(t)); return t; }
__device__ __forceinline__ float bf2f(bf16_t b) { return __uint_as_float(((unsigned)b) << 16); }
__device__ __forceinline__ unsigned cvt_pk_bf16(float lo, float hi) { unsigned r; asm volatile("v_cvt_pk_bf16_f32 %0, %1, %2" : "=v"(r) : "v"(lo), "v"(hi)); return r; }
__device__ __forceinline__ float lo_bf(unsigned u) { return __uint_as_float(u << 16); }
__device__ __forceinline__ float hi_bf(unsigned u) { return __uint_as_float(u & 0xffff0000u); }
__device__ __forceinline__ float gelu_tanh(float x) {
    const float y2 = 1.5957691216f * (x + 0.044715f * x * x * x);
    return x * __builtin_amdgcn_rcpf(1.0f + __expf(-y2));
}
__device__ __forceinline__ float silu(float x) { return x * __builtin_amdgcn_rcpf(1.0f + __expf(-x)); }
__device__ __forceinline__ float wave_sum(float v) {
#pragma unroll
    for (int o = 32; o > 0; o >>= 1) v += __shfl_xor(v, o, 64);
    return v;
}

#define XB_TMO      128
#define XB_XCNT(j)  (256  + 64 * (j))
#define XB_XSUB(j)  (1280 + 64 * (j))
#define XB_XGEN(j)  (2304 + 64 * (j))
#define XB_TOP      3328
#define XB_TOPGEN   3392
#define XCD_BAR_WORDS 3456
#define XB_SPIN_CAP (1u << 18)

__device__ __forceinline__ unsigned xb_ld(unsigned* p)              { return __hip_atomic_load(p, __ATOMIC_RELAXED, __HIP_MEMORY_SCOPE_AGENT); }
__device__ __forceinline__ unsigned xb_add(unsigned* p, unsigned v) { return __hip_atomic_fetch_add(p, v, __ATOMIC_RELAXED, __HIP_MEMORY_SCOPE_AGENT); }
__device__ __forceinline__ unsigned xb_xcc_id() { return (unsigned)__builtin_amdgcn_s_getreg((3 << 11) | 20) & 0xFu; }
#define XB_SPIN(cond, bar) do { unsigned _sp = 0; while (cond) { __builtin_amdgcn_s_sleep(1); \
    if ((++_sp & 255u) == 0u) { if (xb_ld(&(bar)[XB_TMO])) break; if (_sp > XB_SPIN_CAP) { atomicAdd(&(bar)[XB_TMO], 1u); break; } } } } while (0)

struct XcdBarrier {
    unsigned* bar; unsigned x;
    volatile LAS unsigned* st;
};

__device__ __forceinline__ XcdBarrier xcd_barrier_post(unsigned* bar, volatile LAS unsigned* st) {
    XcdBarrier b; b.bar = bar; b.x = xb_xcc_id(); b.st = st;
    if (threadIdx.x == 0) (void)xb_add(&bar[XB_XCNT(b.x)], 1u);
    return b;
}
__device__ __forceinline__ void xcd_barrier_complete(unsigned* bar, unsigned x, unsigned& nloc, unsigned& nx) {
    const unsigned G = gridDim.x * gridDim.y * gridDim.z;
    unsigned sum, cnt, mine, sp = 0u;
    for (;;) {
        sum = 0u; cnt = 0u; mine = 0u;
#pragma unroll
        for (unsigned j = 0; j < 16; ++j) { const unsigned c = xb_ld(&bar[XB_XCNT(j)]); sum += c; cnt += (c > 0u) ? 1u : 0u; mine = (j == x) ? c : mine; }
        if (sum == G) break;
        __builtin_amdgcn_s_sleep(1);
        if ((++sp & 255u) == 0u) { if (xb_ld(&bar[XB_TMO])) break; if (sp > XB_SPIN_CAP) { atomicAdd(&bar[XB_TMO], 1u); break; } }
    }
    nloc = mine > 0u ? mine : 1u; nx = cnt > 0u ? cnt : 1u;
}

__device__ __forceinline__ void xcd_barrier(const XcdBarrier& b) {
    asm volatile("s_waitcnt vmcnt(0)" ::: "memory");
    __syncthreads();
    if (threadIdx.x == 0) {
        unsigned* bar = b.bar;
        __builtin_amdgcn_s_waitcnt(0);
        unsigned nloc = b.st[0], nx = b.st[1];
        if (nloc == 0u) { xcd_barrier_complete(bar, b.x, nloc, nx); b.st[0] = nloc; b.st[1] = nx; }
        const unsigned old = xb_add(&bar[XB_XSUB(b.x)], 1u);
        const unsigned gen = old / nloc;
        if (old + 1u == (gen + 1u) * nloc) {
            __builtin_amdgcn_fence(__ATOMIC_RELEASE, "agent");
            asm volatile("s_waitcnt vmcnt(0)" ::: "memory");
            const unsigned og = xb_add(&bar[XB_TOP], 1u);
            const unsigned tg = og / nx;
            if (og + 1u == (tg + 1u) * nx) xb_add(&bar[XB_TOPGEN], 1u);
            else XB_SPIN(xb_ld(&bar[XB_TOPGEN]) == tg, bar);
            __builtin_amdgcn_fence(__ATOMIC_ACQUIRE, "agent");
            xb_add(&bar[XB_XGEN(b.x)], 1u);
            asm volatile("s_waitcnt vmcnt(0)" ::: "memory");
        } else {
            XB_SPIN(xb_ld(&bar[XB_XGEN(b.x)]) == gen, bar);
            __builtin_amdgcn_fence(__ATOMIC_ACQUIRE, "agent");
            asm volatile("s_waitcnt vmcnt(0)" ::: "memory");
        }
    }
    __syncthreads();
}


namespace pg8 {
constexpr int BM = 256, BK = 64, HALF = 128, HTB = HALF * BK * 2, STAGE_BYTES = 8 * HTB, NXCD = 8, WGM = 8;
__host__ __device__ __forceinline__ int lds_byte(int r, int c) { const int st = (r >> 4) * 2 + (c >> 5), rr = r & 15, cc = c & 31, ob = rr * 64 + cc * 2; return st * 1024 + (ob ^ (((ob >> 9) & 1) << 5)); }
__host__ __device__ __forceinline__ void stage_rc(int b, int& R, int& C) { const int st = b / 1024, sb = b % 1024, swz = sb ^ (((sb >> 9) & 1) << 5); R = (st >> 1) * 16 + swz / 64; C = (st & 1) * 32 + (swz % 64) / 2; }
__host__ __device__ __forceinline__ int perm32(int rho) { const int n = rho >> 4, i = rho & 15; return 8 * (i >> 2) + 4 * n + (i & 3); }
struct Unit { int pm, pn; };
struct Gemm { const bf16_t* A; const bf16_t* Bt; int M, N, K; };
struct StaticOrder {
    int nM, nN, nwg, G, c, wgm = WGM;
    __device__ void init(int M, int N, int G_, int c_) { nM = M / BM; nN = N / BM; nwg = nM * nN; G = G_; c = c_; }
    __device__ void init_tiles(int nM_, int nN_, int G_, int c_) { nM = nM_; nN = nN_; nwg = nM * nN; G = G_; c = c_; }
    __device__ bool next(int i, Unit& u) const {
        const long L = (long)i * G + c; if (L >= nwg) return false;
        int wgid = (int)L; { const int q = nwg / NXCD, r = nwg % NXCD, xcd = wgid % NXCD, off = wgid / NXCD; wgid = (xcd < r ? xcd * (q + 1) : r * (q + 1) + (xcd - r) * q) + off; }
        const int nig = wgm * nN, gid = wgid / nig, fm = gid * wgm, gsz = (nM - fm) < wgm ? (nM - fm) : wgm;
        u.pm = fm + ((wgid % nig) % gsz); u.pn = (wgid % nig) / gsz; return true;
    }
};
struct EpiBf16 {
    static constexpr bool PERM = true, CONV = false, AFTER_DRAIN = false; static constexpr int GAPA = 0;
    bf16_t* O; int ldc;
    __device__ __forceinline__ void operator()(const f32x4 (&acc)[2][2][4][2], const Unit& u, int wr, int wc, int fr, int fq) const {
        const int row0 = u.pm * BM + wr * 64 + fr; const int col0 = u.pn * BM + wc * 32 + 8 * fq;
#pragma unroll
        for (int ai = 0; ai < 2; ++ai)
#pragma unroll
            for (int m = 0; m < 4; ++m) { bf16_t* rowp = O + (size_t)(row0 + ai * HALF + m * 16) * ldc + col0;
#pragma unroll
                for (int bj = 0; bj < 2; ++bj) { const f32x4 v0 = acc[ai][bj][m][0], v1 = acc[ai][bj][m][1];
                    u32x4 w; w.x = cvt_pk_bf16(v0[0], v0[1]); w.y = cvt_pk_bf16(v0[2], v0[3]); w.z = cvt_pk_bf16(v1[0], v1[1]); w.w = cvt_pk_bf16(v1[2], v1[3]);
                    *(u32x4*)(rowp + bj * HALF) = w; } }
    }
};
struct EpiBf16Gm {
    static constexpr bool PERM = true, CONV = false, AFTER_DRAIN = false; static constexpr int GAPA = D_MODEL * 2;
    bf16_t* O; int ldc; float* stats;
    __device__ __forceinline__ void operator()(const f32x4 (&acc)[2][2][4][2], const Unit& u, int wr, int wc, int fr, int fq) const {
        const int row0 = u.pm * BM + wr * 64 + fr; const int col0 = u.pn * BM + wc * 32 + 8 * fq;
        const bool act = u.pn >= 11, st = u.pn >= 14;
#pragma unroll
        for (int ai = 0; ai < 2; ++ai)
#pragma unroll
            for (int m = 0; m < 4; ++m) { const int row = row0 + ai * HALF + m * 16; bf16_t* rowp = O + (size_t)row * ldc + col0; float s1 = 0.f, s2 = 0.f;
#pragma unroll
                for (int bj = 0; bj < 2; ++bj) { f32x4 v0 = acc[ai][bj][m][0], v1 = acc[ai][bj][m][1];
                    if (act) {
#pragma unroll
                        for (int j = 0; j < 4; ++j) { v0[j] = gelu_tanh(v0[j]); v1[j] = gelu_tanh(v1[j]); s1 += v0[j] + v1[j]; s2 += v0[j] * v0[j] + v1[j] * v1[j]; } }
                    u32x4 w; w.x = cvt_pk_bf16(v0[0], v0[1]); w.y = cvt_pk_bf16(v0[2], v0[3]); w.z = cvt_pk_bf16(v1[0], v1[1]); w.w = cvt_pk_bf16(v1[2], v1[3]);
                    *(u32x4*)(rowp + bj * HALF) = w; }
                if (st) { s1 += __shfl_xor(s1, 16, 64); s2 += __shfl_xor(s2, 16, 64); s1 += __shfl_xor(s1, 32, 64); s2 += __shfl_xor(s2, 32, 64);
                    if (fq == 0) *(float2*)(stats + ((size_t)row * 12 + (u.pn - 14) * 4 + wc) * 2) = make_float2(s1, s2); } }
    }
};
__device__ __forceinline__ float dpp_ror1(float v) { return __builtin_bit_cast(float, __builtin_amdgcn_mov_dpp(__builtin_bit_cast(int, v), 0x121, 0xf, 0xf, true)); }
__device__ __forceinline__ float dpp_rol1(float v) { return __builtin_bit_cast(float, __builtin_amdgcn_mov_dpp(__builtin_bit_cast(int, v), 0x12F, 0xf, 0xf, true)); }
struct EpiConvAct {
    static constexpr bool PERM = true, CONV = true, AFTER_DRAIN = false; static constexpr int GAPA = 0;
    bf16_t* ACT; const float* cw; const float* cb;
    __device__ __forceinline__ void operator()(const f32x4 (&acc)[2][2][4][2], const Unit& u, int wr, int wc, int fr, int fq) const {
        const bool f0 = fr == 0, f15 = fr == 15;
#pragma unroll
        for (int n = 0; n < 2; ++n) {
            const int cg = 128 * u.pn + 32 * wc + 8 * fq + 4 * n;
            f32x4 wg[3], wv[3];
#pragma unroll
            for (int k = 0; k < 3; ++k) { wg[k] = *(const f32x4*)(cw + k * D_UP + cg); wv[k] = *(const f32x4*)(cw + k * D_UP + D_FF + cg); }
            const f32x4 bg = *(const f32x4*)(cb + cg), bv = *(const f32x4*)(cb + D_FF + cg);
#pragma unroll
            for (int ai = 0; ai < 2; ++ai) { const int pbase = 248 * u.pm + 62 * (2 * ai + wr);
                float rpg[4], rpv[4], lcg[4], lcv[4];
#pragma unroll
                for (int j = 0; j < 4; ++j) { rpg[j] = 0.f; rpv[j] = 0.f; lcg[j] = dpp_rol1(acc[ai][0][0][n][j]); lcv[j] = dpp_rol1(acc[ai][1][0][n][j]); }
#pragma unroll
                for (int m = 0; m < 4; ++m) { const int q = 16 * m + fr, pr = pbase + q; const int G = pr - 1 - (pr > 4097 ? 1 : 0);
                    const f32x4 gc = acc[ai][0][m][n], vc = acc[ai][1][m][n]; float o[4];
#pragma unroll
                    for (int j = 0; j < 4; ++j) {
                        const float rg = dpp_ror1(gc[j]), rv = dpp_ror1(vc[j]);
                        const float gp = (m > 0 && f0) ? rpg[j] : rg, vp = (m > 0 && f0) ? rpv[j] : rv;
                        float gn = lcg[j], vn = lcv[j];
                        if (m < 3) { const float a = dpp_rol1(acc[ai][0][m + 1][n][j]), b = dpp_rol1(acc[ai][1][m + 1][n][j]); gn = f15 ? a : gn; vn = f15 ? b : vn; lcg[j] = a; lcv[j] = b; }
                        rpg[j] = rg; rpv[j] = rv;
                        const float ga = __builtin_fmaf(wg[0][j], gp, __builtin_fmaf(wg[1][j], gc[j], __builtin_fmaf(wg[2][j], gn, bg[j])));
                        float va = __builtin_fmaf(wv[2][j], vn, bv[j]); asm volatile("" : "+v"(va));
                        va = __builtin_fmaf(wv[1][j], vc[j], va); asm volatile("" : "+v"(va));
                        va = __builtin_fmaf(wv[0][j], vp, va);
                        o[j] = silu(ga) * va; }
                    if (q >= 1 && q <= 62 && pr >= 1 && pr != 4097 && pr <= 8193) { u32x2 ow; ow.x = cvt_pk_bf16(o[0], o[1]); ow.y = cvt_pk_bf16(o[2], o[3]); *(u32x2*)(ACT + (size_t)G * D_FF + cg) = ow; } } }
        }
    }
};
template <bool RF32, bool FINAL> struct EpiResNorm {
    static constexpr bool PERM = true, CONV = false, AFTER_DRAIN = true; static constexpr int GAPA = 0;
    bf16_t* C; const void* R; int ldc; const float* gain; bf16_t* Hout; float* Fout; float* ssp; unsigned* cnt;
    __device__ __forceinline__ void operator()(f32x4 (&acc)[2][2][4][2], const Unit& u, int wr, int wc, int fr, int fq) const {
        const int row0 = u.pm * BM + wr * 64 + fr, col0 = u.pn * BM + wc * 32 + 8 * fq;
#pragma unroll
        for (int ai = 0; ai < 2; ++ai)
#pragma unroll
            for (int m = 0; m < 4; ++m) { const int row = row0 + ai * HALF + m * 16; const size_t ro = (size_t)row * ldc + col0; float sq = 0.f;
#pragma unroll
                for (int bj = 0; bj < 2; ++bj) { f32x4 r0, r1;
                    if (RF32) { const float* rp = (const float*)R + ro + bj * HALF; r0 = *(const f32x4*)rp; r1 = *(const f32x4*)(rp + 4); }
                    else { const u32x4 rr = *(const u32x4*)((const bf16_t*)R + ro + bj * HALF);
                        r0 = (f32x4){lo_bf(rr.x), hi_bf(rr.x), lo_bf(rr.y), hi_bf(rr.y)}; r1 = (f32x4){lo_bf(rr.z), hi_bf(rr.z), lo_bf(rr.w), hi_bf(rr.w)}; }
                    const f32x4 o0 = acc[ai][bj][m][0] + r0, o1 = acc[ai][bj][m][1] + r1; acc[ai][bj][m][0] = o0; acc[ai][bj][m][1] = o1;
                    sq += o0[0] * o0[0] + o0[1] * o0[1] + o0[2] * o0[2] + o0[3] * o0[3] + o1[0] * o1[0] + o1[1] * o1[1] + o1[2] * o1[2] + o1[3] * o1[3]; }
                sq += __shfl_xor(sq, 16, 64); sq += __shfl_xor(sq, 32, 64);
                if (fq == 0) __hip_atomic_store(ssp + (size_t)row * 32 + u.pn * 4 + wc, sq, __ATOMIC_RELAXED, __HIP_MEMORY_SCOPE_AGENT); }
        asm volatile("s_waitcnt vmcnt(0)" ::: "memory");
        __syncthreads();
        if (threadIdx.x == 0) __hip_atomic_fetch_add(cnt + u.pm, 1u, __ATOMIC_RELAXED, __HIP_MEMORY_SCOPE_AGENT);
        if (!FINAL) {
#pragma unroll
            for (int ai = 0; ai < 2; ++ai)
#pragma unroll
                for (int m = 0; m < 4; ++m) { const size_t ro = (size_t)(row0 + ai * HALF + m * 16) * ldc + col0;
#pragma unroll
                    for (int bj = 0; bj < 2; ++bj) { const f32x4 o0 = acc[ai][bj][m][0], o1 = acc[ai][bj][m][1];
                        u32x4 w; w.x = cvt_pk_bf16(o0[0], o0[1]); w.y = cvt_pk_bf16(o0[2], o0[3]); w.z = cvt_pk_bf16(o1[0], o1[1]); w.w = cvt_pk_bf16(o1[2], o1[3]);
                        *(u32x4*)(C + ro + bj * HALF) = w; } } }
        if (threadIdx.x == 0) {
            unsigned spins = 0;
            while (__hip_atomic_load(cnt + u.pm, __ATOMIC_RELAXED, __HIP_MEMORY_SCOPE_AGENT) < 8u) { __builtin_amdgcn_s_sleep(2); if (++spins > (1u << 22)) break; }
            __builtin_amdgcn_fence(__ATOMIC_ACQUIRE, "agent");
            asm volatile("s_waitcnt vmcnt(0)" ::: "memory");
        }
        __syncthreads();
        f32x4 g0[2], g1[2];
#pragma unroll
        for (int bj = 0; bj < 2; ++bj) { g0[bj] = *(const f32x4*)(gain + col0 + bj * HALF); g1[bj] = *(const f32x4*)(gain + col0 + bj * HALF + 4); }
#pragma unroll
        for (int ai = 0; ai < 2; ++ai)
#pragma unroll
            for (int m = 0; m < 4; ++m) { const int row = row0 + ai * HALF + m * 16; const size_t ro = (size_t)row * ldc + col0;
                const f32x4* q = (const f32x4*)(ssp + (size_t)row * 32 + 8 * fq); const f32x4 a = q[0] + q[1];
                float v = (a[0] + a[1]) + (a[2] + a[3]); v += __shfl_xor(v, 16, 64); v += __shfl_xor(v, 32, 64);
                const float rs = rsqrtf(v * (1.0f / D_MODEL) + 1e-6f);
#pragma unroll
                for (int bj = 0; bj < 2; ++bj) { const f32x4 o0 = acc[ai][bj][m][0], o1 = acc[ai][bj][m][1];
                    const f32x4 y0 = o0 * rs * g0[bj], y1 = o1 * rs * g1[bj];
                    if (FINAL) { float* op = Fout + ro + bj * HALF; *(f32x4*)op = y0; *(f32x4*)(op + 4) = y1; }
                    else { u32x4 w; w.x = cvt_pk_bf16(y0[0], y0[1]); w.y = cvt_pk_bf16(y0[2], y0[3]); w.z = cvt_pk_bf16(y1[0], y1[1]); w.w = cvt_pk_bf16(y1[2], y1[3]);
                        *(u32x4*)(Hout + (size_t)(row + 1 + (row >> 12)) * ldc + col0 + bj * HALF) = w; } } }
    }
};

template <class Epi, class Sched, int KDIM>
__device__ __forceinline__ void gemm_phase(LAS unsigned char* lds, const Gemm g, const Sched& S, const Epi& E) {
    int tid_ = threadIdx.x; asm volatile("" : "+v"(tid_));
    const int tid = tid_, wid = __builtin_amdgcn_readfirstlane(tid >> 6), lane = tid & 63, wr = wid >> 2, wc = wid & 3, fr = lane & 15, fq = lane >> 4;
    constexpr int K = KDIM, nt = K / BK;
    unsigned voffA[2], voffB[2];
#pragma unroll
    for (int i = 0; i < 2; ++i) { int R, C; stage_rc(tid * 16 + i * 8192, R, C); const int Rb = Epi::PERM ? ((R & ~31) + perm32(R & 31)) : R;
        const int Ra = Epi::CONV ? (62 * (R >> 6) + (R & 63)) : R;
        voffA[i] = (unsigned)(Ra * K + C) * 2u; voffB[i] = (unsigned)(Rb * K + C) * 2u; }
    const size_t kstep = (size_t)(BK * 2);
    const size_t hstep = (size_t)HALF * K * 2;
    const size_t tstep = 2 * hstep;
    const size_t hstepA = Epi::CONV ? (size_t)124 * K * 2 : hstep, tstepA = 2 * hstepA;
    const unsigned ldsw = (unsigned)wid * 1024u;
    const int aoff = lds_byte(wr * 64 + fr, fq * 8), boff = lds_byte(wc * 32 + fr, fq * 8);
#define PG8_SA(b, h) (((b) * 2 + (h)) * HTB)
#define PG8_SB(b, h) ((4 + (b) * 2 + (h)) * HTB)
#define PG8_STAGE(bufoff, gbase, voff) do { _Pragma("unroll") for (int _i = 0; _i < 2; ++_i) \
        __builtin_amdgcn_global_load_lds((const unsigned*)((const char*)(gbase) + (voff)[_i]), (LAS unsigned*)(lds + (bufoff) + ldsw + _i * 8192), 16, 0, 0); } while (0)
#define PG8_LDA(dst, b, h) do { _Pragma("unroll") for (int m = 0; m < 4; ++m) _Pragma("unroll") for (int k = 0; k < 2; ++k) dst[m][k] = *(const LAS bf16x8*)(lds + PG8_SA(b, h) + aoff + m * 2048 + k * 1024); } while (0)
#define PG8_LDB(dst, b, h) do { _Pragma("unroll") for (int n = 0; n < 2; ++n) _Pragma("unroll") for (int k = 0; k < 2; ++k) dst[n][k] = *(const LAS bf16x8*)(lds + PG8_SB(b, h) + boff + n * 2048 + k * 1024); } while (0)
#define PG8_MMA(ai, bj, At, Bt) do { __builtin_amdgcn_s_setprio(1); _Pragma("unroll") for (int m = 0; m < 4; ++m) _Pragma("unroll") for (int n = 0; n < 2; ++n) _Pragma("unroll") for (int k = 0; k < 2; ++k) \
        acc[ai][bj][m][n] = __builtin_amdgcn_mfma_f32_16x16x32_bf16(Bt[n][k], At[m][k], acc[ai][bj][m][n], 0, 0, 0); __builtin_amdgcn_s_setprio(0); } while (0)
#define PG8_WAIT_V(n) asm volatile("s_waitcnt vmcnt(" #n ")" ::: "memory")
#define PG8_WAIT_L(n) asm volatile("s_waitcnt lgkmcnt(" #n ")" ::: "memory")
#define PG8_BAR __builtin_amdgcn_s_barrier()
#define PG8_SCHED __builtin_amdgcn_sched_barrier(0)
    Unit cur, nxt; int ui = 0;
    if (!S.next(0, cur)) return;
    f32x4 acc[2][2][4][2];
#pragma unroll
    for (int a = 0; a < 2; ++a)
#pragma unroll
        for (int b = 0; b < 2; ++b)
#pragma unroll
            for (int m = 0; m < 4; ++m)
#pragma unroll
                for (int n = 0; n < 2; ++n) acc[a][b][m][n] = (f32x4){0.f, 0.f, 0.f, 0.f};
    bf16x8 At[4][2], B0[2][2], B1[2][2];
    const char* cA = (const char*)g.A + (size_t)cur.pm * tstepA + (cur.pm >= 16 ? Epi::GAPA : 0); const char* cB = (const char*)g.Bt + (size_t)cur.pn * tstep;
    PG8_STAGE(PG8_SB(0, 0), cB, voffB); PG8_STAGE(PG8_SA(0, 0), cA, voffA); PG8_STAGE(PG8_SB(0, 1), cB + hstep, voffB); PG8_STAGE(PG8_SA(0, 1), cA + hstepA, voffA);
    if (wr == 1) PG8_BAR;
    PG8_WAIT_V(4); PG8_BAR;
    PG8_STAGE(PG8_SB(1, 0), cB + kstep, voffB); PG8_STAGE(PG8_SA(1, 0), cA + kstep, voffA); PG8_STAGE(PG8_SB(1, 1), cB + hstep + kstep, voffB);
    PG8_WAIT_V(6); PG8_BAR;
    for (;;) {
        const bool has_next = S.next(ui + 1, nxt);
        const char* nA = has_next ? (const char*)g.A + (size_t)nxt.pm * tstepA + (nxt.pm >= 16 ? Epi::GAPA : 0) : cA; const char* nB = has_next ? (const char*)g.Bt + (size_t)nxt.pn * tstep : cB;
        for (int t = 0; t < nt; t += 2) {
            const bool last = (t == nt - 2);
            const char* a1 = cA + (size_t)(t + 1) * kstep;
            const char* a2 = last ? nA : cA + (size_t)(t + 2) * kstep; const char* b2 = last ? nB : cB + (size_t)(t + 2) * kstep;
            const char* a3 = a2 + kstep; const char* b3 = b2 + kstep;
            PG8_LDB(B0, 0, 0); PG8_SCHED; PG8_LDA(At, 0, 0); PG8_STAGE(PG8_SA(1, 1), a1 + hstepA, voffA);
            PG8_WAIT_L(8); PG8_BAR; PG8_WAIT_L(0); PG8_MMA(0, 0, At, B0); PG8_BAR; PG8_SCHED;
            PG8_LDB(B1, 0, 1); PG8_STAGE(PG8_SB(0, 0), b2, voffB);
            PG8_BAR; PG8_WAIT_L(0); PG8_MMA(0, 1, At, B1); PG8_BAR;
            PG8_LDA(At, 0, 1); PG8_STAGE(PG8_SA(0, 0), a2, voffA);
            PG8_BAR; PG8_WAIT_L(0); PG8_MMA(1, 0, At, B0); PG8_BAR; PG8_SCHED;
            PG8_STAGE(PG8_SB(0, 1), b2 + hstep, voffB);
            PG8_WAIT_V(6); PG8_BAR; PG8_MMA(1, 1, At, B1); PG8_BAR;
            PG8_LDB(B0, 1, 0); PG8_SCHED; PG8_LDA(At, 1, 0); PG8_STAGE(PG8_SA(0, 1), a2 + hstepA, voffA);
            PG8_WAIT_L(8); PG8_BAR; PG8_WAIT_L(0); PG8_MMA(0, 0, At, B0); PG8_BAR; PG8_SCHED;
            PG8_LDB(B1, 1, 1); PG8_STAGE(PG8_SB(1, 0), b3, voffB);
            PG8_BAR; PG8_WAIT_L(0); PG8_MMA(0, 1, At, B1); PG8_BAR;
            PG8_LDA(At, 1, 1); PG8_STAGE(PG8_SA(1, 0), a3, voffA);
            PG8_BAR; PG8_WAIT_L(0); PG8_MMA(1, 0, At, B0); PG8_BAR; PG8_SCHED;
            PG8_STAGE(PG8_SB(1, 1), b3 + hstep, voffB);
            PG8_WAIT_V(6); PG8_BAR; PG8_MMA(1, 1, At, B1); PG8_BAR;
        }
        if constexpr (!Epi::AFTER_DRAIN) E(acc, cur, wr, wc, fr, fq);
        if (!has_next) break;
#pragma unroll
        for (int a = 0; a < 2; ++a)
#pragma unroll
            for (int b = 0; b < 2; ++b)
#pragma unroll
                for (int m = 0; m < 4; ++m)
#pragma unroll
                    for (int n = 0; n < 2; ++n) acc[a][b][m][n] = (f32x4){0.f, 0.f, 0.f, 0.f};
        cur = nxt; cA = nA; cB = nB; ++ui;
    }
    PG8_WAIT_V(0);
    if (wr == 0) PG8_BAR;
    PG8_BAR;
    if constexpr (Epi::AFTER_DRAIN) E(acc, cur, wr, wc, fr, fq);
#undef PG8_SA
#undef PG8_SB
#undef PG8_STAGE
#undef PG8_LDA
#undef PG8_LDB
#undef PG8_MMA
#undef PG8_WAIT_V
#undef PG8_WAIT_L
#undef PG8_BAR
#undef PG8_SCHED
}
}

__device__ __forceinline__ void convert_tile(const float* __restrict__ W, int K, int N, bf16_t* __restrict__ Wt, int k0, int n0, int orow0, float* tile) {
    const int tid = tid_l();
    { const int r = tid >> 4, c4 = (tid & 15) * 4;
#pragma unroll
      for (int ps = 0; ps < 2; ++ps) { const int rr = r + ps * 32; const float4 v = *(const float4*)(W + (size_t)(k0 + rr) * N + n0 + c4);
          tile[rr * 65 + c4 + 0] = v.x; tile[rr * 65 + c4 + 1] = v.y; tile[rr * 65 + c4 + 2] = v.z; tile[rr * 65 + c4 + 3] = v.w; } }
    __syncthreads();
    { const int n = tid >> 3, k8 = (tid & 7) * 8; float v[8];
#pragma unroll
      for (int j = 0; j < 8; ++j) v[j] = tile[(k8 + j) * 65 + n];
      u32x4 w; w.x = cvt_pk_bf16(v[0], v[1]); w.y = cvt_pk_bf16(v[2], v[3]); w.z = cvt_pk_bf16(v[4], v[5]); w.w = cvt_pk_bf16(v[6], v[7]);
      *(u32x4*)(Wt + (size_t)(orow0 + n) * K + k0 + k8) = w; }
    __syncthreads();
}

constexpr int NI_IN = 32 * 68, NI_OUT = 32 * 32, NI_UP = 32 * 176, NI_DN = 88 * 32, NI_POOL = 16, NI_LAYER = NI_IN + NI_OUT + NI_UP + NI_DN + NI_POOL;
constexpr int NI_FILT = 256;
constexpr int NT3 = 1600;
constexpr int R_OUT = NI_IN, R_UP = NI_IN + NI_OUT, R_DN = NI_IN + NI_OUT + NI_UP, R_POOL = NI_IN + NI_OUT + NI_UP + NI_DN;
__device__ void convert_item(const Params& p, int l, int r, float* lds) {
    if (r < NI_IN) { const int tn = r / 32, tk = r % 32;
        convert_tile(inp(2) + (size_t)l * D_MODEL * D_INP, D_MODEL, D_INP, (bf16_t*)(p.ws + OFF_WT_IN + l * SZ_WT_IN), tk * 64, tn * 64, tn * 64, lds); return; }
    r -= NI_IN;
    if (r < NI_OUT) { const int tn = r / 32, tk = r % 32;
        convert_tile(inp(20) + (size_t)l * D_MODEL * D_MODEL, D_MODEL, D_MODEL, (bf16_t*)(p.ws + OFF_WT_OUT + l * SZ_WT_OUT), tk * 64, tn * 64, tn * 64, lds); return; }
    r -= NI_OUT;
    if (r < NI_UP) { const int tn = r / 32, tk = r % 32; const int n0 = tn * 64, s = n0 / D_FF, rem = n0 % D_FF, j = rem / 128, i = rem % 128;
        convert_tile(inp(22) + (size_t)l * D_MODEL * D_UP, D_MODEL, D_UP, (bf16_t*)(p.ws + OFF_WT_UP + l * SZ_WT_UP), tk * 64, n0, 256 * j + 128 * s + i, lds); return; }
    r -= NI_UP;
    if (r < NI_DN) { const int tn = r / 88, tk = r % 88;
        convert_tile(inp(25) + (size_t)l * D_FF * D_MODEL, D_FF, D_MODEL, (bf16_t*)(p.ws + OFF_WT_DN + l * SZ_WT_DN), tk * 64, tn * 64, tn * 64, lds); return; }
    r -= NI_DN;
    { const int g = r >> 2, tn = (r >> 1) & 1, tk = r & 1;
        convert_tile(inp(3) + (size_t)(l * 4 + g) * 128 * 128, 128, 128, (bf16_t*)(p.ws + OFF_POOLWT + l * SZ_POOLWT) + g * 128 * 128, tk * 64, tn * 64, tn * 64, lds); }
}

__device__ __forceinline__ float sin_rad(float x) { return __builtin_amdgcn_sinf(x * 0.15915494309f); }

struct CvDesc { const float* W; bf16_t* Wt; int K, N, k0, n0, orow0; };
__device__ __forceinline__ CvDesc cv_desc(const Params& p, int l, int r) {
    CvDesc d;
    if (r < R_OUT) { const int tn = r / 32, tk = r % 32; d.W = inp(2) + (size_t)l * D_MODEL * D_INP; d.Wt = (bf16_t*)(p.ws + OFF_WT_IN + l * SZ_WT_IN); d.K = D_MODEL; d.N = D_INP; d.k0 = tk * 64; d.n0 = tn * 64; d.orow0 = tn * 64; }
    else if (r < R_UP) { r -= R_OUT; const int tn = r / 32, tk = r % 32; d.W = inp(20) + (size_t)l * D_MODEL * D_MODEL; d.Wt = (bf16_t*)(p.ws + OFF_WT_OUT + l * SZ_WT_OUT); d.K = D_MODEL; d.N = D_MODEL; d.k0 = tk * 64; d.n0 = tn * 64; d.orow0 = tn * 64; }
    else if (r < R_DN) { r -= R_UP; const int tn = r / 32, tk = r % 32; const int n0 = tn * 64, sg = n0 / D_FF, rem = n0 % D_FF, j = rem / 128, i = rem % 128;
        d.W = inp(22) + (size_t)l * D_MODEL * D_UP; d.Wt = (bf16_t*)(p.ws + OFF_WT_UP + l * SZ_WT_UP); d.K = D_MODEL; d.N = D_UP; d.k0 = tk * 64; d.n0 = n0; d.orow0 = 256 * j + 128 * sg + i; }
    else if (r < R_POOL) { r -= R_DN; const int tn = r / 88, tk = r % 88; d.W = inp(25) + (size_t)l * D_FF * D_MODEL; d.Wt = (bf16_t*)(p.ws + OFF_WT_DN + l * SZ_WT_DN); d.K = D_FF; d.N = D_MODEL; d.k0 = tk * 64; d.n0 = tn * 64; d.orow0 = tn * 64; }
    else { r -= R_POOL; const int g = r >> 2, tn = (r >> 1) & 1, tk = r & 1; d.W = inp(3) + (size_t)(l * 4 + g) * 128 * 128; d.Wt = (bf16_t*)(p.ws + OFF_POOLWT + l * SZ_POOLWT) + g * 128 * 128; d.K = 128; d.N = 128; d.k0 = tk * 64; d.n0 = tn * 64; d.orow0 = tn * 64; }
    return d;
}
__device__ __forceinline__ CvDesc cv_pick(const Params& p, int mode, int l, int base, int i) {
    if (mode == 0) { if (i < R_DN) return cv_desc(p, 0, i); if (i < R_DN + NI_POOL) return cv_desc(p, 0, R_POOL + i - R_DN); return cv_desc(p, 1, R_POOL + i - R_DN - NI_POOL); }
    return cv_desc(p, l, base + i);
}
__device__ __forceinline__ void cv_load(const CvDesc& d, int tid, float4 (&v)[2]) {
    const int r = tid >> 4, c4 = (tid & 15) * 4;
#pragma unroll
    for (int ps = 0; ps < 2; ++ps) v[ps] = *(const float4*)(d.W + (size_t)(d.k0 + r + ps * 32) * d.N + d.n0 + c4);
}
__device__ void convert_range(const Params& p, int mode, int l, int base, int count, int start, int stride, float* tile) {
    int i = start; if (i >= count) return;
    const int tid = tid_l();
    CvDesc d = cv_pick(p, mode, l, base, i); float4 v[2]; cv_load(d, tid, v);
    for (;;) {
        { const int r = tid >> 4, c4 = (tid & 15) * 4;
#pragma unroll
          for (int ps = 0; ps < 2; ++ps) { float* tp = tile + (r + ps * 32) * 65 + c4; tp[0] = v[ps].x; tp[1] = v[ps].y; tp[2] = v[ps].z; tp[3] = v[ps].w; } }
        __syncthreads();
        const int ni = i + stride; const bool more = ni < count; CvDesc dn = d;
        if (more) { dn = cv_pick(p, mode, l, base, ni); cv_load(dn, tid, v); }
        { const int n = tid >> 3, k8 = (tid & 7) * 8; float u[8];
#pragma unroll
          for (int j = 0; j < 8; ++j) u[j] = tile[(k8 + j) * 65 + n];
          u32x4 w; w.x = cvt_pk_bf16(u[0], u[1]); w.y = cvt_pk_bf16(u[2], u[3]); w.z = cvt_pk_bf16(u[4], u[5]); w.w = cvt_pk_bf16(u[6], u[7]);
          *(u32x4*)(d.Wt + (size_t)(d.orow0 + n) * d.K + d.k0 + k8) = w; }
        __syncthreads();
        if (!more) break;
        d = dn; i = ni;
    }
}

__device__ __forceinline__ void cv_load4(const CvDesc& d, int tid, float4 (&v)[8]) {
    const int r = tid >> 4, c4 = (tid & 15) * 4;
#pragma unroll
    for (int ps = 0; ps < 8; ++ps) v[ps] = *(const float4*)(d.W + (size_t)(d.k0 + r + ps * 32) * d.N + d.n0 + c4);
}
__device__ void convert_range4(const Params& p, int l, int base, int count4, int start, int stride, float* tile) {
    int i = start; if (i >= count4) return;
    const int tid = tid_l();
    CvDesc d = cv_desc(p, l, base + 4 * i); float4 v[8]; cv_load4(d, tid, v);
    for (;;) {
        { const int r = tid >> 4, c4 = (tid & 15) * 4;
#pragma unroll
          for (int ps = 0; ps < 8; ++ps) { float* tp = tile + (r + ps * 32) * 65 + c4; tp[0] = v[ps].x; tp[1] = v[ps].y; tp[2] = v[ps].z; tp[3] = v[ps].w; } }
        __syncthreads();
        const int ni = i + stride; const bool more = ni < count4; CvDesc dn = d;
        if (more) { dn = cv_desc(p, l, base + 4 * ni); cv_load4(dn, tid, v); }
        { const int n = tid >> 3, kc = tid & 7;
#pragma unroll
          for (int j = 0; j < 4; ++j) { const int k8 = (kc + 8 * j) * 8; float u[8];
#pragma unroll
              for (int q = 0; q < 8; ++q) u[q] = tile[(k8 + q) * 65 + n];
              u32x4 w; w.x = cvt_pk_bf16(u[0], u[1]); w.y = cvt_pk_bf16(u[2], u[3]); w.z = cvt_pk_bf16(u[4], u[5]); w.w = cvt_pk_bf16(u[6], u[7]);
              *(u32x4*)(d.Wt + (size_t)(d.orow0 + n) * d.K + d.k0 + k8) = w; } }
        __syncthreads();
        if (!more) break;
        d = dn; i = ni;
    }
}

__device__ void filter_item(const Params& p, int item, float* lds) {
    const int l = item >> 7, rem = item & 127, ti = rem >> 1, half = rem & 1;
    const int tid = tid_l(), lane = tid & 63, w = __builtin_amdgcn_readfirstlane(tid >> 6);
    const int t = ti * 64 + lane;
    const float* w1 = inp(8) + l * 33 * 64; const float* b1 = inp(9) + l * 64; const float* fr1 = inp(10) + l * 64;
    const float* w2 = inp(11) + l * 64 * 64; const float* b2 = inp(12) + l * 64; const float* fr2 = inp(13) + l * 64;
    const float* w3 = inp(14) + (size_t)l * 64 * 1536;
    float* h1s = lds; float* h2s = lds + 64 * 65;
    const float tt = (float)t / 4095.0f;
    float a[8];
#pragma unroll
    for (int j = 0; j < 8; ++j) a[j] = b1[8 * w + j] + tt * w1[8 * w + j];
    for (int band = 0; band < 16; ++band) {
        const float f = 1e-4f + (float)band * ((15.0f - 1e-4f) / 15.0f);
        float r = f * (float)t * (1.0f / 4096.0f); r -= floorf(r);
        const float cs = __builtin_amdgcn_cosf(r), sn = -__builtin_amdgcn_sinf(r);
#pragma unroll
        for (int j = 0; j < 8; ++j) a[j] += cs * w1[(1 + band) * 64 + 8 * w + j] + sn * w1[(17 + band) * 64 + 8 * w + j];
    }
#pragma unroll
    for (int j = 0; j < 8; ++j) h1s[lane * 65 + 8 * w + j] = sin_rad(fr1[8 * w + j] * a[j]);
    __syncthreads();
#pragma unroll
    for (int j = 0; j < 8; ++j) a[j] = b2[8 * w + j];
    for (int i = 0; i < 64; ++i) { const float h = h1s[lane * 65 + i];
#pragma unroll
        for (int j = 0; j < 8; ++j) a[j] += h * w2[i * 64 + 8 * w + j]; }
#pragma unroll
    for (int j = 0; j < 8; ++j) h2s[lane * 65 + 8 * w + j] = sin_rad(fr2[8 * w + j] * a[j]);
    __syncthreads();
    float* KT = (float*)(p.ws + OFF_ACT) + (size_t)l * 768 * 8192;
    const float d0 = -3.0701134573f, d1 = -15.3505672865f;
    typedef const __attribute__((address_space(4))) f32x4 cf4;
    for (int ci = 0; ci < 24; ++ci) {
        const int c = w * 96 + ci * 4;
        cf4* wc = (cf4*)(unsigned long long)(w3 + half * 768 + c);
        float o0 = 0.f, o1 = 0.f, o2 = 0.f, o3 = 0.f;
#pragma unroll 8
        for (int i = 0; i < 64; ++i) { const float h = h2s[lane * 65 + i]; const f32x4 wv = wc[i * 384]; o0 += h * wv[0]; o1 += h * wv[1]; o2 += h * wv[2]; o3 += h * wv[3]; }
        float o[4] = {o0, o1, o2, o3};
#pragma unroll
        for (int j = 0; j < 4; ++j) {
            const float delta = d0 + (float)(c + j) * ((d1 - d0) / 767.0f);
            const float val = o[j] * __expf(-tt * fabsf(delta));
            float* kt = KT + (size_t)(c + j) * 8192;
            if (half == 0) kt[t] = val; else { if (t == 0) kt[4096] = 0.f; else kt[8192 - t] = val; }
        }
    }
    __syncthreads();
}

__device__ __forceinline__ int phys(int i) { return i + (i >> 5); }
__device__ __forceinline__ float launder_f(float v) { asm volatile("" : "+v"(v)); return v; }
constexpr int FFT_BUF = 8192 + 256;
__device__ __forceinline__ constexpr float c32(int i) { constexpr float T[16] = {1.0f, 0.98078528040f, 0.92387953251f, 0.83146961230f, 0.70710678119f, 0.55557023302f, 0.38268343237f, 0.19509032202f, 0.0f, -0.19509032202f, -0.38268343237f, -0.55557023302f, -0.70710678119f, -0.83146961230f, -0.92387953251f, -0.98078528040f}; return T[i]; }
__device__ __forceinline__ constexpr float s32(int i) { constexpr float T[16] = {0.0f, 0.19509032202f, 0.38268343237f, 0.55557023302f, 0.70710678119f, 0.83146961230f, 0.92387953251f, 0.98078528040f, 1.0f, 0.98078528040f, 0.92387953251f, 0.83146961230f, 0.70710678119f, 0.55557023302f, 0.38268343237f, 0.19509032202f}; return T[i]; }
template <bool INV> __device__ __forceinline__ void radix16(float2 (&x)[16], float rfrac) {
#pragma unroll
    for (int jj = 0; jj < 4; ++jj) { const int j = INV ? 3 - jj : jj; const int half = 8 >> j;
        const float ab = rfrac * (float)(8 / half); const float cb = __builtin_amdgcn_cosf(ab), sb = __builtin_amdgcn_sinf(ab);
#pragma unroll
        for (int kk = 0; kk < half; ++kk) {
            const int idx = kk * (16 / half);
            float cs, sp;
            if (idx == 0) { cs = cb; sp = sb; }
            else if (idx == 8) { cs = -sb; sp = cb; }
            else { cs = cb * c32(idx) - sb * s32(idx); sp = cb * s32(idx) + sb * c32(idx); }
            const float sn = INV ? sp : -sp;
#pragma unroll
            for (int g = 0; g < 16; g += 2 * half) { const int i0 = g + kk, i1 = i0 + half; const float2 a = x[i0], b = x[i1];
                if (!INV) { const float dx = a.x - b.x, dy = a.y - b.y; x[i0] = make_float2(a.x + b.x, a.y + b.y); x[i1] = make_float2(dx * cs - dy * sn, dx * sn + dy * cs); }
                else { const float bx = b.x * cs - b.y * sn, by = b.x * sn + b.y * cs; x[i0] = make_float2(a.x + bx, a.y + by); x[i1] = make_float2(a.x - bx, a.y - by); } }
        }
    }
}
template <bool INV> __device__ __forceinline__ void radix32(float2 (&y)[32]) {
#pragma unroll
    for (int jj = 0; jj < 5; ++jj) { const int j = INV ? 4 - jj : jj; const int half = 16 >> j;
#pragma unroll
        for (int kk = 0; kk < half; ++kk) { const int idx = kk * (16 / half); const float cs = c32(idx), sn = INV ? s32(idx) : -s32(idx);
#pragma unroll
            for (int g = 0; g < 32; g += 2 * half) { const int i0 = g + kk, i1 = i0 + half; const float2 a = y[i0], b = y[i1];
                if (!INV) { const float dx = a.x - b.x, dy = a.y - b.y; y[i0] = make_float2(a.x + b.x, a.y + b.y);
                    if (idx == 0) y[i1] = make_float2(dx, dy);
                    else if (idx == 8) y[i1] = make_float2(dy, -dx);
                    else y[i1] = make_float2(dx * cs - dy * sn, dx * sn + dy * cs); }
                else { float bx, by;
                    if (idx == 0) { bx = b.x; by = b.y; }
                    else if (idx == 8) { bx = -b.y; by = b.x; }
                    else { bx = b.x * cs - b.y * sn; by = b.x * sn + b.y * cs; }
                    y[i0] = make_float2(a.x + bx, a.y + by); y[i1] = make_float2(a.x - bx, a.y - by); } }
        }
    }
}
template <bool INV> __device__ __forceinline__ void fft_pass2(float2* B, int tid, float rfr) {
    const int blk = tid >> 5, r = tid & 31; float2 x[16]; float2* b = B + blk * 528 + r;
#pragma unroll
    for (int k = 0; k < 16; ++k) x[k] = b[33 * k];
    radix16<INV>(x, rfr);
#pragma unroll
    for (int k = 0; k < 16; ++k) b[33 * k] = x[k];
}

__device__ void kf_item(const Params& p, int item, unsigned char* smem) {
    const int l = item / 384, cp = item % 384, c0 = 2 * cp;
    const int tid = tid_l();
    float2* B0 = (float2*)smem; float2* B1 = B0 + FFT_BUF;
    const float* KT = (const float*)(p.ws + OFF_ACT) + ((size_t)l * 768 + c0) * 8192 + tid;
    float2 x0[16], x1[16];
#pragma unroll
    for (int k = 0; k < 16; ++k) { x0[k] = make_float2(KT[512 * k], 0.f); x1[k] = make_float2(KT[8192 + 512 * k], 0.f); }
    const float rf = (float)tid * (1.0f / 8192.0f);
    radix16<false>(x0, rf); radix16<false>(x1, rf);
#pragma unroll
    for (int k = 0; k < 16; ++k) { B0[phys(tid + 512 * k)] = x0[k]; B1[phys(tid + 512 * k)] = x1[k]; }
    __syncthreads();
    { const float r2 = launder_f((float)(tid & 31) * (1.0f / 512.0f)); fft_pass2<false>(B0, tid, r2); fft_pass2<false>(B1, tid, r2); }
    __syncthreads();
    { const int blk = tid & 255, ch = tid >> 8; float2* B = ch ? B1 : B0; float2 y[32];
#pragma unroll
      for (int k = 0; k < 32; ++k) y[k] = B[blk * 33 + k];
      radix32<false>(y);
      float2* KF = (float2*)(p.ws + OFF_KF) + ((size_t)l * 768 + c0 + ch) * 8192 + blk * 2; const float sc = 1.0f / 8192.0f;
#pragma unroll
      for (int k = 0; k < 32; k += 2) *(float4*)(KF + (k >> 1) * 512) = make_float4(y[k].x * sc, y[k].y * sc, y[k + 1].x * sc, y[k + 1].y * sc); }
    __syncthreads();
}

template <bool XF32> __device__ void norm_phase(const void* __restrict__ xin, const float* __restrict__ g, bf16_t* hb, float* hf) {
    const int tid = tid_l(); const int lane = tid & 63; const int gw = blockIdx.x * 8 + (tid >> 6), nw = gridDim.x * 8;
    for (int row = gw; row < NTOK; row += nw) {
        float v[4][8]; float ss = 0.f;
#pragma unroll
        for (int i = 0; i < 4; ++i) { const size_t o = (size_t)row * D_MODEL + i * 512 + lane * 8;
            if (XF32) { const float4 a = *(const float4*)((const float*)xin + o), b = *(const float4*)((const float*)xin + o + 4);
                v[i][0] = a.x; v[i][1] = a.y; v[i][2] = a.z; v[i][3] = a.w; v[i][4] = b.x; v[i][5] = b.y; v[i][6] = b.z; v[i][7] = b.w; }
            else { const u32x4 u = *(const u32x4*)((const bf16_t*)xin + o);
                v[i][0] = lo_bf(u.x); v[i][1] = hi_bf(u.x); v[i][2] = lo_bf(u.y); v[i][3] = hi_bf(u.y); v[i][4] = lo_bf(u.z); v[i][5] = hi_bf(u.z); v[i][6] = lo_bf(u.w); v[i][7] = hi_bf(u.w); }
#pragma unroll
            for (int j = 0; j < 8; ++j) ss += v[i][j] * v[i][j]; }
        ss = wave_sum(ss);
        const float rs = rsqrtf(ss * (1.0f / D_MODEL) + 1e-6f);
#pragma unroll
        for (int i = 0; i < 4; ++i) { const int c = i * 512 + lane * 8; const float4 ga = *(const float4*)(g + c), gb = *(const float4*)(g + c + 4);
            const float y0 = v[i][0] * rs * ga.x, y1 = v[i][1] * rs * ga.y, y2 = v[i][2] * rs * ga.z, y3 = v[i][3] * rs * ga.w, y4 = v[i][4] * rs * gb.x, y5 = v[i][5] * rs * gb.y, y6 = v[i][6] * rs * gb.z, y7 = v[i][7] * rs * gb.w;
            if (hb) { u32x4 w; w.x = cvt_pk_bf16(y0, y1); w.y = cvt_pk_bf16(y2, y3); w.z = cvt_pk_bf16(y4, y5); w.w = cvt_pk_bf16(y6, y7); *(u32x4*)(hb + (size_t)(row + 1 + (row >> 12)) * D_MODEL + c) = w; }
            else { float* op = hf + (size_t)row * D_MODEL + c; *(float4*)op = make_float4(y0, y1, y2, y3); *(float4*)(op + 4) = make_float4(y4, y5, y6, y7); } }
    }
}

__device__ void pool_item(const Params& p, int l, int item, unsigned char* smem) {
    const int tt = item >> 2, g = item & 3;
    const int tid = tid_l(), lane = tid & 63, w = tid >> 6, fr = lane & 15, fq = lane >> 4;
    const bf16_t* P = (const bf16_t*)(p.ws + OFF_P); bf16_t* MIX = (bf16_t*)(p.ws + OFF_MIX);
    const int row0 = tt * 128, b0 = (row0 / SEQ) * SEQ;
    float* X = (float*)smem;
    bf16_t* A = (bf16_t*)(smem + 144 * 129 * 4);
    for (int idx = tid; idx < 144 * 16; idx += 512) { const int r = idx >> 4, c8 = (idx & 15) * 8; const int row = row0 - 8 + r;
        u32x4 v = (u32x4){0u, 0u, 0u, 0u};
        if (row >= b0 && row < b0 + SEQ) v = *(const u32x4*)(P + (size_t)row * D_INP + g * 128 + c8);
        float* xp = X + r * 129 + c8;
        xp[0] = lo_bf(v.x); xp[1] = hi_bf(v.x); xp[2] = lo_bf(v.y); xp[3] = hi_bf(v.y); xp[4] = lo_bf(v.z); xp[5] = hi_bf(v.z); xp[6] = lo_bf(v.w); xp[7] = hi_bf(v.w); }
    __syncthreads();
    { const int c = tid & 127, tq = tid >> 7; const int hw = 1 << g;
      const float* xc = X + (tq * 32 + 8) * 129 + c;
      float s = 0.f;
      for (int q = -hw; q < hw; ++q) s += xc[q * 129];
      const int tb = row0 + tq * 32 - b0;
#pragma unroll 8
      for (int i = 0; i < 32; ++i) { const int t = tb + i; const int lo = max(t - hw, 0), hi = min(t + hw - 1, SEQ - 1);
          const float d = s * __builtin_amdgcn_rcpf((float)(hi - lo + 1)) - xc[i * 129];
          A[(tq * 32 + i) * 136 + c] = (bf16_t)(cvt_pk_bf16(d, 0.f) & 0xffffu);
          s += xc[(i + hw) * 129] - xc[(i - hw) * 129]; } }
    __syncthreads();
    const bf16_t* Wt = (const bf16_t*)(p.ws + OFF_POOLWT + l * SZ_POOLWT) + g * 128 * 128;
    f32x4 acc[8];
#pragma unroll
    for (int nb = 0; nb < 8; ++nb) acc[nb] = (f32x4){0.f, 0.f, 0.f, 0.f};
#pragma unroll
    for (int ks = 0; ks < 4; ++ks) {
        const bf16x8 af = *(const bf16x8*)(A + (16 * w + fr) * 136 + ks * 32 + fq * 8);
#pragma unroll
        for (int nb = 0; nb < 8; ++nb) { const bf16x8 bfr = *(const bf16x8*)(Wt + (nb * 16 + fr) * 128 + ks * 32 + fq * 8);
            acc[nb] = __builtin_amdgcn_mfma_f32_16x16x32_bf16(bfr, af, acc[nb], 0, 0, 0); }
    }
    const float* pb = inp(4) + l * 512 + g * 128; const float* psc = inp(5) + l * 512 + g * 128;
    const int row = row0 + 16 * w + fr;
#pragma unroll
    for (int nb = 0; nb < 8; ++nb) { const int d = nb * 16 + 4 * fq; const float4 bb = *(const float4*)(pb + d), sc = *(const float4*)(psc + d);
        u32x2 o; o.x = cvt_pk_bf16((acc[nb][0] + bb.x) * sc.x, (acc[nb][1] + bb.y) * sc.y); o.y = cvt_pk_bf16((acc[nb][2] + bb.z) * sc.z, (acc[nb][3] + bb.w) * sc.w);
        *(u32x2*)(MIX + (size_t)row * D_MODEL + g * 128 + d) = o; }
    __syncthreads();
}

__device__ void hypre_item(const Params& p, int l, int item, unsigned char* smem) {
    const int tt = item / 6, ct = item % 6; const int tid = tid_l();
    const bf16_t* P = (const bf16_t*)(p.ws + OFF_P); float* ZT = (float*)(p.ws + OFF_ZT); float* X0T = (float*)(p.ws + OFF_X0T);
    const float* sw = inp(6) + (size_t)l * 3 * 2304; const float* sb = inp(7) + (size_t)l * 2304;
    float* zt = (float*)smem;
    float* xt = zt + 128 * 65;
    const int row0 = tt * 64;
    { const int cpq = tid & 63, tr = tid >> 6; const int ch = ct * 128 + 2 * cpq;
      float w[3][3][2], bb[3][2];
#pragma unroll
      for (int s3 = 0; s3 < 3; ++s3) {
#pragma unroll
          for (int k = 0; k < 3; ++k) { const float2 v = *(const float2*)(sw + k * 2304 + s3 * 768 + ch); w[s3][k][0] = v.x; w[s3][k][1] = v.y; }
          const float2 v = *(const float2*)(sb + s3 * 768 + ch); bb[s3][0] = v.x; bb[s3][1] = v.y; }
      const int r0 = row0 + tr * 8; const bf16_t* pr = P + (size_t)r0 * D_INP + COL_HY + ch;
      unsigned pm[3], pc[3], pn[3];
#pragma unroll
      for (int s3 = 0; s3 < 3; ++s3) { pm[s3] = ((r0 & (SEQ - 1)) != 0) ? *(const unsigned*)(pr - D_INP + s3 * 768) : 0u; pc[s3] = *(const unsigned*)(pr + s3 * 768); }
#pragma unroll
      for (int i = 0; i < 8; ++i) { const int row = r0 + i;
#pragma unroll
          for (int s3 = 0; s3 < 3; ++s3) pn[s3] = ((row & (SEQ - 1)) != SEQ - 1) ? *(const unsigned*)(pr + (size_t)(i + 1) * D_INP + s3 * 768) : 0u;
          float o[3][2];
#pragma unroll
          for (int s3 = 0; s3 < 3; ++s3) { o[s3][0] = w[s3][0][0] * lo_bf(pm[s3]) + w[s3][1][0] * lo_bf(pc[s3]) + w[s3][2][0] * lo_bf(pn[s3]) + bb[s3][0];
                                           o[s3][1] = w[s3][0][1] * hi_bf(pm[s3]) + w[s3][1][1] * hi_bf(pc[s3]) + w[s3][2][1] * hi_bf(pn[s3]) + bb[s3][1]; }
          const int tl = tr * 8 + i;
          zt[(2 * cpq) * 65 + tl] = o[1][0] * o[2][0]; zt[(2 * cpq + 1) * 65 + tl] = o[1][1] * o[2][1];
          xt[(2 * cpq) * 65 + tl] = o[0][0]; xt[(2 * cpq + 1) * 65 + tl] = o[0][1];
#pragma unroll
          for (int s3 = 0; s3 < 3; ++s3) { pm[s3] = pc[s3]; pc[s3] = pn[s3]; } } }
    __syncthreads();
    { const int tl = tid & 63, cr = tid >> 6; const int row = row0 + tl, b = row >> 12, t = row & (SEQ - 1);
#pragma unroll
      for (int i = 0; i < 16; ++i) { const int c = cr * 16 + i; const size_t o = (size_t)(ct * 128 + c) * 8192 + b * 4096 + t; ZT[o] = zt[c * 65 + tl]; X0T[o] = xt[c * 65 + tl]; } }
    __syncthreads();
}

constexpr int GM_NH = 3;
__device__ void gmlp_item(const Params& p, int l, int item, unsigned char* smem) {
    const int n = item / (6 / GM_NH), e0 = (item % (6 / GM_NH)) * GM_NH;
    const int tid = tid_l(), lane = tid & 63, w = tid >> 6, fr = lane & 15, fq = lane >> 4;
    const bf16_t* P = (const bf16_t*)(p.ws + OFF_P); bf16_t* MIX = (bf16_t*)(p.ws + OFF_MIX);
    const float* stats = (const float*)(p.ws + OFF_STATS) + (size_t)l * NTOK * 24;
    const float* lng = inp(16) + l * 768; const float* lnb = inp(17) + l * 768;
    bf16_t* VT = (bf16_t*)smem;
    const int t0 = n * 128;
    const int q = 16 * w + fr; const size_t qrow = (size_t)(t0 + q);
    float g0[GM_NH], g1[GM_NH], be0[GM_NH], be1[GM_NH], bq[GM_NH]; u32x2 uu[GM_NH][8]; bf16x8 wf[GM_NH][4];
#pragma unroll
    for (int h = 0; h < GM_NH; ++h) { const int e = e0 + h;
        g0[h] = lng[e * 128 + lane]; g1[h] = lng[e * 128 + 64 + lane]; be0[h] = lnb[e * 128 + lane]; be1[h] = lnb[e * 128 + 64 + lane];
        bq[h] = (inp(19) + (l * 6 + e) * 128)[q];
#pragma unroll
        for (int cb = 0; cb < 8; ++cb) uu[h][cb] = *(const u32x2*)(P + qrow * D_INP + COL_GM + e * 128 + cb * 16 + 4 * fq);
        const float* ws_ = inp(18) + (size_t)(l * 6 + e) * 128 * 128;
#pragma unroll
        for (int ks = 0; ks < 4; ++ks) { const float* wp = ws_ + (16 * w + fr) * 128 + ks * 32 + fq * 8; const float4 a = *(const float4*)wp, b = *(const float4*)(wp + 4);
            u32x4 t; t.x = cvt_pk_bf16(a.x, a.y); t.y = cvt_pk_bf16(a.z, a.w); t.z = cvt_pk_bf16(b.x, b.y); t.w = cvt_pk_bf16(b.z, b.w); wf[h][ks] = __builtin_bit_cast(bf16x8, t); } }
#pragma unroll
    for (int i = 0; i < 16; ++i) { const int pl = 16 * w + i; const size_t row = (size_t)(t0 + pl); const bf16_t* pr = P + row * D_INP + COL_GM + 768 + e0 * 128;
        float2 st; { const f32x4* sp = (const f32x4*)(stats + row * 24); f32x4 a = sp[0];
#pragma unroll
          for (int k = 1; k < 6; ++k) a += sp[k];
          st = make_float2(a[0] + a[2], a[1] + a[3]); }
        const float mean = st.x * (1.0f / 768.0f); const float rstd = rsqrtf(fmaxf(st.y * (1.0f / 768.0f) - mean * mean, 0.f) + 1e-5f);
#pragma unroll
        for (int h = 0; h < GM_NH; ++h) {
            const float y0 = (bf2f(pr[h * 128 + lane]) - mean) * rstd * g0[h] + be0[h], y1 = (bf2f(pr[h * 128 + 64 + lane]) - mean) * rstd * g1[h] + be1[h];
            const unsigned pk = cvt_pk_bf16(y0, y1);
            VT[(h * 128 + lane) * 132 + pl] = (bf16_t)(pk & 0xffffu); VT[(h * 128 + 64 + lane) * 132 + pl] = (bf16_t)(pk >> 16); } }
    __syncthreads();
#pragma unroll
    for (int h = 0; h < GM_NH; ++h) { const int e = e0 + h;
        f32x4 acc[8];
#pragma unroll
        for (int cb = 0; cb < 8; ++cb) acc[cb] = (f32x4){0.f, 0.f, 0.f, 0.f};
#pragma unroll
        for (int ks = 0; ks < 4; ++ks)
#pragma unroll
            for (int cb = 0; cb < 8; ++cb) { const bf16_t* vp = VT + (h * 128 + cb * 16 + fr) * 132 + ks * 32 + fq * 8; const u32x2 lo = *(const u32x2*)vp, hi = *(const u32x2*)(vp + 4);
                u32x4 t; t.x = lo.x; t.y = lo.y; t.z = hi.x; t.w = hi.y;
                acc[cb] = __builtin_amdgcn_mfma_f32_16x16x32_bf16(__builtin_bit_cast(bf16x8, t), wf[h][ks], acc[cb], 0, 0, 0); }
#pragma unroll
        for (int cb = 0; cb < 8; ++cb) { const int c = cb * 16 + 4 * fq;
            const float u0 = lo_bf(uu[h][cb].x), u1 = hi_bf(uu[h][cb].x), u2 = lo_bf(uu[h][cb].y), u3 = hi_bf(uu[h][cb].y);
            u32x2 o; o.x = cvt_pk_bf16(u0 * (acc[cb][0] + bq[h]), u1 * (acc[cb][1] + bq[h])); o.y = cvt_pk_bf16(u2 * (acc[cb][2] + bq[h]), u3 * (acc[cb][3] + bq[h]));
            *(u32x2*)(MIX + qrow * D_MODEL + MIX_GM + e * 128 + c) = o; } }
    __syncthreads();
}

__device__ void fft_item(const Params& p, int l, int cp, unsigned char* smem) {
    const int tid = tid_l(); const int c0 = 2 * cp;
    float2* B0 = (float2*)smem;
    const float* ZT = (const float*)(p.ws + OFF_ZT) + (size_t)c0 * 8192; const float* X0T = (const float*)(p.ws + OFF_X0T) + (size_t)c0 * 8192;
    const float rf = (float)tid * (1.0f / 8192.0f);
#pragma unroll
    for (int ch = 0; ch < 2; ++ch) { float2 x[16]; float2* B = B0 + ch * FFT_BUF; const float* z = ZT + ch * 8192 + tid;
#pragma unroll
        for (int k = 0; k < 8; ++k) { x[k] = make_float2(z[512 * k], z[4096 + 512 * k]); x[k + 8] = make_float2(0.f, 0.f); }
        radix16<false>(x, rf);
#pragma unroll
        for (int k = 0; k < 16; ++k) B[phys(tid + 512 * k)] = x[k]; }
    __syncthreads();
    { const float r2 = launder_f((float)(tid & 31) * (1.0f / 512.0f));
#pragma unroll
      for (int ch = 0; ch < 2; ++ch) fft_pass2<false>(B0 + ch * FFT_BUF, tid, r2); }
    __syncthreads();
    { const int blk = tid & 255, ch = tid >> 8; float2* B = B0 + ch * FFT_BUF + blk * 33; float2 y[32];
#pragma unroll
      for (int k = 0; k < 32; ++k) y[k] = B[k];
      radix32<false>(y);
      const float2* KF = (const float2*)(p.ws + OFF_KF) + ((size_t)l * 768 + c0 + ch) * 8192 + blk * 2;
#pragma unroll
      for (int k = 0; k < 32; k += 2) { const float4 kq = *(const float4*)(KF + (k >> 1) * 512);
          y[k] = make_float2(y[k].x * kq.x - y[k].y * kq.y, y[k].x * kq.y + y[k].y * kq.x); y[k + 1] = make_float2(y[k + 1].x * kq.z - y[k + 1].y * kq.w, y[k + 1].x * kq.w + y[k + 1].y * kq.z); }
      radix32<true>(y);
#pragma unroll
      for (int k = 0; k < 32; ++k) B[k] = y[k]; }
    __syncthreads();
    { const float r2 = launder_f((float)(tid & 31) * (1.0f / 512.0f));
#pragma unroll
      for (int ch = 0; ch < 2; ++ch) fft_pass2<true>(B0 + ch * FFT_BUF, tid, r2); }
    __syncthreads();
    bf16_t* MIX = (bf16_t*)(p.ws + OFF_MIX);
    const float2 dsk = *(const float2*)(inp(15) + l * 768 + c0);
    const float rfi = launder_f(rf);
    { unsigned long long zp = (unsigned long long)ZT; asm volatile("" : "+s"(zp)); ZT = (const float*)zp; }
#pragma unroll 1
    for (int ch = 0; ch < 2; ++ch) { float2 x[16]; float2* B = B0 + ch * FFT_BUF;
#pragma unroll
        for (int k = 0; k < 16; ++k) x[k] = B[phys(tid + 512 * k)];
        radix16<true>(x, rfi);
        const float d = ch ? dsk.y : dsk.x; const float* z = ZT + ch * 8192 + tid; const float* x0 = X0T + ch * 8192 + tid;
        if (ch == 0) {
#pragma unroll
            for (int k = 0; k < 8; ++k) B0[phys(tid + 512 * k)] = make_float2(x0[512 * k] * (x[k].x + d * z[512 * k]), x0[4096 + 512 * k] * (x[k].y + d * z[4096 + 512 * k]));
        } else {
#pragma unroll
            for (int k = 0; k < 8; ++k) { const int t = tid + 512 * k; const float2 r0 = B0[phys(t)];
                const float r1a = x0[512 * k] * (x[k].x + d * z[512 * k]), r1b = x0[4096 + 512 * k] * (x[k].y + d * z[4096 + 512 * k]);
                *(unsigned*)(MIX + (size_t)t * D_MODEL + MIX_HY + c0) = cvt_pk_bf16(r0.x, r1a);
                *(unsigned*)(MIX + (size_t)(4096 + t) * D_MODEL + MIX_HY + c0) = cvt_pk_bf16(r0.y, r1b); }
        } }
    __syncthreads();
}

__device__ void convact_phase(const Params& p, int l) {
    const bf16_t* UP = (const bf16_t*)(p.ws + OFF_UP); bf16_t* ACT = (bf16_t*)(p.ws + OFF_ACT);
    const float* cw = inp(23) + (size_t)l * 3 * D_UP; const float* cb = inp(24) + (size_t)l * D_UP;
    const int nthr = gridDim.x * 512;
    const int tid = tid_l();
    for (int idx = blockIdx.x * 512 + tid; idx < 704 * 512; idx += nthr) {
        const int cg8 = idx % 704, run = idx / 704; const int j = cg8 >> 4, i8 = (cg8 & 15) * 8;
        const int ncol = j * 128 + i8;
        float wg[3][8], wv[3][8], bg[8], bv[8];
#pragma unroll
        for (int k = 0; k < 3; ++k) { const float4 a = *(const float4*)(cw + k * D_UP + ncol), b = *(const float4*)(cw + k * D_UP + ncol + 4);
            wg[k][0] = a.x; wg[k][1] = a.y; wg[k][2] = a.z; wg[k][3] = a.w; wg[k][4] = b.x; wg[k][5] = b.y; wg[k][6] = b.z; wg[k][7] = b.w;
            const float4 c = *(const float4*)(cw + k * D_UP + D_FF + ncol), d = *(const float4*)(cw + k * D_UP + D_FF + ncol + 4);
            wv[k][0] = c.x; wv[k][1] = c.y; wv[k][2] = c.z; wv[k][3] = c.w; wv[k][4] = d.x; wv[k][5] = d.y; wv[k][6] = d.z; wv[k][7] = d.w; }
        { const float4 a = *(const float4*)(cb + ncol), b = *(const float4*)(cb + ncol + 4); bg[0] = a.x; bg[1] = a.y; bg[2] = a.z; bg[3] = a.w; bg[4] = b.x; bg[5] = b.y; bg[6] = b.z; bg[7] = b.w;
          const float4 c = *(const float4*)(cb + D_FF + ncol), d = *(const float4*)(cb + D_FF + ncol + 4); bv[0] = c.x; bv[1] = c.y; bv[2] = c.z; bv[3] = c.w; bv[4] = d.x; bv[5] = d.y; bv[6] = d.z; bv[7] = d.w; }
        const int r0 = run * 16; const size_t colg = (size_t)j * 256 + i8, colv = colg + 128;
        u32x4 gm = (u32x4){0u, 0u, 0u, 0u}, vm = gm, gc, vc, gn, vn;
        if ((r0 & (SEQ - 1)) != 0) { gm = *(const u32x4*)(UP + (size_t)(r0 - 1) * D_UP + colg); vm = *(const u32x4*)(UP + (size_t)(r0 - 1) * D_UP + colv); }
        gc = *(const u32x4*)(UP + (size_t)r0 * D_UP + colg); vc = *(const u32x4*)(UP + (size_t)r0 * D_UP + colv);
        for (int r = r0; r < r0 + 16; ++r) {
            if ((r & (SEQ - 1)) != SEQ - 1) { gn = *(const u32x4*)(UP + (size_t)(r + 1) * D_UP + colg); vn = *(const u32x4*)(UP + (size_t)(r + 1) * D_UP + colv); }
            else { gn = (u32x4){0u, 0u, 0u, 0u}; vn = gn; }
            float o[8];
#pragma unroll
            for (int q = 0; q < 4; ++q) {
                const float ga = wg[0][2 * q] * lo_bf(gm[q]) + wg[1][2 * q] * lo_bf(gc[q]) + wg[2][2 * q] * lo_bf(gn[q]) + bg[2 * q];
                const float gb = wg[0][2 * q + 1] * hi_bf(gm[q]) + wg[1][2 * q + 1] * hi_bf(gc[q]) + wg[2][2 * q + 1] * hi_bf(gn[q]) + bg[2 * q + 1];
                const float va = wv[0][2 * q] * lo_bf(vm[q]) + wv[1][2 * q] * lo_bf(vc[q]) + wv[2][2 * q] * lo_bf(vn[q]) + bv[2 * q];
                const float vb = wv[0][2 * q + 1] * hi_bf(vm[q]) + wv[1][2 * q + 1] * hi_bf(vc[q]) + wv[2][2 * q + 1] * hi_bf(vn[q]) + bv[2 * q + 1];
                o[2 * q] = silu(ga) * va; o[2 * q + 1] = silu(gb) * vb; }
            u32x4 ow; ow.x = cvt_pk_bf16(o[0], o[1]); ow.y = cvt_pk_bf16(o[2], o[3]); ow.z = cvt_pk_bf16(o[4], o[5]); ow.w = cvt_pk_bf16(o[6], o[7]);
            *(u32x4*)(ACT + (size_t)r * D_FF + ncol) = ow;
            gm = gc; vm = vc; gc = gn; vc = vn;
        }
    }
}

__global__ void __launch_bounds__(512, 2) fwd_megakernel(Params p) {
    extern __shared__ __attribute__((aligned(16))) unsigned char smem[];
    cg::grid_group grid = cg::this_grid();
    const int G = gridDim.x, bid = blockIdx.x;
    int step = 0;
    if (p.ph_hi < 0) grid.sync();
    volatile LAS unsigned* xst = (volatile LAS unsigned*)(LAS unsigned char*)(smem + LDS_BYTES - 16);
    if (threadIdx.x < 4) xst[threadIdx.x] = 0u;
    __syncthreads();
    XcdBarrier xb = xcd_barrier_post((unsigned*)(p.ws + OFF_BAR), xst);
#define STEP_BEGIN if (step >= p.ph_lo && step < p.ph_hi) {
#define STEP_END } ++step; if (step > p.ph_lo && step < p.ph_hi) xcd_barrier(xb);

    bf16_t* H = (bf16_t*)(p.ws + OFF_H);
    bf16_t* XA = (bf16_t*)(p.ws + OFF_XA);
#if PROBE == 6
    for (int i = 0; i < 20; ++i) xcd_barrier(xb);
#endif

    STEP_BEGIN
        for (int it = bid; it < NI_FILT; it += G) filter_item(p, it, (float*)smem);
        convert_range4(p, 0, 0, NI_IN / 4, bid, G, (float*)smem);
        convert_range(p, 1, 0, R_POOL, NI_POOL, bid, G, (float*)smem); convert_range(p, 1, 1, R_POOL, NI_POOL, bid, G, (float*)smem);
        if (bid < 3) { const int zr = bid == 0 ? 0 : (bid == 1 ? 4097 : 8194); for (int i = tid_l(); i < D_MODEL / 2; i += 512) ((unsigned*)(H + (size_t)zr * D_MODEL))[i] = 0u; }
        norm_phase<true>(inp(0), inp(1), H, nullptr);
    STEP_END

    for (int l = 0; l < 2; ++l) {
        STEP_BEGIN
            pg8::Gemm g{H + D_MODEL, (const bf16_t*)(p.ws + OFF_WT_IN + l * SZ_WT_IN), NTOK, D_INP, D_MODEL}; pg8::StaticOrder S; S.init(NTOK, D_INP, G, bid);
            pg8::EpiBf16Gm E{(bf16_t*)(p.ws + OFF_P), D_INP, (float*)(p.ws + OFF_STATS) + (size_t)l * NTOK * 24};
            pg8::gemm_phase<pg8::EpiBf16Gm, pg8::StaticOrder, D_MODEL>((LAS unsigned char*)smem, g, S, E);
            { const int rem = (NTOK / 256) * (D_INP / 256) % G;
              if (bid >= rem) for (int rep_ = 0; rep_ < (PROBE == 11 ? 2 : 1); ++rep_) {
                  if (l == 0) { for (int it = bid - rem; it < 768; it += G - rem) kf_item(p, it, smem); convert_range4(p, 1, 0, NI_IN / 4, bid - rem, G - rem, (float*)smem); convert_range4(p, 0, R_DN + NT3, (NI_DN - NT3) / 4, bid - rem, G - rem, (float*)smem); }
                  else { convert_range4(p, 1, R_OUT, (NI_OUT + NI_UP) / 4, bid - rem, G - rem, (float*)smem); convert_range4(p, 1, R_DN + NT3, (NI_DN - NT3) / 4, bid - rem, G - rem, (float*)smem); } } }
        STEP_END
        STEP_BEGIN
            for (int it = bid; it < 768; it += G) hypre_item(p, l, it, smem);
        STEP_END
        STEP_BEGIN
            for (int rep_ = 0; rep_ < (PROBE == 13 ? 2 : 1); ++rep_) {
            unsigned* wq = (unsigned*)(p.ws + OFF_BAR) + 3500 + l + 8 * rep_;
            for (;;) {
                __syncthreads();
                if (threadIdx.x == 0) xst[2] = atomicAdd(wq, 1u);
                __syncthreads();
                const int it = __builtin_amdgcn_readfirstlane((int)xst[2]);
                constexpr int NCH = (NI_OUT + NI_UP) / 8, NMIX = 384 + 128 + 256;
                int mi = it, ch = -1;
                if (l == 0) { if (it < 2 * NMIX) { if (it & 1) { ch = it >> 1; mi = -1; } else mi = it >> 1; } else { ch = NMIX + (it - 2 * NMIX); mi = -1; } }
                if (l == 0 ? it >= NMIX + NCH : it >= NMIX) break;
                if (ch >= 0) { if (ch < NCH) convert_range4(p, 0, R_OUT + ch * 8, 2, 0, 1, (float*)smem); }
                else if (mi < 384) fft_item(p, l, mi, smem); else if (mi < 512) gmlp_item(p, l, mi - 384, smem); else pool_item(p, l, mi - 512, smem);
            }
            }
#if PROBE == 21
            for (int it = bid; it < 256; it += G) pool_item(p, l, it, smem);
#elif PROBE == 22
            for (int it = bid; it < 128; it += G) gmlp_item(p, l, it, smem);
#elif PROBE == 3
            for (int it = bid; it < 384; it += G) fft_item(p, l, it, smem);
#endif
        STEP_END
        STEP_BEGIN
            pg8::Gemm g{(const bf16_t*)(p.ws + OFF_MIX), (const bf16_t*)(p.ws + OFF_WT_OUT + l * SZ_WT_OUT), NTOK, D_MODEL, D_MODEL}; pg8::StaticOrder S; S.init(NTOK, D_MODEL, G, bid); S.wgm = 4;
            float* ssp = (float*)(p.ws + OFF_SSP) + (size_t)(2 * l) * NTOK * 32; unsigned* pc = (unsigned*)(p.ws + OFF_BAR) + 3600 + 64 * l;
            if (l == 0) { pg8::EpiResNorm<true, false> E{XA, inp(0), D_MODEL, inp(21) + l * D_MODEL, H, nullptr, ssp, pc}; pg8::gemm_phase<pg8::EpiResNorm<true, false>, pg8::StaticOrder, D_MODEL>((LAS unsigned char*)smem, g, S, E); }
            else { pg8::EpiResNorm<false, false> E{XA, XA, D_MODEL, inp(21) + l * D_MODEL, H, nullptr, ssp, pc}; pg8::gemm_phase<pg8::EpiResNorm<false, false>, pg8::StaticOrder, D_MODEL>((LAS unsigned char*)smem, g, S, E); }
        STEP_END
        STEP_BEGIN
            pg8::Gemm g{H, (const bf16_t*)(p.ws + OFF_WT_UP + l * SZ_WT_UP), NTOK, D_UP, D_MODEL}; pg8::StaticOrder S; S.init_tiles(34, D_UP / 256, G, bid);
            pg8::EpiConvAct E{(bf16_t*)(p.ws + OFF_ACT), inp(23) + (size_t)l * 3 * D_UP, inp(24) + (size_t)l * D_UP};
            pg8::gemm_phase<pg8::EpiConvAct, pg8::StaticOrder, D_MODEL>((LAS unsigned char*)smem, g, S, E);
#if PROBE == 7
            pg8::gemm_phase<pg8::EpiConvAct, pg8::StaticOrder, D_MODEL>((LAS unsigned char*)smem, g, S, E);
#endif
            { const int rem = (34 * (D_UP / 256)) % G; if (bid >= rem) convert_range4(p, l, R_DN, NT3 / 4, bid - rem, G - rem, (float*)smem); }
        STEP_END
        STEP_BEGIN
            pg8::Gemm g{(const bf16_t*)(p.ws + OFF_ACT), (const bf16_t*)(p.ws + OFF_WT_DN + l * SZ_WT_DN), NTOK, D_MODEL, D_FF}; pg8::StaticOrder S; S.init(NTOK, D_MODEL, G, bid); S.wgm = 4;
            float* ssp = (float*)(p.ws + OFF_SSP) + (size_t)(2 * l + 1) * NTOK * 32; unsigned* pc = (unsigned*)(p.ws + OFF_BAR) + 3600 + 64 * l + 32;
            if (l == 0) { pg8::EpiResNorm<false, false> E{XA, XA, D_MODEL, inp(1) + D_MODEL, H, nullptr, ssp, pc}; pg8::gemm_phase<pg8::EpiResNorm<false, false>, pg8::StaticOrder, D_FF>((LAS unsigned char*)smem, g, S, E); }
            else { pg8::EpiResNorm<false, true> E{XA, XA, D_MODEL, inp(26), nullptr, p.out, ssp, pc}; pg8::gemm_phase<pg8::EpiResNorm<false, true>, pg8::StaticOrder, D_FF>((LAS unsigned char*)smem, g, S, E); }
        STEP_END
    }
}

constexpr int N_STEPS = 13;
#ifndef MULTI_LAUNCH
#define MULTI_LAUNCH 0
#endif

extern "C" void kernel_launch(void* const* d_in, const int* in_sizes, int n_in, void* d_out, int out_size, void* d_ws, size_t ws_size, hipStream_t stream) {
    static int grid = 0;
    if (grid == 0) {
        if (n_in != 27 || ws_size < WS_END) { fprintf(stderr, "kernel_launch: need 27 inputs and %zu bytes of workspace (got %d, %zu)\n", (size_t)WS_END, n_in, ws_size); grid = -1; return; }
        int dev = 0, cus = 0, per_cu = 0;
        hipGetDevice(&dev); hipDeviceGetAttribute(&cus, hipDeviceAttributeMultiprocessorCount, dev);
        if (hipFuncSetAttribute((const void*)fwd_megakernel, hipFuncAttributeMaxDynamicSharedMemorySize, LDS_BYTES) != hipSuccess) { fprintf(stderr, "kernel_launch: hipFuncSetAttribute failed\n"); grid = -1; return; }
        if (hipOccupancyMaxActiveBlocksPerMultiprocessor(&per_cu, (const void*)fwd_megakernel, 512, LDS_BYTES) != hipSuccess || per_cu < 1) { fprintf(stderr, "kernel_launch: occupancy query gave %d\n", per_cu); per_cu = 1; }
        (void)hipGetLastError();
        grid = cus * 1;
    }
    if (grid < 0) return;
    if (hipMemsetAsync((char*)d_ws + OFF_BAR, 0, 16384, stream) != hipSuccess) { fprintf(stderr, "kernel_launch: memset failed\n"); return; }
    Params p{};
    for (int i = 0; i < 27; ++i) p.in[i] = (const float*)d_in[i];
    p.out = (float*)d_out; p.ws = (unsigned char*)d_ws;
#if MULTI_LAUNCH
    for (int s = 0; s < N_STEPS; ++s) { p.ph_lo = s; p.ph_hi = s + 1; hipLaunchKernelGGL(fwd_megakernel, dim3(grid), dim3(512), LDS_BYTES, stream, p); }
#else
    p.ph_lo = 0; p.ph_hi = N_STEPS;
    void* args[] = {&p};
    hipError_t e = hipLaunchCooperativeKernel((const void*)fwd_megakernel, dim3(grid), dim3(512), args, LDS_BYTES, stream);
    if (e != hipSuccess) fprintf(stderr, "cooperative launch failed: %s (grid %d)\n", hipGetErrorString(e), grid);
#endif
}
```

```cpp
#include <hip/hip_runtime.h>
#include <hip/hip_cooperative_groups.h>
#include <cstdio>
namespace cg = cooperative_groups;

#define LAS __attribute__((address_space(3)))
typedef unsigned short bf16_t;
typedef short bf16x8 __attribute__((ext_vector_type(8)));
typedef float f32x4 __attribute__((ext_vector_type(4)));
typedef unsigned u32x4 __attribute__((ext_vector_type(4)));
typedef unsigned u32x2 __attribute__((ext_vector_type(2)));

constexpr int D_MODEL = 2048, SEQ = 4096, NTOK = 8192, D_INP = 4352, D_FF = 5632, D_UP = 11264;
constexpr int D_HY = 768, D_GM = 768;
constexpr int COL_HY = 512, COL_GM = 2816;
constexpr int MIX_HY = 512, MIX_GM = 1280;

constexpr size_t SZ_WT_IN = (size_t)D_INP * D_MODEL * 2, SZ_WT_OUT = (size_t)D_MODEL * D_MODEL * 2, SZ_WT_UP = (size_t)D_UP * D_MODEL * 2, SZ_WT_DN = (size_t)D_MODEL * D_FF * 2;
constexpr size_t SZ_POOLWT = 4 * 128 * 128 * 2, SZ_KF = (size_t)768 * 8192 * 8, SZ_H2 = (size_t)4096 * 64 * 4, SZ_STATS = (size_t)NTOK * 12 * 2 * 4;
constexpr size_t OFF_WT_IN = 0;
constexpr size_t OFF_WT_OUT = OFF_WT_IN + 2 * SZ_WT_IN;
constexpr size_t OFF_WT_UP = OFF_WT_OUT + 2 * SZ_WT_OUT;
constexpr size_t OFF_WT_DN = OFF_WT_UP + 2 * SZ_WT_UP;
constexpr size_t OFF_POOLWT = OFF_WT_DN + 2 * SZ_WT_DN;
constexpr size_t OFF_KF = OFF_POOLWT + 2 * SZ_POOLWT;
constexpr size_t OFF_H2 = OFF_KF + 2 * SZ_KF;
constexpr size_t OFF_STATS = OFF_H2 + 2 * SZ_H2;
constexpr size_t OFF_XA = OFF_STATS + 2 * SZ_STATS;
constexpr size_t OFF_H = OFF_XA + (size_t)NTOK * D_MODEL * 4;
constexpr size_t OFF_R1 = OFF_H + (size_t)(NTOK + 512) * D_MODEL * 2;
constexpr size_t OFF_P = OFF_R1;
constexpr size_t OFF_MIX = OFF_P + (size_t)NTOK * D_INP * 2;
constexpr size_t OFF_ZT = OFF_MIX + (size_t)NTOK * D_MODEL * 2;
constexpr size_t OFF_X0T = OFF_ZT + (size_t)768 * 8192 * 4;
constexpr size_t OFF_UP = OFF_R1;
constexpr size_t OFF_ACT = OFF_R1 + (size_t)NTOK * D_UP * 2;
constexpr size_t OFF_BAR = OFF_ACT + (size_t)NTOK * D_FF * 2;
constexpr size_t OFF_SSP = OFF_BAR + 16384;
constexpr size_t WS_END = OFF_SSP + (size_t)4 * NTOK * 32 * 4;
static_assert(OFF_X0T + (size_t)768 * 8192 * 4 <= OFF_ACT, "alias region");

constexpr int LDS_BYTES = 139264;
#ifndef PROBE
#define PROBE 0
#endif
#define REP(k) for (int rep_ = 0; rep_ < ((PROBE == (k)) ? 2 : 1); ++rep_)

struct Params {
    const float* in[27];
    float* out;
    unsigned char* ws;
    int ph_lo, ph_hi;
};


__device__ __forceinline__ const float* inp(int i) {
    const __attribute__((address_space(4))) char* ka = (const __attribute__((address_space(4))) char*)__builtin_amdgcn_kernarg_segment_ptr();
    int off = i * 8; asm volatile("" : "+s"(off));
    return *(const float* const __attribute__((address_space(4)))*)(ka + off);
}

__device__ __forceinline__ int tid_l() { int t = threadIdx.x; asm volatile("" : "+v"(t)); return t; }
__device__ __forceinline__ float bf2f(bf16_t b) { return __uint_as_float(((unsigned)b) << 16); }
__device__ __forceinline__ unsigned cvt_pk_bf16(float lo, float hi) { unsigned r; asm volatile("v_cvt_pk_bf16_f32 %0, %1, %2" : "=v"(r) : "v"(lo), "v"(hi)); return r; }
__device__ __forceinline__ float lo_bf(unsigned u) { return __uint_as_float(u << 16); }
__device__ __forceinline__ float hi_bf(unsigned u) { return __uint_as_float(u & 0xffff0000u); }
__device__ __forceinline__ float gelu_tanh(float x) {
    const float y2 = 1.5957691216f * (x + 0.044715f * x * x * x);
    return x * __builtin_amdgcn_rcpf(1.0f + __expf(-y2));
}
__device__ __forceinline__ float silu(float x) { return x * __builtin_amdgcn_rcpf(1.0f + __expf(-x)); }
__device__ __forceinline__ float wave_sum(float v) {
#pragma unroll
    for (int o = 32; o > 0; o >>= 1) v += __shfl_xor(v, o, 64);
    return v;
}

#define XB_TMO      128
#define XB_XCNT(j)  (256  + 64 * (j))
#define XB_XSUB(j)  (1280 + 64 * (j))
#define XB_XGEN(j)  (2304 + 64 * (j))
#define XB_TOP      3328
#define XB_TOPGEN   3392
#define XCD_BAR_WORDS 3456
#define XB_SPIN_CAP (1u << 18)

__device__ __forceinline__ unsigned xb_ld(unsigned* p)              { return __hip_atomic_load(p, __ATOMIC_RELAXED, __HIP_MEMORY_SCOPE_AGENT); }
__device__ __forceinline__ unsigned xb_add(unsigned* p, unsigned v) { return __hip_atomic_fetch_add(p, v, __ATOMIC_RELAXED, __HIP_MEMORY_SCOPE_AGENT); }
__device__ __forceinline__ unsigned xb_xcc_id() { return (unsigned)__builtin_amdgcn_s_getreg((3 << 11) | 20) & 0xFu; }
#define XB_SPIN(cond, bar) do { unsigned _sp = 0; while (cond) { __builtin_amdgcn_s_sleep(1); \
    if ((++_sp & 255u) == 0u) { if (xb_ld(&(bar)[XB_TMO])) break; if (_sp > XB_SPIN_CAP) { atomicAdd(&(bar)[XB_TMO], 1u); break; } } } } while (0)

struct XcdBarrier {
    unsigned* bar; unsigned x;
    volatile LAS unsigned* st;
};

__device__ __forceinline__ XcdBarrier xcd_barrier_post(unsigned* bar, volatile LAS unsigned* st) {
    XcdBarrier b; b.bar = bar; b.x = xb_xcc_id(); b.st = st;
    if (threadIdx.x == 0) (void)xb_add(&bar[XB_XCNT(b.x)], 1u);
    return b;
}
__device__ __forceinline__ void xcd_barrier_complete(unsigned* bar, unsigned x, unsigned& nloc, unsigned& nx) {
    const unsigned G = gridDim.x * gridDim.y * gridDim.z;
    unsigned sum, cnt, mine, sp = 0u;
    for (;;) {
        sum = 0u; cnt = 0u; mine = 0u;
#pragma unroll
        for (unsigned j = 0; j < 16; ++j) { const unsigned c = xb_ld(&bar[XB_XCNT(j)]); sum += c; cnt += (c > 0u) ? 1u : 0u; mine = (j == x) ? c : mine; }
        if (sum == G) break;
        __builtin_amdgcn_s_sleep(1);
        if ((++sp & 255u) == 0u) { if (xb_ld(&bar[XB_TMO])) break; if (sp > XB_SPIN_CAP) { atomicAdd(&bar[XB_TMO], 1u); break; } }
    }
    nloc = mine > 0u ? mine : 1u; nx = cnt > 0u ? cnt : 1u;
}

__device__ __forceinline__ void xcd_barrier(const XcdBarrier& b) {
    asm volatile("s_waitcnt vmcnt(0)" ::: "memory");
    __syncthreads();
    if (threadIdx.x == 0) {
        unsigned* bar = b.bar;
        __builtin_amdgcn_s_waitcnt(0);
        unsigned nloc = b.st[0], nx = b.st[1];
        if (nloc == 0u) { xcd_barrier_complete(bar, b.x, nloc, nx); b.st[0] = nloc; b.st[1] = nx; }
        const unsigned old = xb_add(&bar[XB_XSUB(b.x)], 1u);
        const unsigned gen = old / nloc;
        if (old + 1u == (gen + 1u) * nloc) {
            __builtin_amdgcn_fence(__ATOMIC_RELEASE, "agent");
            asm volatile("s_waitcnt vmcnt(0)" ::: "memory");
            const unsigned og = xb_add(&bar[XB_TOP], 1u);
            const unsigned tg = og / nx;
            if (og + 1u == (tg + 1u) * nx) xb_add(&bar[XB_TOPGEN], 1u);
            else XB_SPIN(xb_ld(&bar[XB_TOPGEN]) == tg, bar);
            __builtin_amdgcn_fence(__ATOMIC_ACQUIRE, "agent");
            xb_add(&bar[XB_XGEN(b.x)], 1u);
            asm volatile("s_waitcnt vmcnt(0)" ::: "memory");
        } else {
            XB_SPIN(xb_ld(&bar[XB_XGEN(b.x)]) == gen, bar);
            __builtin_amdgcn_fence(__ATOMIC_ACQUIRE, "agent");
            asm volatile("s_waitcnt vmcnt(0)" ::: "memory");
        }
    }
    __syncthreads();
}


namespace pg8 {
constexpr int BM = 256, BK = 64, HALF = 128, HTB = HALF * BK * 2, STAGE_BYTES = 8 * HTB, NXCD = 8, WGM = 8;
__host__ __device__ __forceinline__ int lds_byte(int r, int c) { const int st = (r >> 4) * 2 + (c >> 5), rr = r & 15, cc = c & 31, ob = rr * 64 + cc * 2; return st * 1024 + (ob ^ (((ob >> 9) & 1) << 5)); }
__host__ __device__ __forceinline__ void stage_rc(int b, int& R, int& C) { const int st = b / 1024, sb = b % 1024, swz = sb ^ (((sb >> 9) & 1) << 5); R = (st >> 1) * 16 + swz / 64; C = (st & 1) * 32 + (swz % 64) / 2; }
__host__ __device__ __forceinline__ int perm32(int rho) { const int n = rho >> 4, i = rho & 15; return 8 * (i >> 2) + 4 * n + (i & 3); }
struct Unit { int pm, pn; };
struct Gemm { const bf16_t* A; const bf16_t* Bt; int M, N, K; };
struct StaticOrder {
    int nM, nN, nwg, G, c, wgm = WGM;
    __device__ void init(int M, int N, int G_, int c_) { nM = M / BM; nN = N / BM; nwg = nM * nN; G = G_; c = c_; }
    __device__ void init_tiles(int nM_, int nN_, int G_, int c_) { nM = nM_; nN = nN_; nwg = nM * nN; G = G_; c = c_; }
    __device__ bool next(int i, Unit& u) const {
        const long L = (long)i * G + c; if (L >= nwg) return false;
        int wgid = (int)L; { const int q = nwg / NXCD, r = nwg % NXCD, xcd = wgid % NXCD, off = wgid / NXCD; wgid = (xcd < r ? xcd * (q + 1) : r * (q + 1) + (xcd - r) * q) + off; }
        const int nig = wgm * nN, gid = wgid / nig, fm = gid * wgm, gsz = (nM - fm) < wgm ? (nM - fm) : wgm;
        u.pm = fm + ((wgid % nig) % gsz); u.pn = (wgid % nig) / gsz; return true;
    }
};
struct EpiBf16 {
    static constexpr bool PERM = true, CONV = false, AFTER_DRAIN = false; static constexpr int GAPA = 0;
    bf16_t* O; int ldc;
    __device__ __forceinline__ void operator()(const f32x4 (&acc)[2][2][4][2], const Unit& u, int wr, int wc, int fr, int fq) const {
        const int row0 = u.pm * BM + wr * 64 + fr; const int col0 = u.pn * BM + wc * 32 + 8 * fq;
#pragma unroll
        for (int ai = 0; ai < 2; ++ai)
#pragma unroll
            for (int m = 0; m < 4; ++m) { bf16_t* rowp = O + (size_t)(row0 + ai * HALF + m * 16) * ldc + col0;
#pragma unroll
                for (int bj = 0; bj < 2; ++bj) { const f32x4 v0 = acc[ai][bj][m][0], v1 = acc[ai][bj][m][1];
                    u32x4 w; w.x = cvt_pk_bf16(v0[0], v0[1]); w.y = cvt_pk_bf16(v0[2], v0[3]); w.z = cvt_pk_bf16(v1[0], v1[1]); w.w = cvt_pk_bf16(v1[2], v1[3]);
                    *(u32x4*)(rowp + bj * HALF) = w; } }
    }
};
struct EpiBf16Gm {
    static constexpr bool PERM = true, CONV = false, AFTER_DRAIN = false; static constexpr int GAPA = D_MODEL * 2;
    bf16_t* O; int ldc; float* stats;
    __device__ __forceinline__ void operator()(const f32x4 (&acc)[2][2][4][2], const Unit& u, int wr, int wc, int fr, int fq) const {
        const int row0 = u.pm * BM + wr * 64 + fr; const int col0 = u.pn * BM + wc * 32 + 8 * fq;
        const bool act = u.pn >= 11, st = u.pn >= 14;
#pragma unroll
        for (int ai = 0; ai < 2; ++ai)
#pragma unroll
            for (int m = 0; m < 4; ++m) { const int row = row0 + ai * HALF + m * 16; bf16_t* rowp = O + (size_t)row * ldc + col0; float s1 = 0.f, s2 = 0.f;
#pragma unroll
                for (int bj = 0; bj < 2; ++bj) { f32x4 v0 = acc[ai][bj][m][0], v1 = acc[ai][bj][m][1];
                    if (act) {
#pragma unroll
                        for (int j = 0; j < 4; ++j) { v0[j] = gelu_tanh(v0[j]); v1[j] = gelu_tanh(v1[j]); s1 += v0[j] + v1[j]; s2 += v0[j] * v0[j] + v1[j] * v1[j]; } }
                    u32x4 w; w.x = cvt_pk_bf16(v0[0], v0[1]); w.y = cvt_pk_bf16(v0[2], v0[3]); w.z = cvt_pk_bf16(v1[0], v1[1]); w.w = cvt_pk_bf16(v1[2], v1[3]);
                    *(u32x4*)(rowp + bj * HALF) = w; }
                if (st) { s1 += __shfl_xor(s1, 16, 64); s2 += __shfl_xor(s2, 16, 64); s1 += __shfl_xor(s1, 32, 64); s2 += __shfl_xor(s2, 32, 64);
                    if (fq == 0) *(float2*)(stats + ((size_t)row * 12 + (u.pn - 14) * 4 + wc) * 2) = make_float2(s1, s2); } }
    }
};
__device__ __forceinline__ float dpp_ror1(float v) { return __builtin_bit_cast(float, __builtin_amdgcn_mov_dpp(__builtin_bit_cast(int, v), 0x121, 0xf, 0xf, true)); }
__device__ __forceinline__ float dpp_rol1(float v) { return __builtin_bit_cast(float, __builtin_amdgcn_mov_dpp(__builtin_bit_cast(int, v), 0x12F, 0xf, 0xf, true)); }
struct EpiConvAct {
    static constexpr bool PERM = true, CONV = true, AFTER_DRAIN = false; static constexpr int GAPA = 0;
    bf16_t* ACT; const float* cw; const float* cb;
    __device__ __forceinline__ void operator()(const f32x4 (&acc)[2][2][4][2], const Unit& u, int wr, int wc, int fr, int fq) const {
        const bool f0 = fr == 0, f15 = fr == 15;
#pragma unroll
        for (int n = 0; n < 2; ++n) {
            const int cg = 128 * u.pn + 32 * wc + 8 * fq + 4 * n;
            f32x4 wg[3], wv[3];
#pragma unroll
            for (int k = 0; k < 3; ++k) { wg[k] = *(const f32x4*)(cw + k * D_UP + cg); wv[k] = *(const f32x4*)(cw + k * D_UP + D_FF + cg); }
            const f32x4 bg = *(const f32x4*)(cb + cg), bv = *(const f32x4*)(cb + D_FF + cg);
#pragma unroll
            for (int ai = 0; ai < 2; ++ai) { const int pbase = 248 * u.pm + 62 * (2 * ai + wr);
                float rpg[4], rpv[4], lcg[4], lcv[4];
#pragma unroll
                for (int j = 0; j < 4; ++j) { rpg[j] = 0.f; rpv[j] = 0.f; lcg[j] = dpp_rol1(acc[ai][0][0][n][j]); lcv[j] = dpp_rol1(acc[ai][1][0][n][j]); }
#pragma unroll
                for (int m = 0; m < 4; ++m) { const int q = 16 * m + fr, pr = pbase + q; const int G = pr - 1 - (pr > 4097 ? 1 : 0);
                    const f32x4 gc = acc[ai][0][m][n], vc = acc[ai][1][m][n]; float o[4];
#pragma unroll
                    for (int j = 0; j < 4; ++j) {
                        const float rg = dpp_ror1(gc[j]), rv = dpp_ror1(vc[j]);
                        const float gp = (m > 0 && f0) ? rpg[j] : rg, vp = (m > 0 && f0) ? rpv[j] : rv;
                        float gn = lcg[j], vn = lcv[j];
                        if (m < 3) { const float a = dpp_rol1(acc[ai][0][m + 1][n][j]), b = dpp_rol1(acc[ai][1][m + 1][n][j]); gn = f15 ? a : gn; vn = f15 ? b : vn; lcg[j] = a; lcv[j] = b; }
                        rpg[j] = rg; rpv[j] = rv;
                        const float ga = __builtin_fmaf(wg[0][j], gp, __builtin_fmaf(wg[1][j], gc[j], __builtin_fmaf(wg[2][j], gn, bg[j])));
                        float va = __builtin_fmaf(wv[2][j], vn, bv[j]); asm volatile("" : "+v"(va));
                        va = __builtin_fmaf(wv[1][j], vc[j], va); asm volatile("" : "+v"(va));
                        va = __builtin_fmaf(wv[0][j], vp, va);
                        o[j] = silu(ga) * va; }
                    if (q >= 1 && q <= 62 && pr >= 1 && pr != 4097 && pr <= 8193) { u32x2 ow; ow.x = cvt_pk_bf16(o[0], o[1]); ow.y = cvt_pk_bf16(o[2], o[3]); *(u32x2*)(ACT + (size_t)G * D_FF + cg) = ow; } } }
        }
    }
};
template <bool RF32, bool FINAL> struct EpiResNorm {
    static constexpr bool PERM = true, CONV = false, AFTER_DRAIN = true; static constexpr int GAPA = 0;
    bf16_t* C; const void* R; int ldc; const float* gain; bf16_t* Hout; float* Fout; float* ssp; unsigned* cnt;
    __device__ __forceinline__ void operator()(f32x4 (&acc)[2][2][4][2], const Unit& u, int wr, int wc, int fr, int fq) const {
        const int row0 = u.pm * BM + wr * 64 + fr, col0 = u.pn * BM + wc * 32 + 8 * fq;
#pragma unroll
        for (int ai = 0; ai < 2; ++ai)
#pragma unroll
            for (int m = 0; m < 4; ++m) { const int row = row0 + ai * HALF + m * 16; const size_t ro = (size_t)row * ldc + col0; float sq = 0.f;
#pragma unroll
                for (int bj = 0; bj < 2; ++bj) { f32x4 r0, r1;
                    if (RF32) { const float* rp = (const float*)R + ro + bj * HALF; r0 = *(const f32x4*)rp; r1 = *(const f32x4*)(rp + 4); }
                    else { const u32x4 rr = *(const u32x4*)((const bf16_t*)R + ro + bj * HALF);
                        r0 = (f32x4){lo_bf(rr.x), hi_bf(rr.x), lo_bf(rr.y), hi_bf(rr.y)}; r1 = (f32x4){lo_bf(rr.z), hi_bf(rr.z), lo_bf(rr.w), hi_bf(rr.w)}; }
                    const f32x4 o0 = acc[ai][bj][m][0] + r0, o1 = acc[ai][bj][m][1] + r1; acc[ai][bj][m][0] = o0; acc[ai][bj][m][1] = o1;
                    sq += o0[0] * o0[0] + o0[1] * o0[1] + o0[2] * o0[2] + o0[3] * o0[3] + o1[0] * o1[0] + o1[1] * o1[1] + o1[2] * o1[2] + o1[3] * o1[3]; }
                sq += __shfl_xor(sq, 16, 64); sq += __shfl_xor(sq, 32, 64);
                if (fq == 0) __hip_atomic_store(ssp + (size_t)row * 32 + u.pn * 4 + wc, sq, __ATOMIC_RELAXED, __HIP_MEMORY_SCOPE_AGENT); }
        asm volatile("s_waitcnt vmcnt(0)" ::: "memory");
        __syncthreads();
        if (threadIdx.x == 0) __hip_atomic_fetch_add(cnt + u.pm, 1u, __ATOMIC_RELAXED, __HIP_MEMORY_SCOPE_AGENT);
        if (!FINAL) {
#pragma unroll
            for (int ai = 0; ai < 2; ++ai)
#pragma unroll
                for (int m = 0; m < 4; ++m) { const size_t ro = (size_t)(row0 + ai * HALF + m * 16) * ldc + col0;
#pragma unroll
                    for (int bj = 0; bj < 2; ++bj) { const f32x4 o0 = acc[ai][bj][m][0], o1 = acc[ai][bj][m][1];
                        u32x4 w; w.x = cvt_pk_bf16(o0[0], o0[1]); w.y = cvt_pk_bf16(o0[2], o0[3]); w.z = cvt_pk_bf16(o1[0], o1[1]); w.w = cvt_pk_bf16(o1[2], o1[3]);
                        *(u32x4*)(C + ro + bj * HALF) = w; } } }
        if (threadIdx.x == 0) {
            unsigned spins = 0;
            while (__hip_atomic_load(cnt + u.pm, __ATOMIC_RELAXED, __HIP_MEMORY_SCOPE_AGENT) < 8u) { __builtin_amdgcn_s_sleep(2); if (++spins > (1u << 22)) break; }
            __builtin_amdgcn_fence(__ATOMIC_ACQUIRE, "agent");
            asm volatile("s_waitcnt vmcnt(0)" ::: "memory");
        }
        __syncthreads();
        f32x4 g0[2], g1[2];
#pragma unroll
        for (int bj = 0; bj < 2; ++bj) { g0[bj] = *(const f32x4*)(gain + col0 + bj * HALF); g1[bj] = *(const f32x4*)(gain + col0 + bj * HALF + 4); }
#pragma unroll
        for (int ai = 0; ai < 2; ++ai)
#pragma unroll
            for (int m = 0; m < 4; ++m) { const int row = row0 + ai * HALF + m * 16; const size_t ro = (size_t)row * ldc + col0;
                const f32x4* q = (const f32x4*)(ssp + (size_t)row * 32 + 8 * fq); const f32x4 a = q[0] + q[1];
                float v = (a[0] + a[1]) + (a[2] + a[3]); v += __shfl_xor(v, 16, 64); v += __shfl_xor(v, 32, 64);
                const float rs = rsqrtf(v * (1.0f / D_MODEL) + 1e-6f);
#pragma unroll
                for (int bj = 0; bj < 2; ++bj) { const f32x4 o0 = acc[ai][bj][m][0], o1 = acc[ai][bj][m][1];
                    const f32x4 y0 = o0 * rs * g0[bj], y1 = o1 * rs * g1[bj];
                    if (FINAL) { float* op = Fout + ro + bj * HALF; *(f32x4*)op = y0; *(f32x4*)(op + 4) = y1; }
                    else { u32x4 w; w.x = cvt_pk_bf16(y0[0], y0[1]); w.y = cvt_pk_bf16(y0[2], y0[3]); w.z = cvt_pk_bf16(y1[0], y1[1]); w.w = cvt_pk_bf16(y1[2], y1[3]);
                        *(u32x4*)(Hout + (size_t)(row + 1 + (row >> 12)) * ldc + col0 + bj * HALF) = w; } } }
    }
};

template <class Epi, class Sched, int KDIM>
__device__ __forceinline__ void gemm_phase(LAS unsigned char* lds, const Gemm g, const Sched& S, const Epi& E) {
    int tid_ = threadIdx.x; asm volatile("" : "+v"(tid_));
    const int tid = tid_, wid = __builtin_amdgcn_readfirstlane(tid >> 6), lane = tid & 63, wr = wid >> 2, wc = wid & 3, fr = lane & 15, fq = lane >> 4;
    constexpr int K = KDIM, nt = K / BK;
    unsigned voffA[2], voffB[2];
#pragma unroll
    for (int i = 0; i < 2; ++i) { int R, C; stage_rc(tid * 16 + i * 8192, R, C); const int Rb = Epi::PERM ? ((R & ~31) + perm32(R & 31)) : R;
        const int Ra = Epi::CONV ? (62 * (R >> 6) + (R & 63)) : R;
        voffA[i] = (unsigned)(Ra * K + C) * 2u; voffB[i] = (unsigned)(Rb * K + C) * 2u; }
    const size_t kstep = (size_t)(BK * 2);
    const size_t hstep = (size_t)HALF * K * 2;
    const size_t tstep = 2 * hstep;
    const size_t hstepA = Epi::CONV ? (size_t)124 * K * 2 : hstep, tstepA = 2 * hstepA;
    const unsigned ldsw = (unsigned)wid * 1024u;
    const int aoff = lds_byte(wr * 64 + fr, fq * 8), boff = lds_byte(wc * 32 + fr, fq * 8);
#define PG8_SA(b, h) (((b) * 2 + (h)) * HTB)
#define PG8_SB(b, h) ((4 + (b) * 2 + (h)) * HTB)
#define PG8_STAGE(bufoff, gbase, voff) do { _Pragma("unroll") for (int _i = 0; _i < 2; ++_i) \
        __builtin_amdgcn_global_load_lds((const unsigned*)((const char*)(gbase) + (voff)[_i]), (LAS unsigned*)(lds + (bufoff) + ldsw + _i * 8192), 16, 0, 0); } while (0)
#define PG8_LDA(dst, b, h) do { _Pragma("unroll") for (int m = 0; m < 4; ++m) _Pragma("unroll") for (int k = 0; k < 2; ++k) dst[m][k] = *(const LAS bf16x8*)(lds + PG8_SA(b, h) + aoff + m * 2048 + k * 1024); } while (0)
#define PG8_LDB(dst, b, h) do { _Pragma("unroll") for (int n = 0; n < 2; ++n) _Pragma("unroll") for (int k = 0; k < 2; ++k) dst[n][k] = *(const LAS bf16x8*)(lds + PG8_SB(b, h) + boff + n * 2048 + k * 1024); } while (0)
#define PG8_MMA(ai, bj, At, Bt) do { __builtin_amdgcn_s_setprio(1); _Pragma("unroll") for (int m = 0; m < 4; ++m) _Pragma("unroll") for (int n = 0; n < 2; ++n) _Pragma("unroll") for (int k = 0; k < 2; ++k) \
        acc[ai][bj][m][n] = __builtin_amdgcn_mfma_f32_16x16x32_bf16(Bt[n][k], At[m][k], acc[ai][bj][m][n], 0, 0, 0); __builtin_amdgcn_s_setprio(0); } while (0)
#define PG8_WAIT_V(n) asm volatile("s_waitcnt vmcnt(" #n ")" ::: "memory")
#define PG8_WAIT_L(n) asm volatile("s_waitcnt lgkmcnt(" #n ")" ::: "memory")
#define PG8_BAR __builtin_amdgcn_s_barrier()
#define PG8_SCHED __builtin_amdgcn_sched_barrier(0)
    Unit cur, nxt; int ui = 0;
    if (!S.next(0, cur)) return;
    f32x4 acc[2][2][4][2];
#pragma unroll
    for (int a = 0; a < 2; ++a)
#pragma unroll
        for (int b = 0; b < 2; ++b)
#pragma unroll
            for (int m = 0; m < 4; ++m)
#pragma unroll
                for (int n = 0; n < 2; ++n) acc[a][b][m][n] = (f32x4){0.f, 0.f, 0.f, 0.f};
    bf16x8 At[4][2], B0[2][2], B1[2][2];
    const char* cA = (const char*)g.A + (size_t)cur.pm * tstepA + (cur.pm >= 16 ? Epi::GAPA : 0); const char* cB = (const char*)g.Bt + (size_t)cur.pn * tstep;
    PG8_STAGE(PG8_SB(0, 0), cB, voffB); PG8_STAGE(PG8_SA(0, 0), cA, voffA); PG8_STAGE(PG8_SB(0, 1), cB + hstep, voffB); PG8_STAGE(PG8_SA(0, 1), cA + hstepA, voffA);
    if (wr == 1) PG8_BAR;
    PG8_WAIT_V(4); PG8_BAR;
    PG8_STAGE(PG8_SB(1, 0), cB + kstep, voffB); PG8_STAGE(PG8_SA(1, 0), cA + kstep, voffA); PG8_STAGE(PG8_SB(1, 1), cB + hstep + kstep, voffB);
    PG8_WAIT_V(6); PG8_BAR;
    for (;;) {
        const bool has_next = S.next(ui + 1, nxt);
        const char* nA = has_next ? (const char*)g.A + (size_t)nxt.pm * tstepA + (nxt.pm >= 16 ? Epi::GAPA : 0) : cA; const char* nB = has_next ? (const char*)g.Bt + (size_t)nxt.pn * tstep : cB;
        for (int t = 0; t < nt; t += 2) {
            const bool last = (t == nt - 2);
            const char* a1 = cA + (size_t)(t + 1) * kstep;
            const char* a2 = last ? nA : cA + (size_t)(t + 2) * kstep; const char* b2 = last ? nB : cB + (size_t)(t + 2) * kstep;
            const char* a3 = a2 + kstep; const char* b3 = b2 + kstep;
            PG8_LDB(B0, 0, 0); PG8_SCHED; PG8_LDA(At, 0, 0); PG8_STAGE(PG8_SA(1, 1), a1 + hstepA, voffA);
            PG8_WAIT_L(8); PG8_BAR; PG8_WAIT_L(0); PG8_MMA(0, 0, At, B0); PG8_BAR; PG8_SCHED;
            PG8_LDB(B1, 0, 1); PG8_STAGE(PG8_SB(0, 0), b2, voffB);
            PG8_BAR; PG8_WAIT_L(0); PG8_MMA(0, 1, At, B1); PG8_BAR;
            PG8_LDA(At, 0, 1); PG8_STAGE(PG8_SA(0, 0), a2, voffA);
            PG8_BAR; PG8_WAIT_L(0); PG8_MMA(1, 0, At, B0); PG8_BAR; PG8_SCHED;
            PG8_STAGE(PG8_SB(0, 1), b2 + hstep, voffB);
            PG8_WAIT_V(6); PG8_BAR; PG8_MMA(1, 1, At, B1); PG8_BAR;
            PG8_LDB(B0, 1, 0); PG8_SCHED; PG8_LDA(At, 1, 0); PG8_STAGE(PG8_SA(0, 1), a2 + hstepA, voffA);
            PG8_WAIT_L(8); PG8_BAR; PG8_WAIT_L(0); PG8_MMA(0, 0, At, B0); PG8_BAR; PG8_SCHED;
            PG8_LDB(B1, 1, 1); PG8_STAGE(PG8_SB(1, 0), b3, voffB);
            PG8_BAR; PG8_WAIT_L(0); PG8_MMA(0, 1, At, B1); PG8_BAR;
            PG8_LDA(At, 1, 1); PG8_STAGE(PG8_SA(1, 0), a3, voffA);
            PG8_BAR; PG8_WAIT_L(0); PG8_MMA(1, 0, At, B0); PG8_BAR; PG8_SCHED;
            PG8_STAGE(PG8_SB(1, 1), b3 + hstep, voffB);
            PG8_WAIT_V(6); PG8_BAR; PG8_MMA(1, 1, At, B1); PG8_BAR;
        }
        if constexpr (!Epi::AFTER_DRAIN) E(acc, cur, wr, wc, fr, fq);
        if (!has_next) break;
#pragma unroll
        for (int a = 0; a < 2; ++a)
#pragma unroll
            for (int b = 0; b < 2; ++b)
#pragma unroll
                for (int m = 0; m < 4; ++m)
#pragma unroll
                    for (int n = 0; n < 2; ++n) acc[a][b][m][n] = (f32x4){0.f, 0.f, 0.f, 0.f};
        cur = nxt; cA = nA; cB = nB; ++ui;
    }
    PG8_WAIT_V(0);
    if (wr == 0) PG8_BAR;
    PG8_BAR;
    if constexpr (Epi::AFTER_DRAIN) E(acc, cur, wr, wc, fr, fq);
#undef PG8_SA
#undef PG8_SB
#undef PG8_STAGE
#undef PG8_LDA
#undef PG8_LDB
#undef PG8_MMA
#undef PG8_WAIT_V
#undef PG8_WAIT_L
#undef PG8_BAR
#undef PG8_SCHED
}
}

__device__ __forceinline__ void convert_tile(const float* __restrict__ W, int K, int N, bf16_t* __restrict__ Wt, int k0, int n0, int orow0, float* tile) {
    const int tid = tid_l();
    { const int r = tid >> 4, c4 = (tid & 15) * 4;
#pragma unroll
      for (int ps = 0; ps < 2; ++ps) { const int rr = r + ps * 32; const float4 v = *(const float4*)(W + (size_t)(k0 + rr) * N + n0 + c4);
          tile[rr * 65 + c4 + 0] = v.x; tile[rr * 65 + c4 + 1] = v.y; tile[rr * 65 + c4 + 2] = v.z; tile[rr * 65 + c4 + 3] = v.w; } }
    __syncthreads();
    { const int n = tid >> 3, k8 = (tid & 7) * 8; float v[8];
#pragma unroll
      for (int j = 0; j < 8; ++j) v[j] = tile[(k8 + j) * 65 + n];
      u32x4 w; w.x = cvt_pk_bf16(v[0], v[1]); w.y = cvt_pk_bf16(v[2], v[3]); w.z = cvt_pk_bf16(v[4], v[5]); w.w = cvt_pk_bf16(v[6], v[7]);
      *(u32x4*)(Wt + (size_t)(orow0 + n) * K + k0 + k8) = w; }
    __syncthreads();
}

constexpr int NI_IN = 32 * 68, NI_OUT = 32 * 32, NI_UP = 32 * 176, NI_DN = 88 * 32, NI_POOL = 16, NI_LAYER = NI_IN + NI_OUT + NI_UP + NI_DN + NI_POOL;
constexpr int NI_FILT = 256;
constexpr int NT3 = 1600;
constexpr int R_OUT = NI_IN, R_UP = NI_IN + NI_OUT, R_DN = NI_IN + NI_OUT + NI_UP, R_POOL = NI_IN + NI_OUT + NI_UP + NI_DN;
__device__ void convert_item(const Params& p, int l, int r, float* lds) {
    if (r < NI_IN) { const int tn = r / 32, tk = r % 32;
        convert_tile(inp(2) + (size_t)l * D_MODEL * D_INP, D_MODEL, D_INP, (bf16_t*)(p.ws + OFF_WT_IN + l * SZ_WT_IN), tk * 64, tn * 64, tn * 64, lds); return; }
    r -= NI_IN;
    if (r < NI_OUT) { const int tn = r / 32, tk = r % 32;
        convert_tile(inp(20) + (size_t)l * D_MODEL * D_MODEL, D_MODEL, D_MODEL, (bf16_t*)(p.ws + OFF_WT_OUT + l * SZ_WT_OUT), tk * 64, tn * 64, tn * 64, lds); return; }
    r -= NI_OUT;
    if (r < NI_UP) { const int tn = r / 32, tk = r % 32; const int n0 = tn * 64, s = n0 / D_FF, rem = n0 % D_FF, j = rem / 128, i = rem % 128;
        convert_tile(inp(22) + (size_t)l * D_MODEL * D_UP, D_MODEL, D_UP, (bf16_t*)(p.ws + OFF_WT_UP + l * SZ_WT_UP), tk * 64, n0, 256 * j + 128 * s + i, lds); return; }
    r -= NI_UP;
    if (r < NI_DN) { const int tn = r / 88, tk = r % 88;
        convert_tile(inp(25) + (size_t)l * D_FF * D_MODEL, D_FF, D_MODEL, (bf16_t*)(p.ws + OFF_WT_DN + l * SZ_WT_DN), tk * 64, tn * 64, tn * 64, lds); return; }
    r -= NI_DN;
    { const int g = r >> 2, tn = (r >> 1) & 1, tk = r & 1;
        convert_tile(inp(3) + (size_t)(l * 4 + g) * 128 * 128, 128, 128, (bf16_t*)(p.ws + OFF_POOLWT + l * SZ_POOLWT) + g * 128 * 128, tk * 64, tn * 64, tn * 64, lds); }
}

__device__ __forceinline__ float sin_rad(float x) { return __builtin_amdgcn_sinf(x * 0.15915494309f); }

struct CvDesc { const float* W; bf16_t* Wt; int K, N, k0, n0, orow0; };
__device__ __forceinline__ CvDesc cv_desc(const Params& p, int l, int r) {
    CvDesc d;
    if (r < R_OUT) { const int tn = r / 32, tk = r % 32; d.W = inp(2) + (size_t)l * D_MODEL * D_INP; d.Wt = (bf16_t*)(p.ws + OFF_WT_IN + l * SZ_WT_IN); d.K = D_MODEL; d.N = D_INP; d.k0 = tk * 64; d.n0 = tn * 64; d.orow0 = tn * 64; }
    else if (r < R_UP) { r -= R_OUT; const int tn = r / 32, tk = r % 32; d.W = inp(20) + (size_t)l * D_MODEL * D_MODEL; d.Wt = (bf16_t*)(p.ws + OFF_WT_OUT + l * SZ_WT_OUT); d.K = D_MODEL; d.N = D_MODEL; d.k0 = tk * 64; d.n0 = tn * 64; d.orow0 = tn * 64; }
    else if (r < R_DN) { r -= R_UP; const int tn = r / 32, tk = r % 32; const int n0 = tn * 64, sg = n0 / D_FF, rem = n0 % D_FF, j = rem / 128, i = rem % 128;
        d.W = inp(22) + (size_t)l * D_MODEL * D_UP; d.Wt = (bf16_t*)(p.ws + OFF_WT_UP + l * SZ_WT_UP); d.K = D_MODEL; d.N = D_UP; d.k0 = tk * 64; d.n0 = n0; d.orow0 = 256 * j + 128 * sg + i; }
    else if (r < R_POOL) { r -= R_DN; const int tn = r / 88, tk = r % 88; d.W = inp(25) + (size_t)l * D_FF * D_MODEL; d.Wt = (bf16_t*)(p.ws + OFF_WT_DN + l * SZ_WT_DN); d.K = D_FF; d.N = D_MODEL; d.k0 = tk * 64; d.n0 = tn * 64; d.orow0 = tn * 64; }
    else { r -= R_POOL; const int g = r >> 2, tn = (r >> 1) & 1, tk = r & 1; d.W = inp(3) + (size_t)(l * 4 + g) * 128 * 128; d.Wt = (bf16_t*)(p.ws + OFF_POOLWT + l * SZ_POOLWT) + g * 128 * 128; d.K = 128; d.N = 128; d.k0 = tk * 64; d.n0 = tn * 64; d.orow0 = tn * 64; }
    return d;
}
__device__ __forceinline__ CvDesc cv_pick(const Params& p, int mode, int l, int base, int i) {
    if (mode == 0) { if (i < R_DN) return cv_desc(p, 0, i); if (i < R_DN + NI_POOL) return cv_desc(p, 0, R_POOL + i - R_DN); return cv_desc(p, 1, R_POOL + i - R_DN - NI_POOL); }
    return cv_desc(p, l, base + i);
}
__device__ __forceinline__ void cv_load(const CvDesc& d, int tid, float4 (&v)[2]) {
    const int r = tid >> 4, c4 = (tid & 15) * 4;
#pragma unroll
    for (int ps = 0; ps < 2; ++ps) v[ps] = *(const float4*)(d.W + (size_t)(d.k0 + r + ps * 32) * d.N + d.n0 + c4);
}
__device__ void convert_range(const Params& p, int mode, int l, int base, int count, int start, int stride, float* tile) {
    int i = start; if (i >= count) return;
    const int tid = tid_l();
    CvDesc d = cv_pick(p, mode, l, base, i); float4 v[2]; cv_load(d, tid, v);
    for (;;) {
        { const int r = tid >> 4, c4 = (tid & 15) * 4;
#pragma unroll
          for (int ps = 0; ps < 2; ++ps) { float* tp = tile + (r + ps * 32) * 65 + c4; tp[0] = v[ps].x; tp[1] = v[ps].y; tp[2] = v[ps].z; tp[3] = v[ps].w; } }
        __syncthreads();
        const int ni = i + stride; const bool more = ni < count; CvDesc dn = d;
        if (more) { dn = cv_pick(p, mode, l, base, ni); cv_load(dn, tid, v); }
        { const int n = tid >> 3, k8 = (tid & 7) * 8; float u[8];
#pragma unroll
          for (int j = 0; j < 8; ++j) u[j] = tile[(k8 + j) * 65 + n];
          u32x4 w; w.x = cvt_pk_bf16(u[0], u[1]); w.y = cvt_pk_bf16(u[2], u[3]); w.z = cvt_pk_bf16(u[4], u[5]); w.w = cvt_pk_bf16(u[6], u[7]);
          *(u32x4*)(d.Wt + (size_t)(d.orow0 + n) * d.K + d.k0 + k8) = w; }
        __syncthreads();
        if (!more) break;
        d = dn; i = ni;
    }
}

__device__ __forceinline__ void cv_load4(const CvDesc& d, int tid, float4 (&v)[8]) {
    const int r = tid >> 4, c4 = (tid & 15) * 4;
#pragma unroll
    for (int ps = 0; ps < 8; ++ps) v[ps] = *(const float4*)(d.W + (size_t)(d.k0 + r + ps * 32) * d.N + d.n0 + c4);
}
__device__ void convert_range4(const Params& p, int l, int base, int count4, int start, int stride, float* tile) {
    int i = start; if (i >= count4) return;
    const int tid = tid_l();
    CvDesc d = cv_desc(p, l, base + 4 * i); float4 v[8]; cv_load4(d, tid, v);
    for (;;) {
        { const int r = tid >> 4, c4 = (tid & 15) * 4;
#pragma unroll
          for (int ps = 0; ps < 8; ++ps) { float* tp = tile + (r + ps * 32) * 65 + c4; tp[0] = v[ps].x; tp[1] = v[ps].y; tp[2] = v[ps].z; tp[3] = v[ps].w; } }
        __syncthreads();
        const int ni = i + stride; const bool more = ni < count4; CvDesc dn = d;
        if (more) { dn = cv_desc(p, l, base + 4 * ni); cv_load4(dn, tid, v); }
        { const int n = tid >> 3, kc = tid & 7;
#pragma unroll
          for (int j = 0; j < 4; ++j) { const int k8 = (kc + 8 * j) * 8; float u[8];
#pragma unroll
              for (int q = 0; q < 8; ++q) u[q] = tile[(k8 + q) * 65 + n];
              u32x4 w; w.x = cvt_pk_bf16(u[0], u[1]); w.y = cvt_pk_bf16(u[2], u[3]); w.z = cvt_pk_bf16(u[4], u[5]); w.w = cvt_pk_bf16(u[6], u[7]);
              *(u32x4*)(d.Wt + (size_t)(d.orow0 + n) * d.K + d.k0 + k8) = w; } }
        __syncthreads();
        if (!more) break;
        d = dn; i = ni;
    }
}

__device__ void filter_item(const Params& p, int item, float* lds) {
    const int l = item >> 7, rem = item & 127, ti = rem >> 1, half = rem & 1;
    const int tid = tid_l(), lane = tid & 63, w = __builtin_amdgcn_readfirstlane(tid >> 6);
    const int t = ti * 64 + lane;
    const float* w1 = inp(8) + l * 33 * 64; const float* b1 = inp(9) + l * 64; const float* fr1 = inp(10) + l * 64;
    const float* w2 = inp(11) + l * 64 * 64; const float* b2 = inp(12) + l * 64; const float* fr2 = inp(13) + l * 64;
    const float* w3 = inp(14) + (size_t)l * 64 * 1536;
    float* h1s = lds; float* h2s = lds + 64 * 65;
    const float tt = (float)t / 4095.0f;
    float a[8];
#pragma unroll
    for (int j = 0; j < 8; ++j) a[j] = b1[8 * w + j] + tt * w1[8 * w + j];
    for (int band = 0; band < 16; ++band) {
        const float f = 1e-4f + (float)band * ((15.0f - 1e-4f) / 15.0f);
        float r = f * (float)t * (1.0f / 4096.0f); r -= floorf(r);
        const float cs = __builtin_amdgcn_cosf(r), sn = -__builtin_amdgcn_sinf(r);
#pragma unroll
        for (int j = 0; j < 8; ++j) a[j] += cs * w1[(1 + band) * 64 + 8 * w + j] + sn * w1[(17 + band) * 64 + 8 * w + j];
    }
#pragma unroll
    for (int j = 0; j < 8; ++j) h1s[lane * 65 + 8 * w + j] = sin_rad(fr1[8 * w + j] * a[j]);
    __syncthreads();
#pragma unroll
    for (int j = 0; j < 8; ++j) a[j] = b2[8 * w + j];
    for (int i = 0; i < 64; ++i) { const float h = h1s[lane * 65 + i];
#pragma unroll
        for (int j = 0; j < 8; ++j) a[j] += h * w2[i * 64 + 8 * w + j]; }
#pragma unroll
    for (int j = 0; j < 8; ++j) h2s[lane * 65 + 8 * w + j] = sin_rad(fr2[8 * w + j] * a[j]);
    __syncthreads();
    float* KT = (float*)(p.ws + OFF_ACT) + (size_t)l * 768 * 8192;
    const float d0 = -3.0701134573f, d1 = -15.3505672865f;
    typedef const __attribute__((address_space(4))) f32x4 cf4;
    for (int ci = 0; ci < 24; ++ci) {
        const int c = w * 96 + ci * 4;
        cf4* wc = (cf4*)(unsigned long long)(w3 + half * 768 + c);
        float o0 = 0.f, o1 = 0.f, o2 = 0.f, o3 = 0.f;
#pragma unroll 8
        for (int i = 0; i < 64; ++i) { const float h = h2s[lane * 65 + i]; const f32x4 wv = wc[i * 384]; o0 += h * wv[0]; o1 += h * wv[1]; o2 += h * wv[2]; o3 += h * wv[3]; }
        float o[4] = {o0, o1, o2, o3};
#pragma unroll
        for (int j = 0; j < 4; ++j) {
            const float delta = d0 + (float)(c + j) * ((d1 - d0) / 767.0f);
            const float val = o[j] * __expf(-tt * fabsf(delta));
            float* kt = KT + (size_t)(c + j) * 8192;
            if (half == 0) kt[t] = val; else { if (t == 0) kt[4096] = 0.f; else kt[8192 - t] = val; }
        }
    }
    __syncthreads();
}

__device__ __forceinline__ int phys(int i) { return i + (i >> 5); }
__device__ __forceinline__ float launder_f(float v) { asm volatile("" : "+v"(v)); return v; }
constexpr int FFT_BUF = 8192 + 256;
__device__ __forceinline__ constexpr float c32(int i) { constexpr float T[16] = {1.0f, 0.98078528040f, 0.92387953251f, 0.83146961230f, 0.70710678119f, 0.55557023302f, 0.38268343237f, 0.19509032202f, 0.0f, -0.19509032202f, -0.38268343237f, -0.55557023302f, -0.70710678119f, -0.83146961230f, -0.92387953251f, -0.98078528040f}; return T[i]; }
__device__ __forceinline__ constexpr float s32(int i) { constexpr float T[16] = {0.0f, 0.19509032202f, 0.38268343237f, 0.55557023302f, 0.70710678119f, 0.83146961230f, 0.92387953251f, 0.98078528040f, 1.0f, 0.98078528040f, 0.92387953251f, 0.83146961230f, 0.70710678119f, 0.55557023302f, 0.38268343237f, 0.19509032202f}; return T[i]; }
template <bool INV> __device__ __forceinline__ void radix16(float2 (&x)[16], float rfrac) {
#pragma unroll
    for (int jj = 0; jj < 4; ++jj) { const int j = INV ? 3 - jj : jj; const int half = 8 >> j;
        const float ab = rfrac * (float)(8 / half); const float cb = __builtin_amdgcn_cosf(ab), sb = __builtin_amdgcn_sinf(ab);
#pragma unroll
        for (int kk = 0; kk < half; ++kk) {
            const int idx = kk * (16 / half);
            float cs, sp;
            if (idx == 0) { cs = cb; sp = sb; }
            else if (idx == 8) { cs = -sb; sp = cb; }
            else { cs = cb * c32(idx) - sb * s32(idx); sp = cb * s32(idx) + sb * c32(idx); }
            const float sn = INV ? sp : -sp;
#pragma unroll
            for (int g = 0; g < 16; g += 2 * half) { const int i0 = g + kk, i1 = i0 + half; const float2 a = x[i0], b = x[i1];
                if (!INV) { const float dx = a.x - b.x, dy = a.y - b.y; x[i0] = make_float2(a.x + b.x, a.y + b.y); x[i1] = make_float2(dx * cs - dy * sn, dx * sn + dy * cs); }
                else { const float bx = b.x * cs - b.y * sn, by = b.x * sn + b.y * cs; x[i0] = make_float2(a.x + bx, a.y + by); x[i1] = make_float2(a.x - bx, a.y - by); } }
        }
    }
}
template <bool INV> __device__ __forceinline__ void radix32(float2 (&y)[32]) {
#pragma unroll
    for (int jj = 0; jj < 5; ++jj) { const int j = INV ? 4 - jj : jj; const int half = 16 >> j;
#pragma unroll
        for (int kk = 0; kk < half; ++kk) { const int idx = kk * (16 / half); const float cs = c32(idx), sn = INV ? s32(idx) : -s32(idx);
#pragma unroll
            for (int g = 0; g < 32; g += 2 * half) { const int i0 = g + kk, i1 = i0 + half; const float2 a = y[i0], b = y[i1];
                if (!INV) { const float dx = a.x - b.x, dy = a.y - b.y; y[i0] = make_float2(a.x + b.x, a.y + b.y);
                    if (idx == 0) y[i1] = make_float2(dx, dy);
                    else if (idx == 8) y[i1] = make_float2(dy, -dx);
                    else y[i1] = make_float2(dx * cs - dy * sn, dx * sn + dy * cs); }
                else { float bx, by;
                    if (idx == 0) { bx = b.x; by = b.y; }
                    else if (idx == 8) { bx = -b.y; by = b.x; }
                    else { bx = b.x * cs - b.y * sn; by = b.x * sn + b.y * cs; }
                    y[i0] = make_float2(a.x + bx, a.y + by); y[i1] = make_float2(a.x - bx, a.y - by); } }
        }
    }
}
template <bool INV> __device__ __forceinline__ void fft_pass2(float2* B, int tid, float rfr) {
    const int blk = tid >> 5, r = tid & 31; float2 x[16]; float2* b = B + blk * 528 + r;
#pragma unroll
    for (int k = 0; k < 16; ++k) x[k] = b[33 * k];
    radix16<INV>(x, rfr);
#pragma unroll
    for (int k = 0; k < 16; ++k) b[33 * k] = x[k];
}

__device__ void kf_item(const Params& p, int item, unsigned char* smem) {
    const int l = item / 384, cp = item % 384, c0 = 2 * cp;
    const int tid = tid_l();
    float2* B0 = (float2*)smem; float2* B1 = B0 + FFT_BUF;
    const float* KT = (const float*)(p.ws + OFF_ACT) + ((size_t)l * 768 + c0) * 8192 + tid;
    float2 x0[16], x1[16];
#pragma unroll
    for (int k = 0; k < 16; ++k) { x0[k] = make_float2(KT[512 * k], 0.f); x1[k] = make_float2(KT[8192 + 512 * k], 0.f); }
    const float rf = (float)tid * (1.0f / 8192.0f);
    radix16<false>(x0, rf); radix16<false>(x1, rf);
#pragma unroll
    for (int k = 0; k < 16; ++k) { B0[phys(tid + 512 * k)] = x0[k]; B1[phys(tid + 512 * k)] = x1[k]; }
    __syncthreads();
    { const float r2 = launder_f((float)(tid & 31) * (1.0f / 512.0f)); fft_pass2<false>(B0, tid, r2); fft_pass2<false>(B1, tid, r2); }
    __syncthreads();
    { const int blk = tid & 255, ch = tid >> 8; float2* B = ch ? B1 : B0; float2 y[32];
#pragma unroll
      for (int k = 0; k < 32; ++k) y[k] = B[blk * 33 + k];
      radix32<false>(y);
      float2* KF = (float2*)(p.ws + OFF_KF) + ((size_t)l * 768 + c0 + ch) * 8192 + blk * 2; const float sc = 1.0f / 8192.0f;
#pragma unroll
      for (int k = 0; k < 32; k += 2) *(float4*)(KF + (k >> 1) * 512) = make_float4(y[k].x * sc, y[k].y * sc, y[k + 1].x * sc, y[k + 1].y * sc); }
    __syncthreads();
}

template <bool XF32> __device__ void norm_phase(const void* __restrict__ xin, const float* __restrict__ g, bf16_t* hb, float* hf) {
    const int tid = tid_l(); const int lane = tid & 63; const int gw = blockIdx.x * 8 + (tid >> 6), nw = gridDim.x * 8;
    for (int row = gw; row < NTOK; row += nw) {
        float v[4][8]; float ss = 0.f;
#pragma unroll
        for (int i = 0; i < 4; ++i) { const size_t o = (size_t)row * D_MODEL + i * 512 + lane * 8;
            if (XF32) { const float4 a = *(const float4*)((const float*)xin + o), b = *(const float4*)((const float*)xin + o + 4);
                v[i][0] = a.x; v[i][1] = a.y; v[i][2] = a.z; v[i][3] = a.w; v[i][4] = b.x; v[i][5] = b.y; v[i][6] = b.z; v[i][7] = b.w; }
            else { const u32x4 u = *(const u32x4*)((const bf16_t*)xin + o);
                v[i][0] = lo_bf(u.x); v[i][1] = hi_bf(u.x); v[i][2] = lo_bf(u.y); v[i][3] = hi_bf(u.y); v[i][4] = lo_bf(u.z); v[i][5] = hi_bf(u.z); v[i][6] = lo_bf(u.w); v[i][7] = hi_bf(u.w); }
#pragma unroll
            for (int j = 0; j < 8; ++j) ss += v[i][j] * v[i][j]; }
        ss = wave_sum(ss);
        const float rs = rsqrtf(ss * (1.0f / D_MODEL) + 1e-6f);
#pragma unroll
        for (int i = 0; i < 4; ++i) { const int c = i * 512 + lane * 8; const float4 ga = *(const float4*)(g + c), gb = *(const float4*)(g + c + 4);
            const float y0 = v[i][0] * rs * ga.x, y1 = v[i][1] * rs * ga.y, y2 = v[i][2] * rs * ga.z, y3 = v[i][3] * rs * ga.w, y4 = v[i][4] * rs * gb.x, y5 = v[i][5] * rs * gb.y, y6 = v[i][6] * rs * gb.z, y7 = v[i][7] * rs * gb.w;
            if (hb) { u32x4 w; w.x = cvt_pk_bf16(y0, y1); w.y = cvt_pk_bf16(y2, y3); w.z = cvt_pk_bf16(y4, y5); w.w = cvt_pk_bf16(y6, y7); *(u32x4*)(hb + (size_t)(row + 1 + (row >> 12)) * D_MODEL + c) = w; }
            else { float* op = hf + (size_t)row * D_MODEL + c; *(float4*)op = make_float4(y0, y1, y2, y3); *(float4*)(op + 4) = make_float4(y4, y5, y6, y7); } }
    }
}

__device__ void pool_item(const Params& p, int l, int item, unsigned char* smem) {
    const int tt = item >> 2, g = item & 3;
    const int tid = tid_l(), lane = tid & 63, w = tid >> 6, fr = lane & 15, fq = lane >> 4;
    const bf16_t* P = (const bf16_t*)(p.ws + OFF_P); bf16_t* MIX = (bf16_t*)(p.ws + OFF_MIX);
    const int row0 = tt * 128, b0 = (row0 / SEQ) * SEQ;
    float* X = (float*)smem;
    bf16_t* A = (bf16_t*)(smem + 144 * 129 * 4);
    for (int idx = tid; idx < 144 * 16; idx += 512) { const int r = idx >> 4, c8 = (idx & 15) * 8; const int row = row0 - 8 + r;
        u32x4 v = (u32x4){0u, 0u, 0u, 0u};
        if (row >= b0 && row < b0 + SEQ) v = *(const u32x4*)(P + (size_t)row * D_INP + g * 128 + c8);
        float* xp = X + r * 129 + c8;
        xp[0] = lo_bf(v.x); xp[1] = hi_bf(v.x); xp[2] = lo_bf(v.y); xp[3] = hi_bf(v.y); xp[4] = lo_bf(v.z); xp[5] = hi_bf(v.z); xp[6] = lo_bf(v.w); xp[7] = hi_bf(v.w); }
    __syncthreads();
    { const int c = tid & 127, tq = tid >> 7; const int hw = 1 << g;
      const float* xc = X + (tq * 32 + 8) * 129 + c;
      float s = 0.f;
      for (int q = -hw; q < hw; ++q) s += xc[q * 129];
      const int tb = row0 + tq * 32 - b0;
#pragma unroll 8
      for (int i = 0; i < 32; ++i) { const int t = tb + i; const int lo = max(t - hw, 0), hi = min(t + hw - 1, SEQ - 1);
          const float d = s * __builtin_amdgcn_rcpf((float)(hi - lo + 1)) - xc[i * 129];
          A[(tq * 32 + i) * 136 + c] = (bf16_t)(cvt_pk_bf16(d, 0.f) & 0xffffu);
          s += xc[(i + hw) * 129] - xc[(i - hw) * 129]; } }
    __syncthreads();
    const bf16_t* Wt = (const bf16_t*)(p.ws + OFF_POOLWT + l * SZ_POOLWT) + g * 128 * 128;
    f32x4 acc[8];
#pragma unroll
    for (int nb = 0; nb < 8; ++nb) acc[nb] = (f32x4){0.f, 0.f, 0.f, 0.f};
#pragma unroll
    for (int ks = 0; ks < 4; ++ks) {
        const bf16x8 af = *(const bf16x8*)(A + (16 * w + fr) * 136 + ks * 32 + fq * 8);
#pragma unroll
        for (int nb = 0; nb < 8; ++nb) { const bf16x8 bfr = *(const bf16x8*)(Wt + (nb * 16 + fr) * 128 + ks * 32 + fq * 8);
            acc[nb] = __builtin_amdgcn_mfma_f32_16x16x32_bf16(bfr, af, acc[nb], 0, 0, 0); }
    }
    const float* pb = inp(4) + l * 512 + g * 128; const float* psc = inp(5) + l * 512 + g * 128;
    const int row = row0 + 16 * w + fr;
#pragma unroll
    for (int nb = 0; nb < 8; ++nb) { const int d = nb * 16 + 4 * fq; const float4 bb = *(const float4*)(pb + d), sc = *(const float4*)(psc + d);
        u32x2 o; o.x = cvt_pk_bf16((acc[nb][0] + bb.x) * sc.x, (acc[nb][1] + bb.y) * sc.y); o.y = cvt_pk_bf16((acc[nb][2] + bb.z) * sc.z, (acc[nb][3] + bb.w) * sc.w);
        *(u32x2*)(MIX + (size_t)row * D_MODEL + g * 128 + d) = o; }
    __syncthreads();
}

__device__ void hypre_item(const Params& p, int l, int item, unsigned char* smem) {
    const int tt = item / 6, ct = item % 6; const int tid = tid_l();
    const bf16_t* P = (const bf16_t*)(p.ws + OFF_P); float* ZT = (float*)(p.ws + OFF_ZT); float* X0T = (float*)(p.ws + OFF_X0T);
    const float* sw = inp(6) + (size_t)l * 3 * 2304; const float* sb = inp(7) + (size_t)l * 2304;
    float* zt = (float*)smem;
    float* xt = zt + 128 * 65;
    const int row0 = tt * 64;
    { const int cpq = tid & 63, tr = tid >> 6; const int ch = ct * 128 + 2 * cpq;
      float w[3][3][2], bb[3][2];
#pragma unroll
      for (int s3 = 0; s3 < 3; ++s3) {
#pragma unroll
          for (int k = 0; k < 3; ++k) { const float2 v = *(const float2*)(sw + k * 2304 + s3 * 768 + ch); w[s3][k][0] = v.x; w[s3][k][1] = v.y; }
          const float2 v = *(const float2*)(sb + s3 * 768 + ch); bb[s3][0] = v.x; bb[s3][1] = v.y; }
      const int r0 = row0 + tr * 8; const bf16_t* pr = P + (size_t)r0 * D_INP + COL_HY + ch;
      unsigned pm[3], pc[3], pn[3];
#pragma unroll
      for (int s3 = 0; s3 < 3; ++s3) { pm[s3] = ((r0 & (SEQ - 1)) != 0) ? *(const unsigned*)(pr - D_INP + s3 * 768) : 0u; pc[s3] = *(const unsigned*)(pr + s3 * 768); }
#pragma unroll
      for (int i = 0; i < 8; ++i) { const int row = r0 + i;
#pragma unroll
          for (int s3 = 0; s3 < 3; ++s3) pn[s3] = ((row & (SEQ - 1)) != SEQ - 1) ? *(const unsigned*)(pr + (size_t)(i + 1) * D_INP + s3 * 768) : 0u;
          float o[3][2];
#pragma unroll
          for (int s3 = 0; s3 < 3; ++s3) { o[s3][0] = w[s3][0][0] * lo_bf(pm[s3]) + w[s3][1][0] * lo_bf(pc[s3]) + w[s3][2][0] * lo_bf(pn[s3]) + bb[s3][0];
                                           o[s3][1] = w[s3][0][1] * hi_bf(pm[s3]) + w[s3][1][1] * hi_bf(pc[s3]) + w[s3][2][1] * hi_bf(pn[s3]) + bb[s3][1]; }
          const int tl = tr * 8 + i;
          zt[(2 * cpq) * 65 + tl] = o[1][0] * o[2][0]; zt[(2 * cpq + 1) * 65 + tl] = o[1][1] * o[2][1];
          xt[(2 * cpq) * 65 + tl] = o[0][0]; xt[(2 * cpq + 1) * 65 + tl] = o[0][1];
#pragma unroll
          for (int s3 = 0; s3 < 3; ++s3) { pm[s3] = pc[s3]; pc[s3] = pn[s3]; } } }
    __syncthreads();
    { const int tl = tid & 63, cr = tid >> 6; const int row = row0 + tl, b = row >> 12, t = row & (SEQ - 1);
#pragma unroll
      for (int i = 0; i < 16; ++i) { const int c = cr * 16 + i; const size_t o = (size_t)(ct * 128 + c) * 8192 + b * 4096 + t; ZT[o] = zt[c * 65 + tl]; X0T[o] = xt[c * 65 + tl]; } }
    __syncthreads();
}

constexpr int GM_NH = 3;
__device__ void gmlp_item(const Params& p, int l, int item, unsigned char* smem) {
    const int n = item / (6 / GM_NH), e0 = (item % (6 / GM_NH)) * GM_NH;
    const int tid = tid_l(), lane = tid & 63, w = tid >> 6, fr = lane & 15, fq = lane >> 4;
    const bf16_t* P = (const bf16_t*)(p.ws + OFF_P); bf16_t* MIX = (bf16_t*)(p.ws + OFF_MIX);
    const float* stats = (const float*)(p.ws + OFF_STATS) + (size_t)l * NTOK * 24;
    const float* lng = inp(16) + l * 768; const float* lnb = inp(17) + l * 768;
    bf16_t* VT = (bf16_t*)smem;
    const int t0 = n * 128;
    const int q = 16 * w + fr; const size_t qrow = (size_t)(t0 + q);
    float g0[GM_NH], g1[GM_NH], be0[GM_NH], be1[GM_NH], bq[GM_NH]; u32x2 uu[GM_NH][8]; bf16x8 wf[GM_NH][4];
#pragma unroll
    for (int h = 0; h < GM_NH; ++h) { const int e = e0 + h;
        g0[h] = lng[e * 128 + lane]; g1[h] = lng[e * 128 + 64 + lane]; be0[h] = lnb[e * 128 + lane]; be1[h] = lnb[e * 128 + 64 + lane];
        bq[h] = (inp(19) + (l * 6 + e) * 128)[q];
#pragma unroll
        for (int cb = 0; cb < 8; ++cb) uu[h][cb] = *(const u32x2*)(P + qrow * D_INP + COL_GM + e * 128 + cb * 16 + 4 * fq);
        const float* ws_ = inp(18) + (size_t)(l * 6 + e) * 128 * 128;
#pragma unroll
        for (int ks = 0; ks < 4; ++ks) { const float* wp = ws_ + (16 * w + fr) * 128 + ks * 32 + fq * 8; const float4 a = *(const float4*)wp, b = *(const float4*)(wp + 4);
            u32x4 t; t.x = cvt_pk_bf16(a.x, a.y); t.y = cvt_pk_bf16(a.z, a.w); t.z = cvt_pk_bf16(b.x, b.y); t.w = cvt_pk_bf16(b.z, b.w); wf[h][ks] = __builtin_bit_cast(bf16x8, t); } }
#pragma unroll
    for (int i = 0; i < 16; ++i) { const int pl = 16 * w + i; const size_t row = (size_t)(t0 + pl); const bf16_t* pr = P + row * D_INP + COL_GM + 768 + e0 * 128;
        float2 st; { const f32x4* sp = (const f32x4*)(stats + row * 24); f32x4 a = sp[0];
#pragma unroll
          for (int k = 1; k < 6; ++k) a += sp[k];
          st = make_float2(a[0] + a[2], a[1] + a[3]); }
        const float mean = st.x * (1.0f / 768.0f); const float rstd = rsqrtf(fmaxf(st.y * (1.0f / 768.0f) - mean * mean, 0.f) + 1e-5f);
#pragma unroll
        for (int h = 0; h < GM_NH; ++h) {
            const float y0 = (bf2f(pr[h * 128 + lane]) - mean) * rstd * g0[h] + be0[h], y1 = (bf2f(pr[h * 128 + 64 + lane]) - mean) * rstd * g1[h] + be1[h];
            const unsigned pk = cvt_pk_bf16(y0, y1);
            VT[(h * 128 + lane) * 132 + pl] = (bf16_t)(pk & 0xffffu); VT[(h * 128 + 64 + lane) * 132 + pl] = (bf16_t)(pk >> 16); } }
    __syncthreads();
#pragma unroll
    for (int h = 0; h < GM_NH; ++h) { const int e = e0 + h;
        f32x4 acc[8];
#pragma unroll
        for (int cb = 0; cb < 8; ++cb) acc[cb] = (f32x4){0.f, 0.f, 0.f, 0.f};
#pragma unroll
        for (int ks = 0; ks < 4; ++ks)
#pragma unroll
            for (int cb = 0; cb < 8; ++cb) { const bf16_t* vp = VT + (h * 128 + cb * 16 + fr) * 132 + ks * 32 + fq * 8; const u32x2 lo = *(const u32x2*)vp, hi = *(const u32x2*)(vp + 4);
                u32x4 t; t.x = lo.x; t.y = lo.y; t.z = hi.x; t.w = hi.y;
                acc[cb] = __builtin_amdgcn_mfma_f32_16x16x32_bf16(__builtin_bit_cast(bf16x8, t), wf[h][ks], acc[cb], 0, 0, 0); }
#pragma unroll
        for (int cb = 0; cb < 8; ++cb) { const int c = cb * 16 + 4 * fq;
            const float u0 = lo_bf(uu[h][cb].x), u1 = hi_bf(uu[h][cb].x), u2 = lo_bf(uu[h][cb].y), u3 = hi_bf(uu[h][cb].y);
            u32x2 o; o.x = cvt_pk_bf16(u0 * (acc[cb][0] + bq[h]), u1 * (acc[cb][1] + bq[h])); o.y = cvt_pk_bf16(u2 * (acc[cb][2] + bq[h]), u3 * (acc[cb][3] + bq[h]));
            *(u32x2*)(MIX + qrow * D_MODEL + MIX_GM + e * 128 + c) = o; } }
    __syncthreads();
}

__device__ void fft_item(const Params& p, int l, int cp, unsigned char* smem) {
    const int tid = tid_l(); const int c0 = 2 * cp;
    float2* B0 = (float2*)smem;
    const float* ZT = (const float*)(p.ws + OFF_ZT) + (size_t)c0 * 8192; const float* X0T = (const float*)(p.ws + OFF_X0T) + (size_t)c0 * 8192;
    const float rf = (float)tid * (1.0f / 8192.0f);
#pragma unroll
    for (int ch = 0; ch < 2; ++ch) { float2 x[16]; float2* B = B0 + ch * FFT_BUF; const float* z = ZT + ch * 8192 + tid;
#pragma unroll
        for (int k = 0; k < 8; ++k) { x[k] = make_float2(z[512 * k], z[4096 + 512 * k]); x[k + 8] = make_float2(0.f, 0.f); }
        radix16<false>(x, rf);
#pragma unroll
        for (int k = 0; k < 16; ++k) B[phys(tid + 512 * k)] = x[k]; }
    __syncthreads();
    { const float r2 = launder_f((float)(tid & 31) * (1.0f / 512.0f));
#pragma unroll
      for (int ch = 0; ch < 2; ++ch) fft_pass2<false>(B0 + ch * FFT_BUF, tid, r2); }
    __syncthreads();
    { const int blk = tid & 255, ch = tid >> 8; float2* B = B0 + ch * FFT_BUF + blk * 33; float2 y[32];
#pragma unroll
      for (int k = 0; k < 32; ++k) y[k] = B[k];
      radix32<false>(y);
      const float2* KF = (const float2*)(p.ws + OFF_KF) + ((size_t)l * 768 + c0 + ch) * 8192 + blk * 2;
#pragma unroll
      for (int k = 0; k < 32; k += 2) { const float4 kq = *(const float4*)(KF + (k >> 1) * 512);
          y[k] = make_float2(y[k].x * kq.x - y[k].y * kq.y, y[k].x * kq.y + y[k].y * kq.x); y[k + 1] = make_float2(y[k + 1].x * kq.z - y[k + 1].y * kq.w, y[k + 1].x * kq.w + y[k + 1].y * kq.z); }
      radix32<true>(y);
#pragma unroll
      for (int k = 0; k < 32; ++k) B[k] = y[k]; }
    __syncthreads();
    { const float r2 = launder_f((float)(tid & 31) * (1.0f / 512.0f));
#pragma unroll
      for (int ch = 0; ch < 2; ++ch) fft_pass2<true>(B0 + ch * FFT_BUF, tid, r2); }
    __syncthreads();
    bf16_t* MIX = (bf16_t*)(p.ws + OFF_MIX);
    const float2 dsk = *(const float2*)(inp(15) + l * 768 + c0);
    const float rfi = launder_f(rf);
    { unsigned long long zp = (unsigned long long)ZT; asm volatile("" : "+s"(zp)); ZT = (const float*)zp; }
#pragma unroll 1
    for (int ch = 0; ch < 2; ++ch) { float2 x[16]; float2* B = B0 + ch * FFT_BUF;
#pragma unroll
        for (int k = 0; k < 16; ++k) x[k] = B[phys(tid + 512 * k)];
        radix16<true>(x, rfi);
        const float d = ch ? dsk.y : dsk.x; const float* z = ZT + ch * 8192 + tid; const float* x0 = X0T + ch * 8192 + tid;
        if (ch == 0) {
#pragma unroll
            for (int k = 0; k < 8; ++k) B0[phys(tid + 512 * k)] = make_float2(x0[512 * k] * (x[k].x + d * z[512 * k]), x0[4096 + 512 * k] * (x[k].y + d * z[4096 + 512 * k]));
        } else {
#pragma unroll
            for (int k = 0; k < 8; ++k) { const int t = tid + 512 * k; const float2 r0 = B0[phys(t)];
                const float r1a = x0[512 * k] * (x[k].x + d * z[512 * k]), r1b = x0[4096 + 512 * k] * (x[k].y + d * z[4096 + 512 * k]);
                *(unsigned*)(MIX + (size_t)t * D_MODEL + MIX_HY + c0) = cvt_pk_bf16(r0.x, r1a);
                *(unsigned*)(MIX + (size_t)(4096 + t) * D_MODEL + MIX_HY + c0) = cvt_pk_bf16(r0.y, r1b); }
        } }
    __syncthreads();
}

__device__ void convact_phase(const Params& p, int l) {
    const bf16_t* UP = (const bf16_t*)(p.ws + OFF_UP); bf16_t* ACT = (bf16_t*)(p.ws + OFF_ACT);
    const float* cw = inp(23) + (size_t)l * 3 * D_UP; const float* cb = inp(24) + (size_t)l * D_UP;
    const int nthr = gridDim.x * 512;
    const int tid = tid_l();
    for (int idx = blockIdx.x * 512 + tid; idx < 704 * 512; idx += nthr) {
        const int cg8 = idx % 704, run = idx / 704; const int j = cg8 >> 4, i8 = (cg8 & 15) * 8;
        const int ncol = j * 128 + i8;
        float wg[3][8], wv[3][8], bg[8], bv[8];
#pragma unroll
        for (int k = 0; k < 3; ++k) { const float4 a = *(const float4*)(cw + k * D_UP + ncol), b = *(const float4*)(cw + k * D_UP + ncol + 4);
            wg[k][0] = a.x; wg[k][1] = a.y; wg[k][2] = a.z; wg[k][3] = a.w; wg[k][4] = b.x; wg[k][5] = b.y; wg[k][6] = b.z; wg[k][7] = b.w;
            const float4 c = *(const float4*)(cw + k * D_UP + D_FF + ncol), d = *(const float4*)(cw + k * D_UP + D_FF + ncol + 4);
            wv[k][0] = c.x; wv[k][1] = c.y; wv[k][2] = c.z; wv[k][3] = c.w; wv[k][4] = d.x; wv[k][5] = d.y; wv[k][6] = d.z; wv[k][7] = d.w; }
        { const float4 a = *(const float4*)(cb + ncol), b = *(const float4*)(cb + ncol + 4); bg[0] = a.x; bg[1] = a.y; bg[2] = a.z; bg[3] = a.w; bg[4] = b.x; bg[5] = b.y; bg[6] = b.z; bg[7] = b.w;
          const float4 c = *(const float4*)(cb + D_FF + ncol), d = *(const float4*)(cb + D_FF + ncol + 4); bv[0] = c.x; bv[1] = c.y; bv[2] = c.z; bv[3] = c.w; bv[4] = d.x; bv[5] = d.y; bv[6] = d.z; bv[7] = d.w; }
        const int r0 = run * 16; const size_t colg = (size_t)j * 256 + i8, colv = colg + 128;
        u32x4 gm = (u32x4){0u, 0u, 0u, 0u}, vm = gm, gc, vc, gn, vn;
        if ((r0 & (SEQ - 1)) != 0) { gm = *(const u32x4*)(UP + (size_t)(r0 - 1) * D_UP + colg); vm = *(const u32x4*)(UP + (size_t)(r0 - 1) * D_UP + colv); }
        gc = *(const u32x4*)(UP + (size_t)r0 * D_UP + colg); vc = *(const u32x4*)(UP + (size_t)r0 * D_UP + colv);
        for (int r = r0; r < r0 + 16; ++r) {
            if ((r & (SEQ - 1)) != SEQ - 1) { gn = *(const u32x4*)(UP + (size_t)(r + 1) * D_UP + colg); vn = *(const u32x4*)(UP + (size_t)(r + 1) * D_UP + colv); }
            else { gn = (u32x4){0u, 0u, 0u, 0u}; vn = gn; }
            float o[8];
#pragma unroll
            for (int q = 0; q < 4; ++q) {
                const float ga = wg[0][2 * q] * lo_bf(gm[q]) + wg[1][2 * q] * lo_bf(gc[q]) + wg[2][2 * q] * lo_bf(gn[q]) + bg[2 * q];
                const float gb = wg[0][2 * q + 1] * hi_bf(gm[q]) + wg[1][2 * q + 1] * hi_bf(gc[q]) + wg[2][2 * q + 1] * hi_bf(gn[q]) + bg[2 * q + 1];
                const float va = wv[0][2 * q] * lo_bf(vm[q]) + wv[1][2 * q] * lo_bf(vc[q]) + wv[2][2 * q] * lo_bf(vn[q]) + bv[2 * q];
                const float vb = wv[0][2 * q + 1] * hi_bf(vm[q]) + wv[1][2 * q + 1] * hi_bf(vc[q]) + wv[2][2 * q + 1] * hi_bf(vn[q]) + bv[2 * q + 1];
                o[2 * q] = silu(ga) * va; o[2 * q + 1] = silu(gb) * vb; }
            u32x4 ow; ow.x = cvt_pk_bf16(o[0], o[1]); ow.y = cvt_pk_bf16(o[2], o[3]); ow.z = cvt_pk_bf16(o[4], o[5]); ow.w = cvt_pk_bf16(o[6], o[7]);
            *(u32x4*)(ACT + (size_t)r * D_FF + ncol) = ow;
            gm = gc; vm = vc; gc = gn; vc = vn;
        }
    }
}

__global__ void __launch_bounds__(512, 2) fwd_megakernel(Params p) {
    extern __shared__ __attribute__((aligned(16))) unsigned char smem[];
    cg::grid_group grid = cg::this_grid();
    const int G = gridDim.x, bid = blockIdx.x;
    int step = 0;
    if (p.ph_hi < 0) grid.sync();
    volatile LAS unsigned* xst = (volatile LAS unsigned*)(LAS unsigned char*)(smem + LDS_BYTES - 16);
    if (threadIdx.x < 4) xst[threadIdx.x] = 0u;
    __syncthreads();
    XcdBarrier xb = xcd_barrier_post((unsigned*)(p.ws + OFF_BAR), xst);
#define STEP_BEGIN if (step >= p.ph_lo && step < p.ph_hi) {
#define STEP_END } ++step; if (step > p.ph_lo && step < p.ph_hi) xcd_barrier(xb);

    bf16_t* H = (bf16_t*)(p.ws + OFF_H);
    bf16_t* XA = (bf16_t*)(p.ws + OFF_XA);
#if PROBE == 6
    for (int i = 0; i < 20; ++i) xcd_barrier(xb);
#endif

    STEP_BEGIN
        for (int it = bid; it < NI_FILT; it += G) filter_item(p, it, (float*)smem);
        convert_range4(p, 0, 0, NI_IN / 4, bid, G, (float*)smem);
        convert_range(p, 1, 0, R_POOL, NI_POOL, bid, G, (float*)smem); convert_range(p, 1, 1, R_POOL, NI_POOL, bid, G, (float*)smem);
        if (bid < 3) { const int zr = bid == 0 ? 0 : (bid == 1 ? 4097 : 8194); for (int i = tid_l(); i < D_MODEL / 2; i += 512) ((unsigned*)(H + (size_t)zr * D_MODEL))[i] = 0u; }
        norm_phase<true>(inp(0), inp(1), H, nullptr);
    STEP_END

    for (int l = 0; l < 2; ++l) {
        STEP_BEGIN
            pg8::Gemm g{H + D_MODEL, (const bf16_t*)(p.ws + OFF_WT_IN + l * SZ_WT_IN), NTOK, D_INP, D_MODEL}; pg8::StaticOrder S; S.init(NTOK, D_INP, G, bid);
            pg8::EpiBf16Gm E{(bf16_t*)(p.ws + OFF_P), D_INP, (float*)(p.ws + OFF_STATS) + (size_t)l * NTOK * 24};
            pg8::gemm_phase<pg8::EpiBf16Gm, pg8::StaticOrder, D_MODEL>((LAS unsigned char*)smem, g, S, E);
            { const int rem = (NTOK / 256) * (D_INP / 256) % G;
              if (bid >= rem) for (int rep_ = 0; rep_ < (PROBE == 11 ? 2 : 1); ++rep_) {
                  if (l == 0) { for (int it = bid - rem; it < 768; it += G - rem) kf_item(p, it, smem); convert_range4(p, 1, 0, NI_IN / 4, bid - rem, G - rem, (float*)smem); convert_range4(p, 0, R_DN + NT3, (NI_DN - NT3) / 4, bid - rem, G - rem, (float*)smem); }
                  else { convert_range4(p, 1, R_OUT, (NI_OUT + NI_UP) / 4, bid - rem, G - rem, (float*)smem); convert_range4(p, 1, R_DN + NT3, (NI_DN - NT3) / 4, bid - rem, G - rem, (float*)smem); } } }
        STEP_END
        STEP_BEGIN
            for (int it = bid; it < 768; it += G) hypre_item(p, l, it, smem);
        STEP_END
        STEP_BEGIN
            for (int rep_ = 0; rep_ < (PROBE == 13 ? 2 : 1); ++rep_) {
            unsigned* wq = (unsigned*)(p.ws + OFF_BAR) + 3500 + l + 8 * rep_;
            for (;;) {
                __syncthreads();
                if (threadIdx.x == 0) xst[2] = atomicAdd(wq, 1u);
                __syncthreads();
                const int it = __builtin_amdgcn_readfirstlane((int)xst[2]);
                constexpr int NCH = (NI_OUT + NI_UP) / 8, NMIX = 384 + 128 + 256;
                int mi = it, ch = -1;
                if (l == 0 && it >= NMIX) { ch = it - NMIX; mi = -1; }
                if (l == 0 ? it >= NMIX + NCH : it >= NMIX) break;
                if (ch >= 0) { if (ch < NCH) convert_range4(p, 0, R_OUT + ch * 8, 2, 0, 1, (float*)smem); }
                else if (mi < 384) fft_item(p, l, mi, smem); else if (mi < 512) gmlp_item(p, l, mi - 384, smem); else pool_item(p, l, mi - 512, smem);
            }
            }
#if PROBE == 21
            for (int it = bid; it < 256; it += G) pool_item(p, l, it, smem);
#elif PROBE == 22
            for (int it = bid; it < 128; it += G) gmlp_item(p, l, it, smem);
#elif PROBE == 3
            for (int it = bid; it < 384; it += G) fft_item(p, l, it, smem);
#endif
        STEP_END
        STEP_BEGIN
            pg8::Gemm g{(const bf16_t*)(p.ws + OFF_MIX), (const bf16_t*)(p.ws + OFF_WT_OUT + l * SZ_WT_OUT), NTOK, D_MODEL, D_MODEL}; pg8::StaticOrder S; S.init(NTOK, D_MODEL, G, bid); S.wgm = 4;
            float* ssp = (float*)(p.ws + OFF_SSP) + (size_t)(2 * l) * NTOK * 32; unsigned* pc = (unsigned*)(p.ws + OFF_BAR) + 3600 + 64 * l;
            if (l == 0) { pg8::EpiResNorm<true, false> E{XA, inp(0), D_MODEL, inp(21) + l * D_MODEL, H, nullptr, ssp, pc}; pg8::gemm_phase<pg8::EpiResNorm<true, false>, pg8::StaticOrder, D_MODEL>((LAS unsigned char*)smem, g, S, E); }
            else { pg8::EpiResNorm<false, false> E{XA, XA, D_MODEL, inp(21) + l * D_MODEL, H, nullptr, ssp, pc}; pg8::gemm_phase<pg8::EpiResNorm<false, false>, pg8::StaticOrder, D_MODEL>((LAS unsigned char*)smem, g, S, E); }
        STEP_END
        STEP_BEGIN
            pg8::Gemm g{H, (const bf16_t*)(p.ws + OFF_WT_UP + l * SZ_WT_UP), NTOK, D_UP, D_MODEL}; pg8::StaticOrder S; S.init_tiles(34, D_UP / 256, G, bid);
            pg8::EpiConvAct E{(bf16_t*)(p.ws + OFF_ACT), inp(23) + (size_t)l * 3 * D_UP, inp(24) + (size_t)l * D_UP};
            pg8::gemm_phase<pg8::EpiConvAct, pg8::StaticOrder, D_MODEL>((LAS unsigned char*)smem, g, S, E);
#if PROBE == 7
            pg8::gemm_phase<pg8::EpiConvAct, pg8::StaticOrder, D_MODEL>((LAS unsigned char*)smem, g, S, E);
#endif
            { const int rem = (34 * (D_UP / 256)) % G; if (bid >= rem) convert_range4(p, l, R_DN, NT3 / 4, bid - rem, G - rem, (float*)smem); }
        STEP_END
        STEP_BEGIN
            pg8::Gemm g{(const bf16_t*)(p.ws + OFF_ACT), (const bf16_t*)(p.ws + OFF_WT_DN + l * SZ_WT_DN), NTOK, D_MODEL, D_FF}; pg8::StaticOrder S; S.init(NTOK, D_MODEL, G, bid); S.wgm = 4;
            float* ssp = (float*)(p.ws + OFF_SSP) + (size_t)(2 * l + 1) * NTOK * 32; unsigned* pc = (unsigned*)(p.ws + OFF_BAR) + 3600 + 64 * l + 32;
            if (l == 0) { pg8::EpiResNorm<false, false> E{XA, XA, D_MODEL, inp(1) + D_MODEL, H, nullptr, ssp, pc}; pg8::gemm_phase<pg8::EpiResNorm<false, false>, pg8::StaticOrder, D_FF>((LAS unsigned char*)smem, g, S, E); }
            else { pg8::EpiResNorm<false, true> E{XA, XA, D_MODEL, inp(26), nullptr, p.out, ssp, pc}; pg8::gemm_phase<pg8::EpiResNorm<false, true>, pg8::StaticOrder, D_FF>((LAS unsigned char*)smem, g, S, E); }
        STEP_END
    }
}

constexpr int N_STEPS = 13;
#ifndef MULTI_LAUNCH
#define MULTI_LAUNCH 0
#endif

extern "C" void kernel_launch(void* const* d_in, const int* in_sizes, int n_in, void* d_out, int out_size, void* d_ws, size_t ws_size, hipStream_t stream) {
    static int grid = 0;
    if (grid == 0) {
        if (n_in != 27 || ws_size < WS_END) { fprintf(stderr, "kernel_launch: need 27 inputs and %zu bytes of workspace (got %d, %zu)\n", (size_t)WS_END, n_in, ws_size); grid = -1; return; }
        int dev = 0, cus = 0, per_cu = 0;
        hipGetDevice(&dev); hipDeviceGetAttribute(&cus, hipDeviceAttributeMultiprocessorCount, dev);
        if (hipFuncSetAttribute((const void*)fwd_megakernel, hipFuncAttributeMaxDynamicSharedMemorySize, LDS_BYTES) != hipSuccess) { fprintf(stderr, "kernel_launch: hipFuncSetAttribute failed\n"); grid = -1; return; }
        if (hipOccupancyMaxActiveBlocksPerMultiprocessor(&per_cu, (const void*)fwd_megakernel, 512, LDS_BYTES) != hipSuccess || per_cu < 1) { fprintf(stderr, "kernel_launch: occupancy query gave %d\n", per_cu); per_cu = 1; }
        (void)hipGetLastError();
        grid = cus * 1;
    }
    if (grid < 0) return;
    if (hipMemsetAsync((char*)d_ws + OFF_BAR, 0, 16384, stream) != hipSuccess) { fprintf(stderr, "kernel_launch: memset failed\n"); return; }
    Params p{};
    for (int i = 0; i < 27; ++i) p.in[i] = (const float*)d_in[i];
    p.out = (float*)d_out; p.ws = (unsigned char*)d_ws;
#if MULTI_LAUNCH
    for (int s = 0; s < N_STEPS; ++s) { p.ph_lo = s; p.ph_hi = s + 1; hipLaunchKernelGGL(fwd_megakernel, dim3(grid), dim3(512), LDS_BYTES, stream, p); }
#else
    p.ph_lo = 0; p.ph_hi = N_STEPS;
    void* args[] = {&p};
    hipError_t e = hipLaunchCooperativeKernel((const void*)fwd_megakernel, dim3(grid), dim3(512), args, LDS_BYTES, stream);
    if (e != hipSuccess) fprintf(stderr, "cooperative launch failed: %s (grid %d)\n", hipGetErrorString(e), grid);
#endif
}
```

```cpp
#include <hip/hip_runtime.h>
#include <hip/hip_cooperative_groups.h>
#include <cstdio>
namespace cg = cooperative_groups;

#define LAS __attribute__((address_space(3)))
typedef unsigned short bf16_t;
typedef short bf16x8 __attribute__((ext_vector_type(8)));
typedef float f32x4 __attribute__((ext_vector_type(4)));
typedef unsigned u32x4 __attribute__((ext_vector_type(4)));
typedef unsigned u32x2 __attribute__((ext_vector_type(2)));

constexpr int D_MODEL = 2048, SEQ = 4096, NTOK = 8192, D_INP = 4352, D_FF = 5632, D_UP = 11264;
constexpr int D_HY = 768, D_GM = 768;
constexpr int COL_HY = 512, COL_GM = 2816;
constexpr int MIX_HY = 512, MIX_GM = 1280;

constexpr size_t SZ_WT_IN = (size_t)D_INP * D_MODEL * 2, SZ_WT_OUT = (size_t)D_MODEL * D_MODEL * 2, SZ_WT_UP = (size_t)D_UP * D_MODEL * 2, SZ_WT_DN = (size_t)D_MODEL * D_FF * 2;
constexpr size_t SZ_POOLWT = 4 * 128 * 128 * 2, SZ_KF = (size_t)768 * 8192 * 8, SZ_H2 = (size_t)4096 * 64 * 4, SZ_STATS = (size_t)NTOK * 12 * 2 * 4;
constexpr size_t OFF_WT_IN = 0;
constexpr size_t OFF_WT_OUT = OFF_WT_IN + 2 * SZ_WT_IN;
constexpr size_t OFF_WT_UP = OFF_WT_OUT + 2 * SZ_WT_OUT;
constexpr size_t OFF_WT_DN = OFF_WT_UP + 2 * SZ_WT_UP;
constexpr size_t OFF_POOLWT = OFF_WT_DN + 2 * SZ_WT_DN;
constexpr size_t OFF_KF = OFF_POOLWT + 2 * SZ_POOLWT;
constexpr size_t OFF_H2 = OFF_KF + 2 * SZ_KF;
constexpr size_t OFF_STATS = OFF_H2 + 2 * SZ_H2;
constexpr size_t OFF_XA = OFF_STATS + 2 * SZ_STATS;
constexpr size_t OFF_H = OFF_XA + (size_t)NTOK * D_MODEL * 4;
constexpr size_t OFF_R1 = OFF_H + (size_t)(NTOK + 512) * D_MODEL * 2;
constexpr size_t OFF_P = OFF_R1;
constexpr size_t OFF_MIX = OFF_P + (size_t)NTOK * D_INP * 2;
constexpr size_t OFF_ZT = OFF_MIX + (size_t)NTOK * D_MODEL * 2;
constexpr size_t OFF_X0T = OFF_ZT + (size_t)768 * 8192 * 4;
constexpr size_t OFF_UP = OFF_R1;
constexpr size_t OFF_ACT = OFF_R1 + (size_t)NTOK * D_UP * 2;
constexpr size_t OFF_BAR = OFF_ACT + (size_t)NTOK * D_FF * 2;
constexpr size_t OFF_SSP = OFF_BAR + 16384;
constexpr size_t WS_END = OFF_SSP + (size_t)4 * NTOK * 32 * 4;
static_assert(OFF_X0T + (size_t)768 * 8192 * 4 <= OFF_ACT, "alias region");

constexpr int LDS_BYTES = 139264;
#ifndef PROBE
#define PROBE 0
#endif
#define REP(k) for (int rep_ = 0; rep_ < ((PROBE == (k)) ? 2 : 1); ++rep_)

struct Params {
    const float* in[27];
    float* out;
    unsigned char* ws;
    int ph_lo, ph_hi;
};


__device__ __forceinline__ const float* inp(int i) {
    const __attribute__((address_space(4))) char* ka = (const __attribute__((address_space(4))) char*)__builtin_amdgcn_kernarg_segment_ptr();
    int off = i * 8; asm volatile("" : "+s"(off));
    return *(const float* const __attribute__((address_space(4)))*)(ka + off);
}

__device__ __forceinline__ int tid_l() { int t = threadIdx.x; asm volatile("" : "+v"(t)); return t; }
__device__ __forceinline__ float bf2f(bf16_t b) { return __uint_as_float(((unsigned)b) << 16); }
__device__ __forceinline__ unsigned cvt_pk_bf16(float lo, float hi) { unsigned r; asm volatile("v_cvt_pk_bf16_f32 %0, %1, %2" : "=v"(r) : "v"(lo), "v"(hi)); return r; }
__device__ __forceinline__ float lo_bf(unsigned u) { return __uint_as_float(u << 16); }
__device__ __forceinline__ float hi_bf(unsigned u) { return __uint_as_float(u & 0xffff0000u); }
__device__ __forceinline__ float gelu_tanh(float x) {
    const float y2 = 1.5957691216f * (x + 0.044715f * x * x * x);
    return x * __builtin_amdgcn_rcpf(1.0f + __expf(-y2));
}
__device__ __forceinline__ float silu(float x) { return x * __builtin_amdgcn_rcpf(1.0f + __expf(-x)); }
__device__ __forceinline__ float wave_sum(float v) {
#pragma unroll
    for (int o = 32; o > 0; o >>= 1) v += __shfl_xor(v, o, 64);
    return v;
}

#define XB_TMO      128
#define XB_XCNT(j)  (256  + 64 * (j))
#define XB_XSUB(j)  (1280 + 64 * (j))
#define XB_XGEN(j)  (2304 + 64 * (j))
#define XB_TOP      3328
#define XB_TOPGEN   3392
#define XCD_BAR_WORDS 3456
#define XB_SPIN_CAP (1u << 18)

__device__ __forceinline__ unsigned xb_ld(unsigned* p)              { return __hip_atomic_load(p, __ATOMIC_RELAXED, __HIP_MEMORY_SCOPE_AGENT); }
__device__ __forceinline__ unsigned xb_add(unsigned* p, unsigned v) { return __hip_atomic_fetch_add(p, v, __ATOMIC_RELAXED, __HIP_MEMORY_SCOPE_AGENT); }
__device__ __forceinline__ unsigned xb_xcc_id() { return (unsigned)__builtin_amdgcn_s_getreg((3 << 11) | 20) & 0xFu; }
#define XB_SPIN(cond, bar) do { unsigned _sp = 0; while (cond) { __builtin_amdgcn_s_sleep(1); \
    if ((++_sp & 255u) == 0u) { if (xb_ld(&(bar)[XB_TMO])) break; if (_sp > XB_SPIN_CAP) { atomicAdd(&(bar)[XB_TMO], 1u); break; } } } } while (0)

struct XcdBarrier {
    unsigned* bar; unsigned x;
    volatile LAS unsigned* st;
};

__device__ __forceinline__ XcdBarrier xcd_barrier_post(unsigned* bar, volatile LAS unsigned* st) {
    XcdBarrier b; b.bar = bar; b.x = xb_xcc_id(); b.st = st;
    if (threadIdx.x == 0) (void)xb_add(&bar[XB_XCNT(b.x)], 1u);
    return b;
}
__device__ __forceinline__ void xcd_barrier_complete(unsigned* bar, unsigned x, unsigned& nloc, unsigned& nx) {
    const unsigned G = gridDim.x * gridDim.y * gridDim.z;
    unsigned sum, cnt, mine, sp = 0u;
    for (;;) {
        sum = 0u; cnt = 0u; mine = 0u;
#pragma unroll
        for (unsigned j = 0; j < 16; ++j) { const unsigned c = xb_ld(&bar[XB_XCNT(j)]); sum += c; cnt += (c > 0u) ? 1u : 0u; mine = (j == x) ? c : mine; }
        if (sum == G) break;
        __builtin_amdgcn_s_sleep(1);
        if ((++sp & 255u) == 0u) { if (xb_ld(&bar[XB_TMO])) break; if (sp > XB_SPIN_CAP) { atomicAdd(&bar[XB_TMO], 1u); break; } }
    }
    nloc = mine > 0u ? mine : 1u; nx = cnt > 0u ? cnt : 1u;
}

__device__ __forceinline__ void xcd_barrier(const XcdBarrier& b) {
    asm volatile("s_waitcnt vmcnt(0)" ::: "memory");
    __syncthreads();
    if (threadIdx.x == 0) {
        unsigned* bar = b.bar;
        __builtin_amdgcn_s_waitcnt(0);
        unsigned nloc = b.st[0], nx = b.st[1];
        if (nloc == 0u) { xcd_barrier_complete(bar, b.x, nloc, nx); b.st[0] = nloc; b.st[1] = nx; }
        const unsigned old = xb_add(&bar[XB_XSUB(b.x)], 1u);
        const unsigned gen = old / nloc;
        if (old + 1u == (gen + 1u) * nloc) {
            __builtin_amdgcn_fence(__ATOMIC_RELEASE, "agent");
            asm volatile("s_waitcnt vmcnt(0)" ::: "memory");
            const unsigned og = xb_add(&bar[XB_TOP], 1u);
            const unsigned tg = og / nx;
            if (og + 1u == (tg + 1u) * nx) xb_add(&bar[XB_TOPGEN], 1u);
            else XB_SPIN(xb_ld(&bar[XB_TOPGEN]) == tg, bar);
            __builtin_amdgcn_fence(__ATOMIC_ACQUIRE, "agent");
            xb_add(&bar[XB_XGEN(b.x)], 1u);
            asm volatile("s_waitcnt vmcnt(0)" ::: "memory");
        } else {
            XB_SPIN(xb_ld(&bar[XB_XGEN(b.x)]) == gen, bar);
            __builtin_amdgcn_fence(__ATOMIC_ACQUIRE, "agent");
            asm volatile("s_waitcnt vmcnt(0)" ::: "memory");
        }
    }
    __syncthreads();
}


namespace pg8 {
constexpr int BM = 256, BK = 64, HALF = 128, HTB = HALF * BK * 2, STAGE_BYTES = 8 * HTB, NXCD = 8, WGM = 8;
__host__ __device__ __forceinline__ int lds_byte(int r, int c) { const int st = (r >> 4) * 2 + (c >> 5), rr = r & 15, cc = c & 31, ob = rr * 64 + cc * 2; return st * 1024 + (ob ^ (((ob >> 9) & 1) << 5)); }
__host__ __device__ __forceinline__ void stage_rc(int b, int& R, int& C) { const int st = b / 1024, sb = b % 1024, swz = sb ^ (((sb >> 9) & 1) << 5); R = (st >> 1) * 16 + swz / 64; C = (st & 1) * 32 + (swz % 64) / 2; }
__host__ __device__ __forceinline__ int perm32(int rho) { const int n = rho >> 4, i = rho & 15; return 8 * (i >> 2) + 4 * n + (i & 3); }
struct Unit { int pm, pn; };
struct Gemm { const bf16_t* A; const bf16_t* Bt; int M, N, K; };
struct StaticOrder {
    int nM, nN, nwg, G, c, wgm = WGM;
    __device__ void init(int M, int N, int G_, int c_) { nM = M / BM; nN = N / BM; nwg = nM * nN; G = G_; c = c_; }
    __device__ void init_tiles(int nM_, int nN_, int G_, int c_) { nM = nM_; nN = nN_; nwg = nM * nN; G = G_; c = c_; }
    __device__ bool next(int i, Unit& u) const {
        const long L = (long)i * G + c; if (L >= nwg) return false;
        int wgid = (int)L; { const int q = nwg / NXCD, r = nwg % NXCD, xcd = wgid % NXCD, off = wgid / NXCD; wgid = (xcd < r ? xcd * (q + 1) : r * (q + 1) + (xcd - r) * q) + off; }
        const int nig = wgm * nN, gid = wgid / nig, fm = gid * wgm, gsz = (nM - fm) < wgm ? (nM - fm) : wgm;
        u.pm = fm + ((wgid % nig) % gsz); u.pn = (wgid % nig) / gsz; return true;
    }
};
struct EpiBf16 {
    static constexpr bool PERM = true, CONV = false, AFTER_DRAIN = false; static constexpr int GAPA = 0;
    bf16_t* O; int ldc;
    __device__ __forceinline__ void operator()(const f32x4 (&acc)[2][2][4][2], const Unit& u, int wr, int wc, int fr, int fq) const {
        const int row0 = u.pm * BM + wr * 64 + fr; const int col0 = u.pn * BM + wc * 32 + 8 * fq;
#pragma unroll
        for (int ai = 0; ai < 2; ++ai)
#pragma unroll
            for (int m = 0; m < 4; ++m) { bf16_t* rowp = O + (size_t)(row0 + ai * HALF + m * 16) * ldc + col0;
#pragma unroll
                for (int bj = 0; bj < 2; ++bj) { const f32x4 v0 = acc[ai][bj][m][0], v1 = acc[ai][bj][m][1];
                    u32x4 w; w.x = cvt_pk_bf16(v0[0], v0[1]); w.y = cvt_pk_bf16(v0[2], v0[3]); w.z = cvt_pk_bf16(v1[0], v1[1]); w.w = cvt_pk_bf16(v1[2], v1[3]);
                    *(u32x4*)(rowp + bj * HALF) = w; } }
    }
};
struct EpiBf16Gm {
    static constexpr bool PERM = true, CONV = false, AFTER_DRAIN = false; static constexpr int GAPA = D_MODEL * 2;
    bf16_t* O; int ldc; float* stats;
    __device__ __forceinline__ void operator()(const f32x4 (&acc)[2][2][4][2], const Unit& u, int wr, int wc, int fr, int fq) const {
        const int row0 = u.pm * BM + wr * 64 + fr; const int col0 = u.pn * BM + wc * 32 + 8 * fq;
        const bool act = u.pn >= 11, st = u.pn >= 14;
#pragma unroll
        for (int ai = 0; ai < 2; ++ai)
#pragma unroll
            for (int m = 0; m < 4; ++m) { const int row = row0 + ai * HALF + m * 16; bf16_t* rowp = O + (size_t)row * ldc + col0; float s1 = 0.f, s2 = 0.f;
#pragma unroll
                for (int bj = 0; bj < 2; ++bj) { f32x4 v0 = acc[ai][bj][m][0], v1 = acc[ai][bj][m][1];
                    if (act) {
#pragma unroll
                        for (int j = 0; j < 4; ++j) { v0[j] = gelu_tanh(v0[j]); v1[j] = gelu_tanh(v1[j]); s1 += v0[j] + v1[j]; s2 += v0[j] * v0[j] + v1[j] * v1[j]; } }
                    u32x4 w; w.x = cvt_pk_bf16(v0[0], v0[1]); w.y = cvt_pk_bf16(v0[2], v0[3]); w.z = cvt_pk_bf16(v1[0], v1[1]); w.w = cvt_pk_bf16(v1[2], v1[3]);
                    *(u32x4*)(rowp + bj * HALF) = w; }
                if (st) { s1 += __shfl_xor(s1, 16, 64); s2 += __shfl_xor(s2, 16, 64); s1 += __shfl_xor(s1, 32, 64); s2 += __shfl_xor(s2, 32, 64);
                    if (fq == 0) *(float2*)(stats + ((size_t)row * 12 + (u.pn - 14) * 4 + wc) * 2) = make_float2(s1, s2); } }
    }
};
__device__ __forceinline__ float dpp_ror1(float v) { return __builtin_bit_cast(float, __builtin_amdgcn_mov_dpp(__builtin_bit_cast(int, v), 0x121, 0xf, 0xf, true)); }
__device__ __forceinline__ float dpp_rol1(float v) { return __builtin_bit_cast(float, __builtin_amdgcn_mov_dpp(__builtin_bit_cast(int, v), 0x12F, 0xf, 0xf, true)); }
struct EpiConvAct {
    static constexpr bool PERM = true, CONV = true, AFTER_DRAIN = false; static constexpr int GAPA = 0;
    bf16_t* ACT; const float* cw; const float* cb;
    __device__ __forceinline__ void operator()(const f32x4 (&acc)[2][2][4][2], const Unit& u, int wr, int wc, int fr, int fq) const {
        const bool f0 = fr == 0, f15 = fr == 15;
#pragma unroll
        for (int n = 0; n < 2; ++n) {
            const int cg = 128 * u.pn + 32 * wc + 8 * fq + 4 * n;
            f32x4 wg[3], wv[3];
#pragma unroll
            for (int k = 0; k < 3; ++k) { wg[k] = *(const f32x4*)(cw + k * D_UP + cg); wv[k] = *(const f32x4*)(cw + k * D_UP + D_FF + cg); }
            const f32x4 bg = *(const f32x4*)(cb + cg), bv = *(const f32x4*)(cb + D_FF + cg);
#pragma unroll
            for (int ai = 0; ai < 2; ++ai) { const int pbase = 248 * u.pm + 62 * (2 * ai + wr);
                float rpg[4], rpv[4], lcg[4], lcv[4];
#pragma unroll
                for (int j = 0; j < 4; ++j) { rpg[j] = 0.f; rpv[j] = 0.f; lcg[j] = dpp_rol1(acc[ai][0][0][n][j]); lcv[j] = dpp_rol1(acc[ai][1][0][n][j]); }
#pragma unroll
                for (int m = 0; m < 4; ++m) { const int q = 16 * m + fr, pr = pbase + q; const int G = pr - 1 - (pr > 4097 ? 1 : 0);
                    const f32x4 gc = acc[ai][0][m][n], vc = acc[ai][1][m][n]; float o[4];
#pragma unroll
                    for (int j = 0; j < 4; ++j) {
                        const float rg = dpp_ror1(gc[j]), rv = dpp_ror1(vc[j]);
                        const float gp = (m > 0 && f0) ? rpg[j] : rg, vp = (m > 0 && f0) ? rpv[j] : rv;
                        float gn = lcg[j], vn = lcv[j];
                        if (m < 3) { const float a = dpp_rol1(acc[ai][0][m + 1][n][j]), b = dpp_rol1(acc[ai][1][m + 1][n][j]); gn = f15 ? a : gn; vn = f15 ? b : vn; lcg[j] = a; lcv[j] = b; }
                        rpg[j] = rg; rpv[j] = rv;
                        const float ga = __builtin_fmaf(wg[0][j], gp, __builtin_fmaf(wg[1][j], gc[j], __builtin_fmaf(wg[2][j], gn, bg[j])));
                        float va = __builtin_fmaf(wv[2][j], vn, bv[j]); asm volatile("" : "+v"(va));
                        va = __builtin_fmaf(wv[1][j], vc[j], va); asm volatile("" : "+v"(va));
                        va = __builtin_fmaf(wv[0][j], vp, va);
                        o[j] = silu(ga) * va; }
                    if (q >= 1 && q <= 62 && pr >= 1 && pr != 4097 && pr <= 8193) { u32x2 ow; ow.x = cvt_pk_bf16(o[0], o[1]); ow.y = cvt_pk_bf16(o[2], o[3]); *(u32x2*)(ACT + (size_t)G * D_FF + cg) = ow; } } }
        }
    }
};
template <bool RF32, bool FINAL> struct EpiResNorm {
    static constexpr bool PERM = true, CONV = false, AFTER_DRAIN = true; static constexpr int GAPA = 0;
    bf16_t* C; const void* R; int ldc; const float* gain; bf16_t* Hout; float* Fout; float* ssp; unsigned* cnt;
    __device__ __forceinline__ void operator()(f32x4 (&acc)[2][2][4][2], const Unit& u, int wr, int wc, int fr, int fq) const {
        const int row0 = u.pm * BM + wr * 64 + fr, col0 = u.pn * BM + wc * 32 + 8 * fq;
#pragma unroll
        for (int ai = 0; ai < 2; ++ai)
#pragma unroll
            for (int m = 0; m < 4; ++m) { const int row = row0 + ai * HALF + m * 16; const size_t ro = (size_t)row * ldc + col0; float sq = 0.f;
#pragma unroll
                for (int bj = 0; bj < 2; ++bj) { f32x4 r0, r1;
                    if (RF32) { const float* rp = (const float*)R + ro + bj * HALF; r0 = *(const f32x4*)rp; r1 = *(const f32x4*)(rp + 4); }
                    else { const u32x4 rr = *(const u32x4*)((const bf16_t*)R + ro + bj * HALF);
                        r0 = (f32x4){lo_bf(rr.x), hi_bf(rr.x), lo_bf(rr.y), hi_bf(rr.y)}; r1 = (f32x4){lo_bf(rr.z), hi_bf(rr.z), lo_bf(rr.w), hi_bf(rr.w)}; }
                    const f32x4 o0 = acc[ai][bj][m][0] + r0, o1 = acc[ai][bj][m][1] + r1; acc[ai][bj][m][0] = o0; acc[ai][bj][m][1] = o1;
                    sq += o0[0] * o0[0] + o0[1] * o0[1] + o0[2] * o0[2] + o0[3] * o0[3] + o1[0] * o1[0] + o1[1] * o1[1] + o1[2] * o1[2] + o1[3] * o1[3]; }
                sq += __shfl_xor(sq, 16, 64); sq += __shfl_xor(sq, 32, 64);
                if (fq == 0) __hip_atomic_store(ssp + (size_t)row * 32 + u.pn * 4 + wc, sq, __ATOMIC_RELAXED, __HIP_MEMORY_SCOPE_AGENT); }
        asm volatile("s_waitcnt vmcnt(0)" ::: "memory");
        __syncthreads();
        if (threadIdx.x == 0) __hip_atomic_fetch_add(cnt + u.pm, 1u, __ATOMIC_RELAXED, __HIP_MEMORY_SCOPE_AGENT);
        if (!FINAL) {
#pragma unroll
            for (int ai = 0; ai < 2; ++ai)
#pragma unroll
                for (int m = 0; m < 4; ++m) { const size_t ro = (size_t)(row0 + ai * HALF + m * 16) * ldc + col0;
#pragma unroll
                    for (int bj = 0; bj < 2; ++bj) { const f32x4 o0 = acc[ai][bj][m][0], o1 = acc[ai][bj][m][1];
                        u32x4 w; w.x = cvt_pk_bf16(o0[0], o0[1]); w.y = cvt_pk_bf16(o0[2], o0[3]); w.z = cvt_pk_bf16(o1[0], o1[1]); w.w = cvt_pk_bf16(o1[2], o1[3]);
                        *(u32x4*)(C + ro + bj * HALF) = w; } } }
        if (threadIdx.x == 0) {
            unsigned spins = 0;
            while (__hip_atomic_load(cnt + u.pm, __ATOMIC_RELAXED, __HIP_MEMORY_SCOPE_AGENT) < 8u) { __builtin_amdgcn_s_sleep(2); if (++spins > (1u << 22)) break; }
            __builtin_amdgcn_fence(__ATOMIC_ACQUIRE, "agent");
            asm volatile("s_waitcnt vmcnt(0)" ::: "memory");
        }
        __syncthreads();
        f32x4 g0[2], g1[2];
#pragma unroll
        for (int bj = 0; bj < 2; ++bj) { g0[bj] = *(const f32x4*)(gain + col0 + bj * HALF); g1[bj] = *(const f32x4*)(gain + col0 + bj * HALF + 4); }
#pragma unroll
        for (int ai = 0; ai < 2; ++ai)
#pragma unroll
            for (int m = 0; m < 4; ++m) { const int row = row0 + ai * HALF + m * 16; const size_t ro = (size_t)row * ldc + col0;
                const f32x4* q = (const f32x4*)(ssp + (size_t)row * 32 + 8 * fq); const f32x4 a = q[0] + q[1];
                float v = (a[0] + a[1]) + (a[2] + a[3]); v += __shfl_xor(v, 16, 64); v += __shfl_xor(v, 32, 64);
                const float rs = rsqrtf(v * (1.0f / D_MODEL) + 1e-6f);
#pragma unroll
                for (int bj = 0; bj < 2; ++bj) { const f32x4 o0 = acc[ai][bj][m][0], o1 = acc[ai][bj][m][1];
                    const f32x4 y0 = o0 * rs * g0[bj], y1 = o1 * rs * g1[bj];
                    if (FINAL) { float* op = Fout + ro + bj * HALF; *(f32x4*)op = y0; *(f32x4*)(op + 4) = y1; }
                    else { u32x4 w; w.x = cvt_pk_bf16(y0[0], y0[1]); w.y = cvt_pk_bf16(y0[2], y0[3]); w.z = cvt_pk_bf16(y1[0], y1[1]); w.w = cvt_pk_bf16(y1[2], y1[3]);
                        *(u32x4*)(Hout + (size_t)(row + 1 + (row >> 12)) * ldc + col0 + bj * HALF) = w; } } }
    }
};

template <class Epi, class Sched, int KDIM>
__device__ __forceinline__ void gemm_phase(LAS unsigned char* lds, const Gemm g, const Sched& S, const Epi& E) {
    int tid_ = threadIdx.x; asm volatile("" : "+v"(tid_));
    const int tid = tid_, wid = __builtin_amdgcn_readfirstlane(tid >> 6), lane = tid & 63, wr = wid >> 2, wc = wid & 3, fr = lane & 15, fq = lane >> 4;
    constexpr int K = KDIM, nt = K / BK;
    unsigned voffA[2], voffB[2];
#pragma unroll
    for (int i = 0; i < 2; ++i) { int R, C; stage_rc(tid * 16 + i * 8192, R, C); const int Rb = Epi::PERM ? ((R & ~31) + perm32(R & 31)) : R;
        const int Ra = Epi::CONV ? (62 * (R >> 6) + (R & 63)) : R;
        voffA[i] = (unsigned)(Ra * K + C) * 2u; voffB[i] = (unsigned)(Rb * K + C) * 2u; }
    const size_t kstep = (size_t)(BK * 2);
    const size_t hstep = (size_t)HALF * K * 2;
    const size_t tstep = 2 * hstep;
    const size_t hstepA = Epi::CONV ? (size_t)124 * K * 2 : hstep, tstepA = 2 * hstepA;
    const unsigned ldsw = (unsigned)wid * 1024u;
    const int aoff = lds_byte(wr * 64 + fr, fq * 8), boff = lds_byte(wc * 32 + fr, fq * 8);
#define PG8_SA(b, h) (((b) * 2 + (h)) * HTB)
#define PG8_SB(b, h) ((4 + (b) * 2 + (h)) * HTB)
#define PG8_STAGE(bufoff, gbase, voff) do { _Pragma("unroll") for (int _i = 0; _i < 2; ++_i) \
        __builtin_amdgcn_global_load_lds((const unsigned*)((const char*)(gbase) + (voff)[_i]), (LAS unsigned*)(lds + (bufoff) + ldsw + _i * 8192), 16, 0, 0); } while (0)
#define PG8_LDA(dst, b, h) do { _Pragma("unroll") for (int m = 0; m < 4; ++m) _Pragma("unroll") for (int k = 0; k < 2; ++k) dst[m][k] = *(const LAS bf16x8*)(lds + PG8_SA(b, h) + aoff + m * 2048 + k * 1024); } while (0)
#define PG8_LDB(dst, b, h) do { _Pragma("unroll") for (int n = 0; n < 2; ++n) _Pragma("unroll") for (int k = 0; k < 2; ++k) dst[n][k] = *(const LAS bf16x8*)(lds + PG8_SB(b, h) + boff + n * 2048 + k * 1024); } while (0)
#define PG8_MMA(ai, bj, At, Bt) do { __builtin_amdgcn_s_setprio(1); _Pragma("unroll") for (int m = 0; m < 4; ++m) _Pragma("unroll") for (int n = 0; n < 2; ++n) _Pragma("unroll") for (int k = 0; k < 2; ++k) \
        acc[ai][bj][m][n] = __builtin_amdgcn_mfma_f32_16x16x32_bf16(Bt[n][k], At[m][k], acc[ai][bj][m][n], 0, 0, 0); __builtin_amdgcn_s_setprio(0); } while (0)
#define PG8_WAIT_V(n) asm volatile("s_waitcnt vmcnt(" #n ")" ::: "memory")
#define PG8_WAIT_L(n) asm volatile("s_waitcnt lgkmcnt(" #n ")" ::: "memory")
#define PG8_BAR __builtin_amdgcn_s_barrier()
#define PG8_SCHED __builtin_amdgcn_sched_barrier(0)
    Unit cur, nxt; int ui = 0;
    if (!S.next(0, cur)) return;
    f32x4 acc[2][2][4][2];
#pragma unroll
    for (int a = 0; a < 2; ++a)
#pragma unroll
        for (int b = 0; b < 2; ++b)
#pragma unroll
            for (int m = 0; m < 4; ++m)
#pragma unroll
                for (int n = 0; n < 2; ++n) acc[a][b][m][n] = (f32x4){0.f, 0.f, 0.f, 0.f};
    bf16x8 At[4][2], B0[2][2], B1[2][2];
    const char* cA = (const char*)g.A + (size_t)cur.pm * tstepA + (cur.pm >= 16 ? Epi::GAPA : 0); const char* cB = (const char*)g.Bt + (size_t)cur.pn * tstep;
    PG8_STAGE(PG8_SB(0, 0), cB, voffB); PG8_STAGE(PG8_SA(0, 0), cA, voffA); PG8_STAGE(PG8_SB(0, 1), cB + hstep, voffB); PG8_STAGE(PG8_SA(0, 1), cA + hstepA, voffA);
    if (wr == 1) PG8_BAR;
    PG8_WAIT_V(4); PG8_BAR;
    PG8_STAGE(PG8_SB(1, 0), cB + kstep, voffB); PG8_STAGE(PG8_SA(1, 0), cA + kstep, voffA); PG8_STAGE(PG8_SB(1, 1), cB + hstep + kstep, voffB);
    PG8_WAIT_V(6); PG8_BAR;
    for (;;) {
        const bool has_next = S.next(ui + 1, nxt);
        const char* nA = has_next ? (const char*)g.A + (size_t)nxt.pm * tstepA + (nxt.pm >= 16 ? Epi::GAPA : 0) : cA; const char* nB = has_next ? (const char*)g.Bt + (size_t)nxt.pn * tstep : cB;
        for (int t = 0; t < nt; t += 2) {
            const bool last = (t == nt - 2);
            const char* a1 = cA + (size_t)(t + 1) * kstep;
            const char* a2 = last ? nA : cA + (size_t)(t + 2) * kstep; const char* b2 = last ? nB : cB + (size_t)(t + 2) * kstep;
            const char* a3 = a2 + kstep; const char* b3 = b2 + kstep;
            PG8_LDB(B0, 0, 0); PG8_SCHED; PG8_LDA(At, 0, 0); PG8_STAGE(PG8_SA(1, 1), a1 + hstepA, voffA);
            PG8_WAIT_L(8); PG8_BAR; PG8_WAIT_L(0); PG8_MMA(0, 0, At, B0); PG8_BAR; PG8_SCHED;
            PG8_LDB(B1, 0, 1); PG8_STAGE(PG8_SB(0, 0), b2, voffB);
            PG8_BAR; PG8_WAIT_L(0); PG8_MMA(0, 1, At, B1); PG8_BAR;
            PG8_LDA(At, 0, 1); PG8_STAGE(PG8_SA(0, 0), a2, voffA);
            PG8_BAR; PG8_WAIT_L(0); PG8_MMA(1, 0, At, B0); PG8_BAR; PG8_SCHED;
            PG8_STAGE(PG8_SB(0, 1), b2 + hstep, voffB);
            PG8_WAIT_V(6); PG8_BAR; PG8_MMA(1, 1, At, B1); PG8_BAR;
            PG8_LDB(B0, 1, 0); PG8_SCHED; PG8_LDA(At, 1, 0); PG8_STAGE(PG8_SA(0, 1), a2 + hstepA, voffA);
            PG8_WAIT_L(8); PG8_BAR; PG8_WAIT_L(0); PG8_MMA(0, 0, At, B0); PG8_BAR; PG8_SCHED;
            PG8_LDB(B1, 1, 1); PG8_STAGE(PG8_SB(1, 0), b3, voffB);
            PG8_BAR; PG8_WAIT_L(0); PG8_MMA(0, 1, At, B1); PG8_BAR;
            PG8_LDA(At, 1, 1); PG8_STAGE(PG8_SA(1, 0), a3, voffA);
            PG8_BAR; PG8_WAIT_L(0); PG8_MMA(1, 0, At, B0); PG8_BAR; PG8_SCHED;
            PG8_STAGE(PG8_SB(1, 1), b3 + hstep, voffB);
            PG8_WAIT_V(6); PG8_BAR; PG8_MMA(1, 1, At, B1); PG8_BAR;
        }
        if constexpr (!Epi::AFTER_DRAIN) E(acc, cur, wr, wc, fr, fq);
        if (!has_next) break;
#pragma unroll
        for (int a = 0; a < 2; ++a)
#pragma unroll
            for (int b = 0; b < 2; ++b)
#pragma unroll
                for (int m = 0; m < 4; ++m)
#pragma unroll
                    for (int n = 0; n < 2; ++n) acc[a][b][m][n] = (f32x4){0.f, 0.f, 0.f, 0.f};
        cur = nxt; cA = nA; cB = nB; ++ui;
    }
    PG8_WAIT_V(0);
    if (wr == 0) PG8_BAR;
    PG8_BAR;
    if constexpr (Epi::AFTER_DRAIN) E(acc, cur, wr, wc, fr, fq);
#undef PG8_SA
#undef PG8_SB
#undef PG8_STAGE
#undef PG8_LDA
#undef PG8_LDB
#undef PG8_MMA
#undef PG8_WAIT_V
#undef PG8_WAIT_L
#undef PG8_BAR
#undef PG8_SCHED
}
}

__device__ __forceinline__ void convert_tile(const float* __restrict__ W, int K, int N, bf16_t* __restrict__ Wt, int k0, int n0, int orow0, float* tile) {
    const int tid = tid_l();
    { const int r = tid >> 4, c4 = (tid & 15) * 4;
#pragma unroll
      for (int ps = 0; ps < 2; ++ps) { const int rr = r + ps * 32; const float4 v = *(const float4*)(W + (size_t)(k0 + rr) * N + n0 + c4);
          tile[rr * 65 + c4 + 0] = v.x; tile[rr * 65 + c4 + 1] = v.y; tile[rr * 65 + c4 + 2] = v.z; tile[rr * 65 + c4 + 3] = v.w; } }
    __syncthreads();
    { const int n = tid >> 3, k8 = (tid & 7) * 8; float v[8];
#pragma unroll
      for (int j = 0; j < 8; ++j) v[j] = tile[(k8 + j) * 65 + n];
      u32x4 w; w.x = cvt_pk_bf16(v[0], v[1]); w.y = cvt_pk_bf16(v[2], v[3]); w.z = cvt_pk_bf16(v[4], v[5]); w.w = cvt_pk_bf16(v[6], v[7]);
      *(u32x4*)(Wt + (size_t)(orow0 + n) * K + k0 + k8) = w; }
    __syncthreads();
}

constexpr int NI_IN = 32 * 68, NI_OUT = 32 * 32, NI_UP = 32 * 176, NI_DN = 88 * 32, NI_POOL = 16, NI_LAYER = NI_IN + NI_OUT + NI_UP + NI_DN + NI_POOL;
constexpr int NI_FILT = 256;
constexpr int NT3 = 2080;
constexpr int R_OUT = NI_IN, R_UP = NI_IN + NI_OUT, R_DN = NI_IN + NI_OUT + NI_UP, R_POOL = NI_IN + NI_OUT + NI_UP + NI_DN;
__device__ void convert_item(const Params& p, int l, int r, float* lds) {
    if (r < NI_IN) { const int tn = r / 32, tk = r % 32;
        convert_tile(inp(2) + (size_t)l * D_MODEL * D_INP, D_MODEL, D_INP, (bf16_t*)(p.ws + OFF_WT_IN + l * SZ_WT_IN), tk * 64, tn * 64, tn * 64, lds); return; }
    r -= NI_IN;
    if (r < NI_OUT) { const int tn = r / 32, tk = r % 32;
        convert_tile(inp(20) + (size_t)l * D_MODEL * D_MODEL, D_MODEL, D_MODEL, (bf16_t*)(p.ws + OFF_WT_OUT + l * SZ_WT_OUT), tk * 64, tn * 64, tn * 64, lds); return; }
    r -= NI_OUT;
    if (r < NI_UP) { const int tn = r / 32, tk = r % 32; const int n0 = tn * 64, s = n0 / D_FF, rem = n0 % D_FF, j = rem / 128, i = rem % 128;
        convert_tile(inp(22) + (size_t)l * D_MODEL * D_UP, D_MODEL, D_UP, (bf16_t*)(p.ws + OFF_WT_UP + l * SZ_WT_UP), tk * 64, n0, 256 * j + 128 * s + i, lds); return; }
    r -= NI_UP;
    if (r < NI_DN) { const int tn = r / 88, tk = r % 88;
        convert_tile(inp(25) + (size_t)l * D_FF * D_MODEL, D_FF, D_MODEL, (bf16_t*)(p.ws + OFF_WT_DN + l * SZ_WT_DN), tk * 64, tn * 64, tn * 64, lds); return; }
    r -= NI_DN;
    { const int g = r >> 2, tn = (r >> 1) & 1, tk = r & 1;
        convert_tile(inp(3) + (size_t)(l * 4 + g) * 128 * 128, 128, 128, (bf16_t*)(p.ws + OFF_POOLWT + l * SZ_POOLWT) + g * 128 * 128, tk * 64, tn * 64, tn * 64, lds); }
}

__device__ __forceinline__ float sin_rad(float x) { return __builtin_amdgcn_sinf(x * 0.15915494309f); }

struct CvDesc { const float* W; bf16_t* Wt; int K, N, k0, n0, orow0; };
__device__ __forceinline__ CvDesc cv_desc(const Params& p, int l, int r) {
    CvDesc d;
    if (r < R_OUT) { const int tn = r / 32, tk = r % 32; d.W = inp(2) + (size_t)l * D_MODEL * D_INP; d.Wt = (bf16_t*)(p.ws + OFF_WT_IN + l * SZ_WT_IN); d.K = D_MODEL; d.N = D_INP; d.k0 = tk * 64; d.n0 = tn * 64; d.orow0 = tn * 64; }
    else if (r < R_UP) { r -= R_OUT; const int tn = r / 32, tk = r % 32; d.W = inp(20) + (size_t)l * D_MODEL * D_MODEL; d.Wt = (bf16_t*)(p.ws + OFF_WT_OUT + l * SZ_WT_OUT); d.K = D_MODEL; d.N = D_MODEL; d.k0 = tk * 64; d.n0 = tn * 64; d.orow0 = tn * 64; }
    else if (r < R_DN) { r -= R_UP; const int tn = r / 32, tk = r % 32; const int n0 = tn * 64, sg = n0 / D_FF, rem = n0 % D_FF, j = rem / 128, i = rem % 128;
        d.W = inp(22) + (size_t)l * D_MODEL * D_UP; d.Wt = (bf16_t*)(p.ws + OFF_WT_UP + l * SZ_WT_UP); d.K = D_MODEL; d.N = D_UP; d.k0 = tk * 64; d.n0 = n0; d.orow0 = 256 * j + 128 * sg + i; }
    else if (r < R_POOL) { r -= R_DN; const int tn = r / 88, tk = r % 88; d.W = inp(25) + (size_t)l * D_FF * D_MODEL; d.Wt = (bf16_t*)(p.ws + OFF_WT_DN + l * SZ_WT_DN); d.K = D_FF; d.N = D_MODEL; d.k0 = tk * 64; d.n0 = tn * 64; d.orow0 = tn * 64; }
    else { r -= R_POOL; const int g = r >> 2, tn = (r >> 1) & 1, tk = r & 1; d.W = inp(3) + (size_t)(l * 4 + g) * 128 * 128; d.Wt = (bf16_t*)(p.ws + OFF_POOLWT + l * SZ_POOLWT) + g * 128 * 128; d.K = 128; d.N = 128; d.k0 = tk * 64; d.n0 = tn * 64; d.orow0 = tn * 64; }
    return d;
}
__device__ __forceinline__ CvDesc cv_pick(const Params& p, int mode, int l, int base, int i) {
    if (mode == 0) { if (i < R_DN) return cv_desc(p, 0, i); if (i < R_DN + NI_POOL) return cv_desc(p, 0, R_POOL + i - R_DN); return cv_desc(p, 1, R_POOL + i - R_DN - NI_POOL); }
    return cv_desc(p, l, base + i);
}
__device__ __forceinline__ void cv_load(const CvDesc& d, int tid, float4 (&v)[2]) {
    const int r = tid >> 4, c4 = (tid & 15) * 4;
#pragma unroll
    for (int ps = 0; ps < 2; ++ps) v[ps] = *(const float4*)(d.W + (size_t)(d.k0 + r + ps * 32) * d.N + d.n0 + c4);
}
__device__ void convert_range(const Params& p, int mode, int l, int base, int count, int start, int stride, float* tile) {
    int i = start; if (i >= count) return;
    const int tid = tid_l();
    CvDesc d = cv_pick(p, mode, l, base, i); float4 v[2]; cv_load(d, tid, v);
    for (;;) {
        { const int r = tid >> 4, c4 = (tid & 15) * 4;
#pragma unroll
          for (int ps = 0; ps < 2; ++ps) { float* tp = tile + (r + ps * 32) * 65 + c4; tp[0] = v[ps].x; tp[1] = v[ps].y; tp[2] = v[ps].z; tp[3] = v[ps].w; } }
        __syncthreads();
        const int ni = i + stride; const bool more = ni < count; CvDesc dn = d;
        if (more) { dn = cv_pick(p, mode, l, base, ni); cv_load(dn, tid, v); }
        { const int n = tid >> 3, k8 = (tid & 7) * 8; float u[8];
#pragma unroll
          for (int j = 0; j < 8; ++j) u[j] = tile[(k8 + j) * 65 + n];
          u32x4 w; w.x = cvt_pk_bf16(u[0], u[1]); w.y = cvt_pk_bf16(u[2], u[3]); w.z = cvt_pk_bf16(u[4], u[5]); w.w = cvt_pk_bf16(u[6], u[7]);
          *(u32x4*)(d.Wt + (size_t)(d.orow0 + n) * d.K + d.k0 + k8) = w; }
        __syncthreads();
        if (!more) break;
        d = dn; i = ni;
    }
}

__device__ __forceinline__ void cv_load4(const CvDesc& d, int tid, float4 (&v)[8]) {
    const int r = tid >> 4, c4 = (tid & 15) * 4;
#pragma unroll
    for (int ps = 0; ps < 8; ++ps) v[ps] = *(const float4*)(d.W + (size_t)(d.k0 + r + ps * 32) * d.N + d.n0 + c4);
}
__device__ void convert_range4(const Params& p, int l, int base, int count4, int start, int stride, float* tile) {
    int i = start; if (i >= count4) return;
    const int tid = tid_l();
    CvDesc d = cv_desc(p, l, base + 4 * i); float4 v[8]; cv_load4(d, tid, v);
    for (;;) {
        { const int r = tid >> 4, c4 = (tid & 15) * 4;
#pragma unroll
          for (int ps = 0; ps < 8; ++ps) { float* tp = tile + (r + ps * 32) * 65 + c4; tp[0] = v[ps].x; tp[1] = v[ps].y; tp[2] = v[ps].z; tp[3] = v[ps].w; } }
        __syncthreads();
        const int ni = i + stride; const bool more = ni < count4; CvDesc dn = d;
        if (more) { dn = cv_desc(p, l, base + 4 * ni); cv_load4(dn, tid, v); }
        { const int n = tid >> 3, kc = tid & 7;
#pragma unroll
          for (int j = 0; j < 4; ++j) { const int k8 = (kc + 8 * j) * 8; float u[8];
#pragma unroll
              for (int q = 0; q < 8; ++q) u[q] = tile[(k8 + q) * 65 + n];
              u32x4 w; w.x = cvt_pk_bf16(u[0], u[1]); w.y = cvt_pk_bf16(u[2], u[3]); w.z = cvt_pk_bf16(u[4], u[5]); w.w = cvt_pk_bf16(u[6], u[7]);
              *(u32x4*)(d.Wt + (size_t)(d.orow0 + n) * d.K + d.k0 + k8) = w; } }
        __syncthreads();
        if (!more) break;
        d = dn; i = ni;
    }
}

__device__ void filter_item(const Params& p, int item, float* lds) {
    const int l = item >> 7, rem = item & 127, ti = rem >> 1, half = rem & 1;
    const int tid = tid_l(), lane = tid & 63, w = __builtin_amdgcn_readfirstlane(tid >> 6);
    const int t = ti * 64 + lane;
    const float* w1 = inp(8) + l * 33 * 64; const float* b1 = inp(9) + l * 64; const float* fr1 = inp(10) + l * 64;
    const float* w2 = inp(11) + l * 64 * 64; const float* b2 = inp(12) + l * 64; const float* fr2 = inp(13) + l * 64;
    const float* w3 = inp(14) + (size_t)l * 64 * 1536;
    float* h1s = lds; float* h2s = lds + 64 * 65;
    const float tt = (float)t / 4095.0f;
    float a[8];
#pragma unroll
    for (int j = 0; j < 8; ++j) a[j] = b1[8 * w + j] + tt * w1[8 * w + j];
    for (int band = 0; band < 16; ++band) {
        const float f = 1e-4f + (float)band * ((15.0f - 1e-4f) / 15.0f);
        float r = f * (float)t * (1.0f / 4096.0f); r -= floorf(r);
        const float cs = __builtin_amdgcn_cosf(r), sn = -__builtin_amdgcn_sinf(r);
#pragma unroll
        for (int j = 0; j < 8; ++j) a[j] += cs * w1[(1 + band) * 64 + 8 * w + j] + sn * w1[(17 + band) * 64 + 8 * w + j];
    }
#pragma unroll
    for (int j = 0; j < 8; ++j) h1s[lane * 65 + 8 * w + j] = sin_rad(fr1[8 * w + j] * a[j]);
    __syncthreads();
#pragma unroll
    for (int j = 0; j < 8; ++j) a[j] = b2[8 * w + j];
    for (int i = 0; i < 64; ++i) { const float h = h1s[lane * 65 + i];
#pragma unroll
        for (int j = 0; j < 8; ++j) a[j] += h * w2[i * 64 + 8 * w + j]; }
#pragma unroll
    for (int j = 0; j < 8; ++j) h2s[lane * 65 + 8 * w + j] = sin_rad(fr2[8 * w + j] * a[j]);
    __syncthreads();
    float* KT = (float*)(p.ws + OFF_ACT) + (size_t)l * 768 * 8192;
    const float d0 = -3.0701134573f, d1 = -15.3505672865f;
    typedef const __attribute__((address_space(4))) f32x4 cf4;
    for (int ci = 0; ci < 24; ++ci) {
        const int c = w * 96 + ci * 4;
        cf4* wc = (cf4*)(unsigned long long)(w3 + half * 768 + c);
        float o0 = 0.f, o1 = 0.f, o2 = 0.f, o3 = 0.f;
#pragma unroll 8
        for (int i = 0; i < 64; ++i) { const float h = h2s[lane * 65 + i]; const f32x4 wv = wc[i * 384]; o0 += h * wv[0]; o1 += h * wv[1]; o2 += h * wv[2]; o3 += h * wv[3]; }
        float o[4] = {o0, o1, o2, o3};
#pragma unroll
        for (int j = 0; j < 4; ++j) {
            const float delta = d0 + (float)(c + j) * ((d1 - d0) / 767.0f);
            const float val = o[j] * __expf(-tt * fabsf(delta));
            float* kt = KT + (size_t)(c + j) * 8192;
            if (half == 0) kt[t] = val; else { if (t == 0) kt[4096] = 0.f; else kt[8192 - t] = val; }
        }
    }
    __syncthreads();
}

__device__ __forceinline__ int phys(int i) { return i + (i >> 5); }
__device__ __forceinline__ float launder_f(float v) { asm volatile("" : "+v"(v)); return v; }
constexpr int FFT_BUF = 8192 + 256;
__device__ __forceinline__ constexpr float c32(int i) { constexpr float T[16] = {1.0f, 0.98078528040f, 0.92387953251f, 0.83146961230f, 0.70710678119f, 0.55557023302f, 0.38268343237f, 0.19509032202f, 0.0f, -0.19509032202f, -0.38268343237f, -0.55557023302f, -0.70710678119f, -0.83146961230f, -0.92387953251f, -0.98078528040f}; return T[i]; }
__device__ __forceinline__ constexpr float s32(int i) { constexpr float T[16] = {0.0f, 0.19509032202f, 0.38268343237f, 0.55557023302f, 0.70710678119f, 0.83146961230f, 0.92387953251f, 0.98078528040f, 1.0f, 0.98078528040f, 0.92387953251f, 0.83146961230f, 0.70710678119f, 0.55557023302f, 0.38268343237f, 0.19509032202f}; return T[i]; }
template <bool INV> __device__ __forceinline__ void radix16(float2 (&x)[16], float rfrac) {
#pragma unroll
    for (int jj = 0; jj < 4; ++jj) { const int j = INV ? 3 - jj : jj; const int half = 8 >> j;
        const float ab = rfrac * (float)(8 / half); const float cb = __builtin_amdgcn_cosf(ab), sb = __builtin_amdgcn_sinf(ab);
#pragma unroll
        for (int kk = 0; kk < half; ++kk) {
            const int idx = kk * (16 / half);
            float cs, sp;
            if (idx == 0) { cs = cb; sp = sb; }
            else if (idx == 8) { cs = -sb; sp = cb; }
            else { cs = cb * c32(idx) - sb * s32(idx); sp = cb * s32(idx) + sb * c32(idx); }
            const float sn = INV ? sp : -sp;
#pragma unroll
            for (int g = 0; g < 16; g += 2 * half) { const int i0 = g + kk, i1 = i0 + half; const float2 a = x[i0], b = x[i1];
                if (!INV) { const float dx = a.x - b.x, dy = a.y - b.y; x[i0] = make_float2(a.x + b.x, a.y + b.y); x[i1] = make_float2(dx * cs - dy * sn, dx * sn + dy * cs); }
                else { const float bx = b.x * cs - b.y * sn, by = b.x * sn + b.y * cs; x[i0] = make_float2(a.x + bx, a.y + by); x[i1] = make_float2(a.x - bx, a.y - by); } }
        }
    }
}
template <bool INV> __device__ __forceinline__ void radix32(float2 (&y)[32]) {
#pragma unroll
    for (int jj = 0; jj < 5; ++jj) { const int j = INV ? 4 - jj : jj; const int half = 16 >> j;
#pragma unroll
        for (int kk = 0; kk < half; ++kk) { const int idx = kk * (16 / half); const float cs = c32(idx), sn = INV ? s32(idx) : -s32(idx);
#pragma unroll
            for (int g = 0; g < 32; g += 2 * half) { const int i0 = g + kk, i1 = i0 + half; const float2 a = y[i0], b = y[i1];
                if (!INV) { const float dx = a.x - b.x, dy = a.y - b.y; y[i0] = make_float2(a.x + b.x, a.y + b.y);
                    if (idx == 0) y[i1] = make_float2(dx, dy);
                    else if (idx == 8) y[i1] = make_float2(dy, -dx);
                    else y[i1] = make_float2(dx * cs - dy * sn, dx * sn + dy * cs); }
                else { float bx, by;
                    if (idx == 0) { bx = b.x; by = b.y; }
                    else if (idx == 8) { bx = -b.y; by = b.x; }
                    else { bx = b.x * cs - b.y * sn; by = b.x * sn + b.y * cs; }
                    y[i0] = make_float2(a.x + bx, a.y + by); y[i1] = make_float2(a.x - bx, a.y - by); } }
        }
    }
}
template <bool INV> __device__ __forceinline__ void fft_pass2(float2* B, int tid, float rfr) {
    const int blk = tid >> 5, r = tid & 31; float2 x[16]; float2* b = B + blk * 528 + r;
#pragma unroll
    for (int k = 0; k < 16; ++k) x[k] = b[33 * k];
    radix16<INV>(x, rfr);
#pragma unroll
    for (int k = 0; k < 16; ++k) b[33 * k] = x[k];
}

__device__ void kf_item(const Params& p, int item, unsigned char* smem) {
    const int l = item / 384, cp = item % 384, c0 = 2 * cp;
    const int tid = tid_l();
    float2* B0 = (float2*)smem; float2* B1 = B0 + FFT_BUF;
    const float* KT = (const float*)(p.ws + OFF_ACT) + ((size_t)l * 768 + c0) * 8192 + tid;
    float2 x0[16], x1[16];
#pragma unroll
    for (int k = 0; k < 16; ++k) { x0[k] = make_float2(KT[512 * k], 0.f); x1[k] = make_float2(KT[8192 + 512 * k], 0.f); }
    const float rf = (float)tid * (1.0f / 8192.0f);
    radix16<false>(x0, rf); radix16<false>(x1, rf);
#pragma unroll
    for (int k = 0; k < 16; ++k) { B0[phys(tid + 512 * k)] = x0[k]; B1[phys(tid + 512 * k)] = x1[k]; }
    __syncthreads();
    { const float r2 = launder_f((float)(tid & 31) * (1.0f / 512.0f)); fft_pass2<false>(B0, tid, r2); fft_pass2<false>(B1, tid, r2); }
    __syncthreads();
    { const int blk = tid & 255, ch = tid >> 8; float2* B = ch ? B1 : B0; float2 y[32];
#pragma unroll
      for (int k = 0; k < 32; ++k) y[k] = B[blk * 33 + k];
      radix32<false>(y);
      float2* KF = (float2*)(p.ws + OFF_KF) + ((size_t)l * 768 + c0 + ch) * 8192 + blk * 2; const float sc = 1.0f / 8192.0f;
#pragma unroll
      for (int k = 0; k < 32; k += 2) *(float4*)(KF + (k >> 1) * 512) = make_float4(y[k].x * sc, y[k].y * sc, y[k + 1].x * sc, y[k + 1].y * sc); }
    __syncthreads();
}

template <bool XF32> __device__ void norm_phase(const void* __restrict__ xin, const float* __restrict__ g, bf16_t* hb, float* hf) {
    const int tid = tid_l(); const int lane = tid & 63; const int gw = blockIdx.x * 8 + (tid >> 6), nw = gridDim.x * 8;
    for (int row = gw; row < NTOK; row += nw) {
        float v[4][8]; float ss = 0.f;
#pragma unroll
        for (int i = 0; i < 4; ++i) { const size_t o = (size_t)row * D_MODEL + i * 512 + lane * 8;
            if (XF32) { const float4 a = *(const float4*)((const float*)xin + o), b = *(const float4*)((const float*)xin + o + 4);
                v[i][0] = a.x; v[i][1] = a.y; v[i][2] = a.z; v[i][3] = a.w; v[i][4] = b.x; v[i][5] = b.y; v[i][6] = b.z; v[i][7] = b.w; }
            else { const u32x4 u = *(const u32x4*)((const bf16_t*)xin + o);
                v[i][0] = lo_bf(u.x); v[i][1] = hi_bf(u.x); v[i][2] = lo_bf(u.y); v[i][3] = hi_bf(u.y); v[i][4] = lo_bf(u.z); v[i][5] = hi_bf(u.z); v[i][6] = lo_bf(u.w); v[i][7] = hi_bf(u.w); }
#pragma unroll
            for (int j = 0; j < 8; ++j) ss += v[i][j] * v[i][j]; }
        ss = wave_sum(ss);
        const float rs = rsqrtf(ss * (1.0f / D_MODEL) + 1e-6f);
#pragma unroll
        for (int i = 0; i < 4; ++i) { const int c = i * 512 + lane * 8; const float4 ga = *(const float4*)(g + c), gb = *(const float4*)(g + c + 4);
            const float y0 = v[i][0] * rs * ga.x, y1 = v[i][1] * rs * ga.y, y2 = v[i][2] * rs * ga.z, y3 = v[i][3] * rs * ga.w, y4 = v[i][4] * rs * gb.x, y5 = v[i][5] * rs * gb.y, y6 = v[i][6] * rs * gb.z, y7 = v[i][7] * rs * gb.w;
            if (hb) { u32x4 w; w.x = cvt_pk_bf16(y0, y1); w.y = cvt_pk_bf16(y2, y3); w.z = cvt_pk_bf16(y4, y5); w.w = cvt_pk_bf16(y6, y7); *(u32x4*)(hb + (size_t)(row + 1 + (row >> 12)) * D_MODEL + c) = w; }
            else { float* op = hf + (size_t)row * D_MODEL + c; *(float4*)op = make_float4(y0, y1, y2, y3); *(float4*)(op + 4) = make_float4(y4, y5, y6, y7); } }
    }
}

__device__ void pool_item(const Params& p, int l, int item, unsigned char* smem) {
    const int tt = item >> 2, g = item & 3;
    const int tid = tid_l(), lane = tid & 63, w = tid >> 6, fr = lane & 15, fq = lane >> 4;
    const bf16_t* P = (const bf16_t*)(p.ws + OFF_P); bf16_t* MIX = (bf16_t*)(p.ws + OFF_MIX);
    const int row0 = tt * 128, b0 = (row0 / SEQ) * SEQ;
    float* X = (float*)smem;
    bf16_t* A = (bf16_t*)(smem + 144 * 129 * 4);
    for (int idx = tid; idx < 144 * 16; idx += 512) { const int r = idx >> 4, c8 = (idx & 15) * 8; const int row = row0 - 8 + r;
        u32x4 v = (u32x4){0u, 0u, 0u, 0u};
        if (row >= b0 && row < b0 + SEQ) v = *(const u32x4*)(P + (size_t)row * D_INP + g * 128 + c8);
        float* xp = X + r * 129 + c8;
        xp[0] = lo_bf(v.x); xp[1] = hi_bf(v.x); xp[2] = lo_bf(v.y); xp[3] = hi_bf(v.y); xp[4] = lo_bf(v.z); xp[5] = hi_bf(v.z); xp[6] = lo_bf(v.w); xp[7] = hi_bf(v.w); }
    __syncthreads();
    { const int c = tid & 127, tq = tid >> 7; const int hw = 1 << g;
      const float* xc = X + (tq * 32 + 8) * 129 + c;
      float s = 0.f;
      for (int q = -hw; q < hw; ++q) s += xc[q * 129];
      const int tb = row0 + tq * 32 - b0;
#pragma unroll 8
      for (int i = 0; i < 32; ++i) { const int t = tb + i; const int lo = max(t - hw, 0), hi = min(t + hw - 1, SEQ - 1);
          const float d = s * __builtin_amdgcn_rcpf((float)(hi - lo + 1)) - xc[i * 129];
          A[(tq * 32 + i) * 136 + c] = (bf16_t)(cvt_pk_bf16(d, 0.f) & 0xffffu);
          s += xc[(i + hw) * 129] - xc[(i - hw) * 129]; } }
    __syncthreads();
    const bf16_t* Wt = (const bf16_t*)(p.ws + OFF_POOLWT + l * SZ_POOLWT) + g * 128 * 128;
    f32x4 acc[8];
#pragma unroll
    for (int nb = 0; nb < 8; ++nb) acc[nb] = (f32x4){0.f, 0.f, 0.f, 0.f};
#pragma unroll
    for (int ks = 0; ks < 4; ++ks) {
        const bf16x8 af = *(const bf16x8*)(A + (16 * w + fr) * 136 + ks * 32 + fq * 8);
#pragma unroll
        for (int nb = 0; nb < 8; ++nb) { const bf16x8 bfr = *(const bf16x8*)(Wt + (nb * 16 + fr) * 128 + ks * 32 + fq * 8);
            acc[nb] = __builtin_amdgcn_mfma_f32_16x16x32_bf16(bfr, af, acc[nb], 0, 0, 0); }
    }
    const float* pb = inp(4) + l * 512 + g * 128; const float* psc = inp(5) + l * 512 + g * 128;
    const int row = row0 + 16 * w + fr;
#pragma unroll
    for (int nb = 0; nb < 8; ++nb) { const int d = nb * 16 + 4 * fq; const float4 bb = *(const float4*)(pb + d), sc = *(const float4*)(psc + d);
        u32x2 o; o.x = cvt_pk_bf16((acc[nb][0] + bb.x) * sc.x, (acc[nb][1] + bb.y) * sc.y); o.y = cvt_pk_bf16((acc[nb][2] + bb.z) * sc.z, (acc[nb][3] + bb.w) * sc.w);
        *(u32x2*)(MIX + (size_t)row * D_MODEL + g * 128 + d) = o; }
    __syncthreads();
}

__device__ void hypre_item(const Params& p, int l, int item, unsigned char* smem) {
    const int tt = item / 6, ct = item % 6; const int tid = tid_l();
    const bf16_t* P = (const bf16_t*)(p.ws + OFF_P); float* ZT = (float*)(p.ws + OFF_ZT); float* X0T = (float*)(p.ws + OFF_X0T);
    const float* sw = inp(6) + (size_t)l * 3 * 2304; const float* sb = inp(7) + (size_t)l * 2304;
    float* zt = (float*)smem;
    float* xt = zt + 128 * 65;
    const int row0 = tt * 64;
    { const int cpq = tid & 63, tr = tid >> 6; const int ch = ct * 128 + 2 * cpq;
      float w[3][3][2], bb[3][2];
#pragma unroll
      for (int s3 = 0; s3 < 3; ++s3) {
#pragma unroll
          for (int k = 0; k < 3; ++k) { const float2 v = *(const float2*)(sw + k * 2304 + s3 * 768 + ch); w[s3][k][0] = v.x; w[s3][k][1] = v.y; }
          const float2 v = *(const float2*)(sb + s3 * 768 + ch); bb[s3][0] = v.x; bb[s3][1] = v.y; }
      const int r0 = row0 + tr * 8; const bf16_t* pr = P + (size_t)r0 * D_INP + COL_HY + ch;
      unsigned pm[3], pc[3], pn[3];
#pragma unroll
      for (int s3 = 0; s3 < 3; ++s3) { pm[s3] = ((r0 & (SEQ - 1)) != 0) ? *(const unsigned*)(pr - D_INP + s3 * 768) : 0u; pc[s3] = *(const unsigned*)(pr + s3 * 768); }
#pragma unroll
      for (int i = 0; i < 8; ++i) { const int row = r0 + i;
#pragma unroll
          for (int s3 = 0; s3 < 3; ++s3) pn[s3] = ((row & (SEQ - 1)) != SEQ - 1) ? *(const unsigned*)(pr + (size_t)(i + 1) * D_INP + s3 * 768) : 0u;
          float o[3][2];
#pragma unroll
          for (int s3 = 0; s3 < 3; ++s3) { o[s3][0] = w[s3][0][0] * lo_bf(pm[s3]) + w[s3][1][0] * lo_bf(pc[s3]) + w[s3][2][0] * lo_bf(pn[s3]) + bb[s3][0];
                                           o[s3][1] = w[s3][0][1] * hi_bf(pm[s3]) + w[s3][1][1] * hi_bf(pc[s3]) + w[s3][2][1] * hi_bf(pn[s3]) + bb[s3][1]; }
          const int tl = tr * 8 + i;
          zt[(2 * cpq) * 65 + tl] = o[1][0] * o[2][0]; zt[(2 * cpq + 1) * 65 + tl] = o[1][1] * o[2][1];
          xt[(2 * cpq) * 65 + tl] = o[0][0]; xt[(2 * cpq + 1) * 65 + tl] = o[0][1];
#pragma unroll
          for (int s3 = 0; s3 < 3; ++s3) { pm[s3] = pc[s3]; pc[s3] = pn[s3]; } } }
    __syncthreads();
    { const int tl = tid & 63, cr = tid >> 6; const int row = row0 + tl, b = row >> 12, t = row & (SEQ - 1);
#pragma unroll
      for (int i = 0; i < 16; ++i) { const int c = cr * 16 + i; const size_t o = (size_t)(ct * 128 + c) * 8192 + b * 4096 + t; ZT[o] = zt[c * 65 + tl]; X0T[o] = xt[c * 65 + tl]; } }
    __syncthreads();
}

constexpr int GM_NH = 3;
__device__ void gmlp_item(const Params& p, int l, int item, unsigned char* smem) {
    const int n = item / (6 / GM_NH), e0 = (item % (6 / GM_NH)) * GM_NH;
    const int tid = tid_l(), lane = tid & 63, w = tid >> 6, fr = lane & 15, fq = lane >> 4;
    const bf16_t* P = (const bf16_t*)(p.ws + OFF_P); bf16_t* MIX = (bf16_t*)(p.ws + OFF_MIX);
    const float* stats = (const float*)(p.ws + OFF_STATS) + (size_t)l * NTOK * 24;
    const float* lng = inp(16) + l * 768; const float* lnb = inp(17) + l * 768;
    bf16_t* VT = (bf16_t*)smem;
    const int t0 = n * 128;
    const int q = 16 * w + fr; const size_t qrow = (size_t)(t0 + q);
    float g0[GM_NH], g1[GM_NH], be0[GM_NH], be1[GM_NH], bq[GM_NH]; u32x2 uu[GM_NH][8]; bf16x8 wf[GM_NH][4];
#pragma unroll
    for (int h = 0; h < GM_NH; ++h) { const int e = e0 + h;
        g0[h] = lng[e * 128 + lane]; g1[h] = lng[e * 128 + 64 + lane]; be0[h] = lnb[e * 128 + lane]; be1[h] = lnb[e * 128 + 64 + lane];
        bq[h] = (inp(19) + (l * 6 + e) * 128)[q];
#pragma unroll
        for (int cb = 0; cb < 8; ++cb) uu[h][cb] = *(const u32x2*)(P + qrow * D_INP + COL_GM + e * 128 + cb * 16 + 4 * fq);
        const float* ws_ = inp(18) + (size_t)(l * 6 + e) * 128 * 128;
#pragma unroll
        for (int ks = 0; ks < 4; ++ks) { const float* wp = ws_ + (16 * w + fr) * 128 + ks * 32 + fq * 8; const float4 a = *(const float4*)wp, b = *(const float4*)(wp + 4);
            u32x4 t; t.x = cvt_pk_bf16(a.x, a.y); t.y = cvt_pk_bf16(a.z, a.w); t.z = cvt_pk_bf16(b.x, b.y); t.w = cvt_pk_bf16(b.z, b.w); wf[h][ks] = __builtin_bit_cast(bf16x8, t); } }
#pragma unroll
    for (int i = 0; i < 16; ++i) { const int pl = 16 * w + i; const size_t row = (size_t)(t0 + pl); const bf16_t* pr = P + row * D_INP + COL_GM + 768 + e0 * 128;
        float2 st; { const f32x4* sp = (const f32x4*)(stats + row * 24); f32x4 a = sp[0];
#pragma unroll
          for (int k = 1; k < 6; ++k) a += sp[k];
          st = make_float2(a[0] + a[2], a[1] + a[3]); }
        const float mean = st.x * (1.0f / 768.0f); const float rstd = rsqrtf(fmaxf(st.y * (1.0f / 768.0f) - mean * mean, 0.f) + 1e-5f);
#pragma unroll
        for (int h = 0; h < GM_NH; ++h) {
            const float y0 = (bf2f(pr[h * 128 + lane]) - mean) * rstd * g0[h] + be0[h], y1 = (bf2f(pr[h * 128 + 64 + lane]) - mean) * rstd * g1[h] + be1[h];
            const unsigned pk = cvt_pk_bf16(y0, y1);
            VT[(h * 128 + lane) * 132 + pl] = (bf16_t)(pk & 0xffffu); VT[(h * 128 + 64 + lane) * 132 + pl] = (bf16_t)(pk >> 16); } }
    __syncthreads();
#pragma unroll
    for (int h = 0; h < GM_NH; ++h) { const int e = e0 + h;
        f32x4 acc[8];
#pragma unroll
        for (int cb = 0; cb < 8; ++cb) acc[cb] = (f32x4){0.f, 0.f, 0.f, 0.f};
#pragma unroll
        for (int ks = 0; ks < 4; ++ks)
#pragma unroll
            for (int cb = 0; cb < 8; ++cb) { const bf16_t* vp = VT + (h * 128 + cb * 16 + fr) * 132 + ks * 32 + fq * 8; const u32x2 lo = *(const u32x2*)vp, hi = *(const u32x2*)(vp + 4);
                u32x4 t; t.x = lo.x; t.y = lo.y; t.z = hi.x; t.w = hi.y;
                acc[cb] = __builtin_amdgcn_mfma_f32_16x16x32_bf16(__builtin_bit_cast(bf16x8, t), wf[h][ks], acc[cb], 0, 0, 0); }
#pragma unroll
        for (int cb = 0; cb < 8; ++cb) { const int c = cb * 16 + 4 * fq;
            const float u0 = lo_bf(uu[h][cb].x), u1 = hi_bf(uu[h][cb].x), u2 = lo_bf(uu[h][cb].y), u3 = hi_bf(uu[h][cb].y);
            u32x2 o; o.x = cvt_pk_bf16(u0 * (acc[cb][0] + bq[h]), u1 * (acc[cb][1] + bq[h])); o.y = cvt_pk_bf16(u2 * (acc[cb][2] + bq[h]), u3 * (acc[cb][3] + bq[h]));
            *(u32x2*)(MIX + qrow * D_MODEL + MIX_GM + e * 128 + c) = o; } }
    __syncthreads();
}

__device__ void fft_item(const Params& p, int l, int cp, unsigned char* smem) {
    const int tid = tid_l(); const int c0 = 2 * cp;
    float2* B0 = (float2*)smem;
    const float* ZT = (const float*)(p.ws + OFF_ZT) + (size_t)c0 * 8192; const float* X0T = (const float*)(p.ws + OFF_X0T) + (size_t)c0 * 8192;
    const float rf = (float)tid * (1.0f / 8192.0f);
#pragma unroll
    for (int ch = 0; ch < 2; ++ch) { float2 x[16]; float2* B = B0 + ch * FFT_BUF; const float* z = ZT + ch * 8192 + tid;
#pragma unroll
        for (int k = 0; k < 8; ++k) { x[k] = make_float2(z[512 * k], z[4096 + 512 * k]); x[k + 8] = make_float2(0.f, 0.f); }
        radix16<false>(x, rf);
#pragma unroll
        for (int k = 0; k < 16; ++k) B[phys(tid + 512 * k)] = x[k]; }
    __syncthreads();
    { const float r2 = launder_f((float)(tid & 31) * (1.0f / 512.0f));
#pragma unroll
      for (int ch = 0; ch < 2; ++ch) fft_pass2<false>(B0 + ch * FFT_BUF, tid, r2); }
    __syncthreads();
    { const int blk = tid & 255, ch = tid >> 8; float2* B = B0 + ch * FFT_BUF + blk * 33; float2 y[32];
#pragma unroll
      for (int k = 0; k < 32; ++k) y[k] = B[k];
      radix32<false>(y);
      const float2* KF = (const float2*)(p.ws + OFF_KF) + ((size_t)l * 768 + c0 + ch) * 8192 + blk * 2;
#pragma unroll
      for (int k = 0; k < 32; k += 2) { const float4 kq = *(const float4*)(KF + (k >> 1) * 512);
          y[k] = make_float2(y[k].x * kq.x - y[k].y * kq.y, y[k].x * kq.y + y[k].y * kq.x); y[k + 1] = make_float2(y[k + 1].x * kq.z - y[k + 1].y * kq.w, y[k + 1].x * kq.w + y[k + 1].y * kq.z); }
      radix32<true>(y);
#pragma unroll
      for (int k = 0; k < 32; ++k) B[k] = y[k]; }
    __syncthreads();
    { const float r2 = launder_f((float)(tid & 31) * (1.0f / 512.0f));
#pragma unroll
      for (int ch = 0; ch < 2; ++ch) fft_pass2<true>(B0 + ch * FFT_BUF, tid, r2); }
    __syncthreads();
    bf16_t* MIX = (bf16_t*)(p.ws + OFF_MIX);
    const float2 dsk = *(const float2*)(inp(15) + l * 768 + c0);
    const float rfi = launder_f(rf);
    { unsigned long long zp = (unsigned long long)ZT; asm volatile("" : "+s"(zp)); ZT = (const float*)zp; }
#pragma unroll 1
    for (int ch = 0; ch < 2; ++ch) { float2 x[16]; float2* B = B0 + ch * FFT_BUF;
#pragma unroll
        for (int k = 0; k < 16; ++k) x[k] = B[phys(tid + 512 * k)];
        radix16<true>(x, rfi);
        const float d = ch ? dsk.y : dsk.x; const float* z = ZT + ch * 8192 + tid; const float* x0 = X0T + ch * 8192 + tid;
        if (ch == 0) {
#pragma unroll
            for (int k = 0; k < 8; ++k) B0[phys(tid + 512 * k)] = make_float2(x0[512 * k] * (x[k].x + d * z[512 * k]), x0[4096 + 512 * k] * (x[k].y + d * z[4096 + 512 * k]));
        } else {
#pragma unroll
            for (int k = 0; k < 8; ++k) { const int t = tid + 512 * k; const float2 r0 = B0[phys(t)];
                const float r1a = x0[512 * k] * (x[k].x + d * z[512 * k]), r1b = x0[4096 + 512 * k] * (x[k].y + d * z[4096 + 512 * k]);
                *(unsigned*)(MIX + (size_t)t * D_MODEL + MIX_HY + c0) = cvt_pk_bf16(r0.x, r1a);
                *(unsigned*)(MIX + (size_t)(4096 + t) * D_MODEL + MIX_HY + c0) = cvt_pk_bf16(r0.y, r1b); }
        } }
    __syncthreads();
}

__device__ void convact_phase(const Params& p, int l) {
    const bf16_t* UP = (const bf16_t*)(p.ws + OFF_UP); bf16_t* ACT = (bf16_t*)(p.ws + OFF_ACT);
    const float* cw = inp(23) + (size_t)l * 3 * D_UP; const float* cb = inp(24) + (size_t)l * D_UP;
    const int nthr = gridDim.x * 512;
    const int tid = tid_l();
    for (int idx = blockIdx.x * 512 + tid; idx < 704 * 512; idx += nthr) {
        const int cg8 = idx % 704, run = idx / 704; const int j = cg8 >> 4, i8 = (cg8 & 15) * 8;
        const int ncol = j * 128 + i8;
        float wg[3][8], wv[3][8], bg[8], bv[8];
#pragma unroll
        for (int k = 0; k < 3; ++k) { const float4 a = *(const float4*)(cw + k * D_UP + ncol), b = *(const float4*)(cw + k * D_UP + ncol + 4);
            wg[k][0] = a.x; wg[k][1] = a.y; wg[k][2] = a.z; wg[k][3] = a.w; wg[k][4] = b.x; wg[k][5] = b.y; wg[k][6] = b.z; wg[k][7] = b.w;
            const float4 c = *(const float4*)(cw + k * D_UP + D_FF + ncol), d = *(const float4*)(cw + k * D_UP + D_FF + ncol + 4);
            wv[k][0] = c.x; wv[k][1] = c.y; wv[k][2] = c.z; wv[k][3] = c.w; wv[k][4] = d.x; wv[k][5] = d.y; wv[k][6] = d.z; wv[k][7] = d.w; }
        { const float4 a = *(const float4*)(cb + ncol), b = *(const float4*)(cb + ncol + 4); bg[0] = a.x; bg[1] = a.y; bg[2] = a.z; bg[3] = a.w; bg[4] = b.x; bg[5] = b.y; bg[6] = b.z; bg[7] = b.w;
          const float4 c = *(const float4*)(cb + D_FF + ncol), d = *(const float4*)(cb + D_FF + ncol + 4); bv[0] = c.x; bv[1] = c.y; bv[2] = c.z; bv[3] = c.w; bv[4] = d.x; bv[5] = d.y; bv[6] = d.z; bv[7] = d.w; }
        const int r0 = run * 16; const size_t colg = (size_t)j * 256 + i8, colv = colg + 128;
        u32x4 gm = (u32x4){0u, 0u, 0u, 0u}, vm = gm, gc, vc, gn, vn;
        if ((r0 & (SEQ - 1)) != 0) { gm = *(const u32x4*)(UP + (size_t)(r0 - 1) * D_UP + colg); vm = *(const u32x4*)(UP + (size_t)(r0 - 1) * D_UP + colv); }
        gc = *(const u32x4*)(UP + (size_t)r0 * D_UP + colg); vc = *(const u32x4*)(UP + (size_t)r0 * D_UP + colv);
        for (int r = r0; r < r0 + 16; ++r) {
            if ((r & (SEQ - 1)) != SEQ - 1) { gn = *(const u32x4*)(UP + (size_t)(r + 1) * D_UP + colg); vn = *(const u32x4*)(UP + (size_t)(r + 1) * D_UP + colv); }
            else { gn = (u32x4){0u, 0u, 0u, 0u}; vn = gn; }
            float o[8];
#pragma unroll
            for (int q = 0; q < 4; ++q) {
                const float ga = wg[0][2 * q] * lo_bf(gm[q]) + wg[1][2 * q] * lo_bf(gc[q]) + wg[2][2 * q] * lo_bf(gn[q]) + bg[2 * q];
                const float gb = wg[0][2 * q + 1] * hi_bf(gm[q]) + wg[1][2 * q + 1] * hi_bf(gc[q]) + wg[2][2 * q + 1] * hi_bf(gn[q]) + bg[2 * q + 1];
                const float va = wv[0][2 * q] * lo_bf(vm[q]) + wv[1][2 * q] * lo_bf(vc[q]) + wv[2][2 * q] * lo_bf(vn[q]) + bv[2 * q];
                const float vb = wv[0][2 * q + 1] * hi_bf(vm[q]) + wv[1][2 * q + 1] * hi_bf(vc[q]) + wv[2][2 * q + 1] * hi_bf(vn[q]) + bv[2 * q + 1];
                o[2 * q] = silu(ga) * va; o[2 * q + 1] = silu(gb) * vb; }
            u32x4 ow; ow.x = cvt_pk_bf16(o[0], o[1]); ow.y = cvt_pk_bf16(o[2], o[3]); ow.z = cvt_pk_bf16(o[4], o[5]); ow.w = cvt_pk_bf16(o[6], o[7]);
            *(u32x4*)(ACT + (size_t)r * D_FF + ncol) = ow;
            gm = gc; vm = vc; gc = gn; vc = vn;
        }
    }
}

__global__ void __launch_bounds__(512, 2) fwd_megakernel(Params p) {
    extern __shared__ __attribute__((aligned(16))) unsigned char smem[];
    cg::grid_group grid = cg::this_grid();
    const int G = gridDim.x, bid = blockIdx.x;
    int step = 0;
    if (p.ph_hi < 0) grid.sync();
    volatile LAS unsigned* xst = (volatile LAS unsigned*)(LAS unsigned char*)(smem + LDS_BYTES - 16);
    if (threadIdx.x < 4) xst[threadIdx.x] = 0u;
    __syncthreads();
    XcdBarrier xb = xcd_barrier_post((unsigned*)(p.ws + OFF_BAR), xst);
#define STEP_BEGIN if (step >= p.ph_lo && step < p.ph_hi) {
#define STEP_END } ++step; if (step > p.ph_lo && step < p.ph_hi) xcd_barrier(xb);

    bf16_t* H = (bf16_t*)(p.ws + OFF_H);
    bf16_t* XA = (bf16_t*)(p.ws + OFF_XA);
#if PROBE == 6
    for (int i = 0; i < 20; ++i) xcd_barrier(xb);
#endif

    STEP_BEGIN
        for (int it = bid; it < NI_FILT; it += G) filter_item(p, it, (float*)smem);
        convert_range4(p, 0, 0, NI_IN / 4, bid, G, (float*)smem);
        convert_range(p, 1, 0, R_POOL, NI_POOL, bid, G, (float*)smem); convert_range(p, 1, 1, R_POOL, NI_POOL, bid, G, (float*)smem);
        if (bid < 3) { const int zr = bid == 0 ? 0 : (bid == 1 ? 4097 : 8194); for (int i = tid_l(); i < D_MODEL / 2; i += 512) ((unsigned*)(H + (size_t)zr * D_MODEL))[i] = 0u; }
        norm_phase<true>(inp(0), inp(1), H, nullptr);
    STEP_END

    for (int l = 0; l < 2; ++l) {
        STEP_BEGIN
            pg8::Gemm g{H + D_MODEL, (const bf16_t*)(p.ws + OFF_WT_IN + l * SZ_WT_IN), NTOK, D_INP, D_MODEL}; pg8::StaticOrder S; S.init(NTOK, D_INP, G, bid);
            pg8::EpiBf16Gm E{(bf16_t*)(p.ws + OFF_P), D_INP, (float*)(p.ws + OFF_STATS) + (size_t)l * NTOK * 24};
            pg8::gemm_phase<pg8::EpiBf16Gm, pg8::StaticOrder, D_MODEL>((LAS unsigned char*)smem, g, S, E);
            { const int rem = (NTOK / 256) * (D_INP / 256) % G;
              if (bid >= rem) for (int rep_ = 0; rep_ < (PROBE == 11 ? 2 : 1); ++rep_) {
                  if (l == 0) { for (int it = bid - rem; it < 768; it += G - rem) kf_item(p, it, smem); convert_range4(p, 1, 0, NI_IN / 4, bid - rem, G - rem, (float*)smem); convert_range4(p, 0, R_DN + NT3, (NI_DN - NT3) / 4, bid - rem, G - rem, (float*)smem); }
                  else { convert_range4(p, 1, R_OUT, (NI_OUT + NI_UP) / 4, bid - rem, G - rem, (float*)smem); convert_range4(p, 1, R_DN + NT3, (NI_DN - NT3) / 4, bid - rem, G - rem, (float*)smem); } } }
        STEP_END
        STEP_BEGIN
            for (int it = bid; it < 768; it += G) hypre_item(p, l, it, smem);
        STEP_END
        STEP_BEGIN
            for (int rep_ = 0; rep_ < (PROBE == 13 ? 2 : 1); ++rep_) {
            unsigned* wq = (unsigned*)(p.ws + OFF_BAR) + 3500 + l + 8 * rep_;
            for (;;) {
                __syncthreads();
                if (threadIdx.x == 0) xst[2] = atomicAdd(wq, 1u);
                __syncthreads();
                const int it = __builtin_amdgcn_readfirstlane((int)xst[2]);
                constexpr int NCH = (NI_OUT + NI_UP) / 8, NMIX = 384 + 128 + 256;
                int mi = it, ch = -1;
                if (l == 0 && it >= NMIX) { ch = it - NMIX; mi = -1; }
                if (l == 0 ? it >= NMIX + NCH : it >= NMIX) break;
                if (ch >= 0) { if (ch < NCH) convert_range4(p, 0, R_OUT + ch * 8, 2, 0, 1, (float*)smem); }
                else if (mi < 384) fft_item(p, l, mi, smem); else if (mi < 512) gmlp_item(p, l, mi - 384, smem); else pool_item(p, l, mi - 512, smem);
            }
            }
#if PROBE == 21
            for (int it = bid; it < 256; it += G) pool_item(p, l, it, smem);
#elif PROBE == 22
            for (int it = bid; it < 128; it += G) gmlp_item(p, l, it, smem);
#elif PROBE == 3
            for (int it = bid; it < 384; it += G) fft_item(p, l, it, smem);
#endif
        STEP_END
        STEP_BEGIN
            pg8::Gemm g{(const bf16_t*)(p.ws + OFF_MIX), (const bf16_t*)(p.ws + OFF_WT_OUT + l * SZ_WT_OUT), NTOK, D_MODEL, D_MODEL}; pg8::StaticOrder S; S.init(NTOK, D_MODEL, G, bid); S.wgm = 4;
            float* ssp = (float*)(p.ws + OFF_SSP) + (size_t)(2 * l) * NTOK * 32; unsigned* pc = (unsigned*)(p.ws + OFF_BAR) + 3600 + 64 * l;
            if (l == 0) { pg8::EpiResNorm<true, false> E{XA, inp(0), D_MODEL, inp(21) + l * D_MODEL, H, nullptr, ssp, pc}; pg8::gemm_phase<pg8::EpiResNorm<true, false>, pg8::StaticOrder, D_MODEL>((LAS unsigned char*)smem, g, S, E); }
            else { pg8::EpiResNorm<false, false> E{XA, XA, D_MODEL, inp(21) + l * D_MODEL, H, nullptr, ssp, pc}; pg8::gemm_phase<pg8::EpiResNorm<false, false>, pg8::StaticOrder, D_MODEL>((LAS unsigned char*)smem, g, S, E); }
        STEP_END
        STEP_BEGIN
            pg8::Gemm g{H, (const bf16_t*)(p.ws + OFF_WT_UP + l * SZ_WT_UP), NTOK, D_UP, D_MODEL}; pg8::StaticOrder S; S.init_tiles(34, D_UP / 256, G, bid);
            pg8::EpiConvAct E{(bf16_t*)(p.ws + OFF_ACT), inp(23) + (size_t)l * 3 * D_UP, inp(24) + (size_t)l * D_UP};
            pg8::gemm_phase<pg8::EpiConvAct, pg8::StaticOrder, D_MODEL>((LAS unsigned char*)smem, g, S, E);
#if PROBE == 7
            pg8::gemm_phase<pg8::EpiConvAct, pg8::StaticOrder, D_MODEL>((LAS unsigned char*)smem, g, S, E);
#endif
            { const int rem = (34 * (D_UP / 256)) % G; if (bid >= rem) convert_range4(p, l, R_DN, NT3 / 4, bid - rem, G - rem, (float*)smem); }
        STEP_END
        STEP_BEGIN
            pg8::Gemm g{(const bf16_t*)(p.ws + OFF_ACT), (const bf16_t*)(p.ws + OFF_WT_DN + l * SZ_WT_DN), NTOK, D_MODEL, D_FF}; pg8::StaticOrder S; S.init(NTOK, D_MODEL, G, bid); S.wgm = 4;
            float* ssp = (float*)(p.ws + OFF_SSP) + (size_t)(2 * l + 1) * NTOK * 32; unsigned* pc = (unsigned*)(p.ws + OFF_BAR) + 3600 + 64 * l + 32;
            if (l == 0) { pg8::EpiResNorm<false, false> E{XA, XA, D_MODEL, inp(1) + D_MODEL, H, nullptr, ssp, pc}; pg8::gemm_phase<pg8::EpiResNorm<false, false>, pg8::StaticOrder, D_FF>((LAS unsigned char*)smem, g, S, E); }
            else { pg8::EpiResNorm<false, true> E{XA, XA, D_MODEL, inp(26), nullptr, p.out, ssp, pc}; pg8::gemm_phase<pg8::EpiResNorm<false, true>, pg8::StaticOrder, D_FF>((LAS unsigned char*)smem, g, S, E); }
        STEP_END
    }
}

constexpr int N_STEPS = 13;
#ifndef MULTI_LAUNCH
#define MULTI_LAUNCH 0
#endif

extern "C" void kernel_launch(void* const* d_in, const int* in_sizes, int n_in, void* d_out, int out_size, void* d_ws, size_t ws_size, hipStream_t stream) {
    static int grid = 0;
    if (grid == 0) {
        if (n_in != 27 || ws_size < WS_END) { fprintf(stderr, "kernel_launch: need 27 inputs and %zu bytes of workspace (got %d, %zu)\n", (size_t)WS_END, n_in, ws_size); grid = -1; return; }
        int dev = 0, cus = 0, per_cu = 0;
        hipGetDevice(&dev); hipDeviceGetAttribute(&cus, hipDeviceAttributeMultiprocessorCount, dev);
        if (hipFuncSetAttribute((const void*)fwd_megakernel, hipFuncAttributeMaxDynamicSharedMemorySize, LDS_BYTES) != hipSuccess) { fprintf(stderr, "kernel_launch: hipFuncSetAttribute failed\n"); grid = -1; return; }
        if (hipOccupancyMaxActiveBlocksPerMultiprocessor(&per_cu, (const void*)fwd_megakernel, 512, LDS_BYTES) != hipSuccess || per_cu < 1) { fprintf(stderr, "kernel_launch: occupancy query gave %d\n", per_cu); per_cu = 1; }
        (void)hipGetLastError();
        grid = cus * 1;
    }
    if (grid < 0) return;
    if (hipMemsetAsync((char*)d_ws + OFF_BAR, 0, 16384, stream) != hipSuccess) { fprintf(stderr, "kernel_launch: memset failed\n"); return; }
    Params p{};
    for (int i = 0; i < 27; ++i) p.in[i] = (const float*)d_in[i];
    p.out = (float*)d_out; p.ws = (unsigned char*)d_ws;
#if MULTI_LAUNCH
    for (int s = 0; s < N_STEPS; ++s) { p.ph_lo = s; p.ph_hi = s + 1; hipLaunchKernelGGL(fwd_megakernel, dim3(grid), dim3(512), LDS_BYTES, stream, p); }
#else
    p.ph_lo = 0; p.ph_hi = N_STEPS;
    void* args[] = {&p};
    hipError_t e = hipLaunchCooperativeKernel((const void*)fwd_megakernel, dim3(grid), dim3(512), args, LDS_BYTES, stream);
    if (e != hipSuccess) fprintf(stderr, "cooperative launch failed: %s (grid %d)\n", hipGetErrorString(e), grid);
#endif
}
```
